# Optimizing an MI355X kernel written in HIP

```python
import math
import jax, jax.numpy as jnp
from jax import lax
import numpy as np

D_MODEL = 1024
BATCH = 8
SEQ = 4096
DEPTH = 4

N_MIXERS = 2
EPS = 1e-6
NEG_INF = -1e30

GMLP_CHUNK = 128
GMLP_WIDTH = 3 * D_MODEL
GMLP_GROUPS = 8
GMLP_GROUP_WIDTH = GMLP_WIDTH // GMLP_GROUPS

DIL_PATTERNS = ((128, 1), (512, 4), (2048, 16))
N_DIL_GROUPS = len(DIL_PATTERNS)
HEADS_PER_GROUP = 8
HEAD_DIM = 64
ATTN_WIDTH = HEADS_PER_GROUP * HEAD_DIM
QKV_WIDTH = 3 * N_DIL_GROUPS * ATTN_WIDTH
QUERY_BLOCK = 128

N_EXPERTS = 16
CAPACITY_FACTOR = 2
D_EXPERT = 2 * D_MODEL

kernel_name = "hybrid_gmlp_dilated_attn_ec_moe_encoder"


def rmsnorm(x, gain):
    xf = x.astype(jnp.float32)
    y = xf * lax.rsqrt(jnp.mean(xf * xf, axis=-1, keepdims=True) + EPS)
    return (y * gain.astype(jnp.float32)).astype(x.dtype)


def head_rmsnorm(t, gain):
    tf = t.astype(jnp.float32)
    y = tf * lax.rsqrt(jnp.mean(tf * tf, axis=-1, keepdims=True) + EPS)
    return y * gain.astype(jnp.float32)[:, None, :]


def alibi_slopes(n_heads):
    return jnp.exp2(-8.0 * jnp.arange(1, n_heads + 1, dtype=jnp.float32) / n_heads)


def gmlp_mixer(h, w_in, b_in, v_gain, w_s, b_s, w_out, b_out):
    B, S, _ = h.shape
    z = jax.nn.gelu(h @ w_in + b_in)
    u, v = z[..., :GMLP_WIDTH], z[..., GMLP_WIDTH:]
    v = rmsnorm(v, v_gain)
    n_chunks = S // GMLP_CHUNK
    v = v.reshape(B, n_chunks, GMLP_CHUNK, GMLP_GROUPS, GMLP_GROUP_WIDTH)
    v = jnp.einsum('gts,bcsge->bctge', w_s, v) + b_s.T[None, None, :, :, None]
    return (u * v.reshape(B, S, GMLP_WIDTH)) @ w_out + b_out


def dilated_band_attention(q, k, v, dil, half, slopes):
    B, S, H, Dh = q.shape
    L = S // dil
    N = B * dil

    def to_sub(t):
        return t.reshape(B, L, dil, H, Dh).transpose(0, 2, 1, 3, 4).reshape(N, L, H, Dh)

    qs, ks, vs = to_sub(q), to_sub(k), to_sub(v.astype(jnp.float32))
    nb = -(-L // QUERY_BLOCK)
    Lp = nb * QUERY_BLOCK
    KB = QUERY_BLOCK + 2 * half
    qs = jnp.pad(qs, ((0, 0), (0, Lp - L), (0, 0), (0, 0)))
    kpad = ((0, 0), (half, Lp - L + half), (0, 0), (0, 0))
    ks, vs = jnp.pad(ks, kpad), jnp.pad(vs, kpad)
    kidx = jnp.arange(nb)[:, None] * QUERY_BLOCK + jnp.arange(KB)[None, :]
    kb, vb = ks[:, kidx], vs[:, kidx]
    qb = qs.reshape(N, nb, QUERY_BLOCK, H, Dh)
    s = jnp.einsum('nbqhd,nbkhd->nbhqk', qb, kb) / math.sqrt(Dh)
    rel = jnp.arange(KB)[None, :] - half - jnp.arange(QUERY_BLOCK)[:, None]
    kpos = kidx - half
    valid = (jnp.abs(rel)[None] <= half) & ((kpos >= 0) & (kpos < L))[:, None, :]
    bias = -slopes[:, None, None] * (dil * jnp.abs(rel)).astype(jnp.float32)[None]
    s = jnp.where(valid[None, :, None], s + bias[None, None], NEG_INF)
    lse = jax.nn.logsumexp(s, axis=-1)
    p = jnp.exp(s - lse[..., None])
    o = jnp.einsum('nbhqk,nbkhd->nbqhd', p, vb).reshape(N, Lp, H, Dh)[:, :L]
    lse = lse.transpose(0, 1, 3, 2).reshape(N, Lp, H)[:, :L]
    o = o.reshape(B, dil, L, H, Dh).transpose(0, 2, 1, 3, 4).reshape(B, S, H, Dh)
    lse = lse.reshape(B, dil, L, H).transpose(0, 2, 1, 3).reshape(B, S, H)
    return o, lse


def dilated_mixer(h, w_qkv, q_gain, k_gain, w_o):
    B, S, _ = h.shape
    qkv = (h @ w_qkv).reshape(B, S, 3, N_DIL_GROUPS, HEADS_PER_GROUP, HEAD_DIM)
    q = head_rmsnorm(qkv[:, :, 0], q_gain)
    k = head_rmsnorm(qkv[:, :, 1], k_gain)
    v = qkv[:, :, 2]
    slopes = alibi_slopes(HEADS_PER_GROUP)
    outs, lses = [], []
    for g, (window, dil) in enumerate(DIL_PATTERNS):
        o, l = dilated_band_attention(q[:, :, g], k[:, :, g], v[:, :, g], dil, window // (2 * dil), slopes)
        outs.append(o)
        lses.append(l)
    wts = jax.nn.softmax(jnp.stack(lses, 0), axis=0)
    o = jnp.einsum('gbsh,gbshd->bshd', wts, jnp.stack(outs, 0))
    return o.reshape(B, S, ATTN_WIDTH).astype(h.dtype) @ w_o


def ec_moe(h, w_router, b_router, w1, w3, w2):
    B, S, D = h.shape
    cap = CAPACITY_FACTOR * S // N_EXPERTS
    logits = jnp.einsum('bsd,de->bse', h, w_router).astype(jnp.float32) + b_router.astype(jnp.float32)
    aff = jax.nn.softmax(logits, axis=-1)
    gates, idx = lax.top_k(jnp.swapaxes(aff, 1, 2), cap)
    xin = jax.vmap(lambda hb, ib: hb[ib])(h, idx)
    hid = jax.nn.silu(jnp.einsum('becd,edf->becf', xin, w1)) * jnp.einsum('becd,edf->becf', xin, w3)
    y = jnp.einsum('becf,efd->becd', hid, w2) * gates[..., None].astype(h.dtype)
    return jax.vmap(lambda ib, yb: jax.ops.segment_sum(yb.reshape(-1, D), ib.reshape(-1), num_segments=S))(idx, y)


def setup_inputs(seed: int = 0) -> dict:
    key = jax.random.key(seed)
    ks = jax.random.split(key, 20)
    f32 = jnp.float32
    n_a = (DEPTH + 1) // N_MIXERS
    n_b = DEPTH // N_MIXERS

    def nrm(k, shape, scale):
        return jax.random.normal(k, shape, f32) * scale

    return {
        "x": nrm(ks[0], (BATCH, SEQ, D_MODEL), 1.0),
        "mix_norm": 1.0 + nrm(ks[1], (DEPTH, D_MODEL), 0.02),
        "ffn_norm": 1.0 + nrm(ks[2], (DEPTH, D_MODEL), 0.02),
        "gm_w_in": nrm(ks[3], (n_a, D_MODEL, 2 * GMLP_WIDTH), D_MODEL ** -0.5),
        "gm_b_in": nrm(ks[4], (n_a, 2 * GMLP_WIDTH), 0.02),
        "gm_v_norm": 1.0 + nrm(ks[5], (n_a, GMLP_WIDTH), 0.02),
        "gm_w_s": nrm(ks[6], (n_a, GMLP_GROUPS, GMLP_CHUNK, GMLP_CHUNK), GMLP_CHUNK ** -0.5),
        "gm_b_s": 1.0 + nrm(ks[7], (n_a, GMLP_GROUPS, GMLP_CHUNK), 0.02),
        "gm_w_out": nrm(ks[8], (n_a, GMLP_WIDTH, D_MODEL), GMLP_WIDTH ** -0.5),
        "gm_b_out": nrm(ks[9], (n_a, D_MODEL), 0.02),
        "at_w_qkv": nrm(ks[10], (n_b, D_MODEL, QKV_WIDTH), D_MODEL ** -0.5),
        "at_q_norm": 1.0 + nrm(ks[11], (n_b, N_DIL_GROUPS, HEAD_DIM), 0.02),
        "at_k_norm": 1.0 + nrm(ks[12], (n_b, N_DIL_GROUPS, HEAD_DIM), 0.02),
        "at_w_o": nrm(ks[13], (n_b, ATTN_WIDTH, D_MODEL), ATTN_WIDTH ** -0.5),
        "moe_w_router": nrm(ks[14], (DEPTH, D_MODEL, N_EXPERTS), D_MODEL ** -0.5),
        "moe_b_router": nrm(ks[15], (DEPTH, N_EXPERTS), 0.01),
        "moe_w1": nrm(ks[16], (DEPTH, N_EXPERTS, D_MODEL, D_EXPERT), D_MODEL ** -0.5),
        "moe_w3": nrm(ks[17], (DEPTH, N_EXPERTS, D_MODEL, D_EXPERT), D_MODEL ** -0.5),
        "moe_w2": nrm(ks[18], (DEPTH, N_EXPERTS, D_EXPERT, D_MODEL), D_EXPERT ** -0.5),
    }


def reference(x, mix_norm, ffn_norm, gm_w_in, gm_b_in, gm_v_norm, gm_w_s, gm_b_s, gm_w_out, gm_b_out,
              at_w_qkv, at_q_norm, at_k_norm, at_w_o,
              moe_w_router, moe_b_router, moe_w1, moe_w3, moe_w2):
    for i in range(DEPTH):
        j = i // N_MIXERS
        h = rmsnorm(x, mix_norm[i])
        if i % N_MIXERS == 0:
            x = x + gmlp_mixer(h, gm_w_in[j], gm_b_in[j], gm_v_norm[j], gm_w_s[j], gm_b_s[j],
                               gm_w_out[j], gm_b_out[j])
        else:
            x = x + dilated_mixer(h, at_w_qkv[j], at_q_norm[j], at_k_norm[j], at_w_o[j])
        h = rmsnorm(x, ffn_norm[i])
        x = x + ec_moe(h, moe_w_router[i], moe_b_router[i], moe_w1[i], moe_w3[i], moe_w2[i])
    return x
```

```cpp
#include <hip/hip_runtime.h>
#include <cstdio>
#include <cstdint>

#ifndef MK_MULTI
#define MK_MULTI 1
#endif

namespace pg8 {
#define PG8_LAS __attribute__((address_space(3)))
typedef unsigned short bf16_t;
typedef short bf16x8 __attribute__((ext_vector_type(8)));
typedef float f32x4 __attribute__((ext_vector_type(4)));
typedef float f32x2 __attribute__((ext_vector_type(2)));
typedef unsigned u32x4 __attribute__((ext_vector_type(4)));
typedef unsigned u32x2 __attribute__((ext_vector_type(2)));
constexpr int BM = 256, BK = 64, HALF = 128, HTB = HALF * BK * 2, STAGE_BYTES = 8 * HTB, NXCD = 8, WGM = 8;

__host__ __device__ __forceinline__ int lds_byte(int r, int c) { const int st = (r >> 4) * 2 + (c >> 5), rr = r & 15, cc = c & 31, ob = rr * 64 + cc * 2; return st * 1024 + (ob ^ (((ob >> 9) & 1) << 5)); }
__host__ __device__ __forceinline__ void stage_rc(int b, int& R, int& C) { const int st = b / 1024, sb = b % 1024, swz = sb ^ (((sb >> 9) & 1) << 5); R = (st >> 1) * 16 + swz / 64; C = (st & 1) * 32 + (swz % 64) / 2; }
__host__ __device__ __forceinline__ int perm32(int rho) { const int n = rho >> 4, i = rho & 15; return 8 * (i >> 2) + 4 * n + (i & 3); }

struct Unit { int pm, pn; };
struct Gemm { const bf16_t* A; const bf16_t* Bt; int M, N, K; };

struct StaticOrder {
    int nM, nN, nwg, G, c;
    __host__ __device__ void init(int M, int N, int G_, int c_) { nM = M / BM; nN = N / BM; nwg = nM * nN; G = G_; c = c_; }
    __host__ __device__ bool next(int i, Unit& u) const {
        const long L = (long)i * G + c; if (L >= nwg) return false;
        int wgid = (int)L; { const int q = nwg / NXCD, r = nwg % NXCD, xcd = wgid % NXCD, off = wgid / NXCD; wgid = (xcd < r ? xcd * (q + 1) : r * (q + 1) + (xcd - r) * q) + off; }
        const int nig = WGM * nN, gid = wgid / nig, fm = gid * WGM, gsz = (nM - fm) < WGM ? (nM - fm) : WGM;
        u.pm = fm + ((wgid % nig) % gsz); u.pn = (wgid % nig) / gsz; return true;
    }
    __device__ __forceinline__ void a_ready(const Unit&) const {}
    __device__ __forceinline__ void done(const Unit&) const {}
};
struct MoeOrder1 {
    int G, c;
    __device__ bool next(int i, Unit& u) const {
        const int L = i * G + c; if (L >= 4096) return false;
        const int e = L >> 8, w = L & 255, x = w & 7, off = w >> 3;
        u.pm = e * 16 + 4 * (x >> 1) + (off & 3); u.pn = e * 16 + 8 * (x & 1) + (off >> 2); return true;
    }
    __device__ __forceinline__ void a_ready(const Unit&) const {}
    __device__ __forceinline__ void done(const Unit&) const {}
};
struct MoeOrder2 {
    int G, c;
    __device__ bool next(int i, Unit& u) const {
        const int L = i * G + c; if (L >= 1024) return false;
        const int r = L >> 8, w0 = L & 255, wg = (w0 & 7) * 32 + (w0 >> 3), e = r * 4 + (wg >> 6), w = wg & 63;
        u.pm = e * 16 + (w >> 2); u.pn = e * 4 + (w & 3); return true;
    }
    __device__ __forceinline__ void a_ready(const Unit&) const {}
    __device__ __forceinline__ void done(const Unit&) const {}
};

__device__ __forceinline__ unsigned cvt_pk_bf16(float lo, float hi) { unsigned r; asm volatile("v_cvt_pk_bf16_f32 %0, %1, %2" : "=v"(r) : "v"(lo), "v"(hi)); return r; }
__device__ __forceinline__ float gelu_tanh(float x) {
    const float t = x * (1.0f + 0.044715f * x * x);
    const float e = __builtin_amdgcn_exp2f(t * (-2.0f * 0.7978845608f * 1.4426950409f));
    return x * __builtin_amdgcn_rcpf(1.0f + e);
}
__device__ __forceinline__ float silu_f(float a) { return a * __builtin_amdgcn_rcpf(1.0f + __builtin_amdgcn_exp2f(a * -1.4426950409f)); }

struct EpiGeluBf16 {
    static constexpr bool PERM = true, AFTER_DRAIN = false;
    bf16_t* O; int ldc; const float* bias;
    __device__ __forceinline__ void operator()(const f32x4 (&acc)[2][2][4][2], const Unit& u, int wr, int wc, int fr, int fq) const {
        const int row0 = u.pm * BM + wr * 64 + fr, col0 = u.pn * BM + wc * 32 + 8 * fq;
        f32x4 bv[2][2];
#pragma unroll
        for (int bj = 0; bj < 2; ++bj)
#pragma unroll
            for (int n = 0; n < 2; ++n) bv[bj][n] = *(const f32x4*)(bias + col0 + bj * HALF + 4 * n);
#pragma unroll
        for (int ai = 0; ai < 2; ++ai)
#pragma unroll
            for (int m = 0; m < 4; ++m) { bf16_t* rowp = O + (size_t)(row0 + ai * HALF + m * 16) * ldc + col0;
#pragma unroll
                for (int bj = 0; bj < 2; ++bj) { const f32x4 v0 = acc[ai][bj][m][0] + bv[bj][0], v1 = acc[ai][bj][m][1] + bv[bj][1];
                    u32x4 w; w.x = cvt_pk_bf16(gelu_tanh(v0[0]), gelu_tanh(v0[1])); w.y = cvt_pk_bf16(gelu_tanh(v0[2]), gelu_tanh(v0[3]));
                    w.z = cvt_pk_bf16(gelu_tanh(v1[0]), gelu_tanh(v1[1])); w.w = cvt_pk_bf16(gelu_tanh(v1[2]), gelu_tanh(v1[3]));
                    *(u32x4*)(rowp + bj * HALF) = w; } }
    }
};
struct EpiVT {
    static constexpr bool PERM = true, AFTER_DRAIN = false;
    bf16_t* VT; int ldc; const float* bias; float* ssq;
    __device__ __forceinline__ void operator()(const f32x4 (&acc)[2][2][4][2], const Unit& u, int wr, int wc, int fr, int fq) const {
        const int row0 = u.pm * BM + wr * 64 + fr, col0 = u.pn * BM + wc * 32 + 8 * fq;
        f32x4 cs[2][2];
#pragma unroll
        for (int bj = 0; bj < 2; ++bj)
#pragma unroll
            for (int n = 0; n < 2; ++n) cs[bj][n] = (f32x4){0.f, 0.f, 0.f, 0.f};
#pragma unroll
        for (int ai = 0; ai < 2; ++ai)
#pragma unroll
            for (int m = 0; m < 4; ++m) { const int e = row0 + ai * HALF + m * 16; const float b = bias[e]; bf16_t* rowp = VT + (size_t)e * ldc + col0;
#pragma unroll
                for (int bj = 0; bj < 2; ++bj) { f32x4 v0 = acc[ai][bj][m][0] + b, v1 = acc[ai][bj][m][1] + b;
#pragma unroll
                    for (int j = 0; j < 4; ++j) { v0[j] = gelu_tanh(v0[j]); v1[j] = gelu_tanh(v1[j]); }
                    cs[bj][0] += v0 * v0; cs[bj][1] += v1 * v1;
                    u32x4 w; w.x = cvt_pk_bf16(v0[0], v0[1]); w.y = cvt_pk_bf16(v0[2], v0[3]); w.z = cvt_pk_bf16(v1[0], v1[1]); w.w = cvt_pk_bf16(v1[2], v1[3]);
                    *(u32x4*)(rowp + bj * HALF) = w; } }
#pragma unroll
        for (int bj = 0; bj < 2; ++bj)
#pragma unroll
            for (int n = 0; n < 2; ++n)
#pragma unroll
                for (int j = 0; j < 4; ++j) { float s = cs[bj][n][j];
                    s += __shfl_xor(s, 1); s += __shfl_xor(s, 2); s += __shfl_xor(s, 4); s += __shfl_xor(s, 8); cs[bj][n][j] = s; }
        if (fr == 0) {
            float* sp = ssq + (size_t)(2 * u.pm + wr) * ldc + col0;
#pragma unroll
            for (int bj = 0; bj < 2; ++bj)
#pragma unroll
                for (int n = 0; n < 2; ++n) *(f32x4*)(sp + bj * HALF + 4 * n) = cs[bj][n];
        }
    }
};
struct EpiResid {
    static constexpr bool PERM = false, AFTER_DRAIN = false;
    const float* base; float* out; int ldc; const float* bias;
    __device__ __forceinline__ void operator()(const f32x4 (&acc)[2][2][4][2], const Unit& u, int wr, int wc, int fr, int fq) const {
        const int row0 = u.pm * BM + wr * 64 + fr, col0 = u.pn * BM + wc * 32 + 4 * fq;
        f32x4 bv[2][2];
#pragma unroll
        for (int bj = 0; bj < 2; ++bj)
#pragma unroll
            for (int n = 0; n < 2; ++n) bv[bj][n] = bias ? *(const f32x4*)(bias + col0 + bj * HALF + n * 16) : (f32x4){0.f, 0.f, 0.f, 0.f};
#pragma unroll
        for (int ai = 0; ai < 2; ++ai)
#pragma unroll
            for (int m = 0; m < 4; ++m) { const size_t off = (size_t)(row0 + ai * HALF + m * 16) * ldc + col0;
#pragma unroll
                for (int bj = 0; bj < 2; ++bj)
#pragma unroll
                    for (int n = 0; n < 2; ++n) { const f32x4 bs = *(const f32x4*)(base + off + bj * HALF + n * 16);
                        *(f32x4*)(out + off + bj * HALF + n * 16) = bs + acc[ai][bj][m][n] + bv[bj][n]; }
                asm volatile("" ::: "memory"); }
    }
};
struct EpiQKV {
    static constexpr bool PERM = true, AFTER_DRAIN = false;
    bf16_t* QKV; const float* qg; const float* kg;
    __device__ __forceinline__ void operator()(const f32x4 (&acc)[2][2][4][2], const Unit& u, int wr, int wc, int fr, int fq) const {
        const int hd = u.pn * 4 + wc, which = hd / 24, g = (hd % 24) >> 3, h = hd & 7;
        f32x4 gv[2][2];
#pragma unroll
        for (int bj = 0; bj < 2; ++bj)
#pragma unroll
            for (int n = 0; n < 2; ++n) {
                if (which == 0) gv[bj][n] = *(const f32x4*)(qg + g * 64 + 32 * bj + 8 * fq + 4 * n) * 0.125f;
                else if (which == 1) gv[bj][n] = *(const f32x4*)(kg + g * 64 + 32 * bj + 8 * fq + 4 * n);
                else gv[bj][n] = (f32x4){1.f, 1.f, 1.f, 1.f}; }
        bf16_t* hb = QKV + (size_t)(which * 3 + g) * (8 * 8 * 4096 * 64) + (size_t)h * (4096 * 64) + 8 * fq;
#pragma unroll
        for (int ai = 0; ai < 2; ++ai)
#pragma unroll
            for (int m = 0; m < 4; ++m) { const int row = u.pm * BM + ai * HALF + wr * 64 + m * 16 + fr, b = row >> 12, s = row & 4095;
                float ss = 0.f;
#pragma unroll
                for (int bj = 0; bj < 2; ++bj)
#pragma unroll
                    for (int n = 0; n < 2; ++n) { const f32x4 x = acc[ai][bj][m][n]; ss += (x[0] * x[0] + x[1] * x[1]) + (x[2] * x[2] + x[3] * x[3]); }
                ss += __shfl_xor(ss, 16); ss += __shfl_xor(ss, 32);
                const float rinv = which < 2 ? __builtin_amdgcn_rsqf(ss * (1.0f / 64.0f) + 1e-6f) : 1.0f;
                bf16_t* dst = hb + (size_t)b * (8 * 4096 * 64) + (size_t)s * 64;
#pragma unroll
                for (int bj = 0; bj < 2; ++bj) { const f32x4 v0 = acc[ai][bj][m][0] * rinv * gv[bj][0], v1 = acc[ai][bj][m][1] * rinv * gv[bj][1];
                    u32x4 w; w.x = cvt_pk_bf16(v0[0], v0[1]); w.y = cvt_pk_bf16(v0[2], v0[3]); w.z = cvt_pk_bf16(v1[0], v1[1]); w.w = cvt_pk_bf16(v1[2], v1[3]);
                    *(u32x4*)(dst + 32 * bj) = w; } }
    }
};
struct EpiSwiGLU {
    static constexpr bool PERM = true, AFTER_DRAIN = false;
    bf16_t* HID;
    __device__ __forceinline__ void operator()(const f32x4 (&acc)[2][2][4][2], const Unit& u, int wr, int wc, int fr, int fq) const {
        const int row0 = u.pm * BM + wr * 64 + fr, col0 = (u.pn & 15) * HALF + wc * 32 + 8 * fq;
#pragma unroll
        for (int ai = 0; ai < 2; ++ai)
#pragma unroll
            for (int m = 0; m < 4; ++m) { bf16_t* rowp = HID + (size_t)(row0 + ai * HALF + m * 16) * 2048 + col0;
                const f32x4 a0 = acc[ai][0][m][0], a1 = acc[ai][0][m][1], b0 = acc[ai][1][m][0], b1 = acc[ai][1][m][1];
                u32x4 w; w.x = cvt_pk_bf16(silu_f(a0[0]) * b0[0], silu_f(a0[1]) * b0[1]); w.y = cvt_pk_bf16(silu_f(a0[2]) * b0[2], silu_f(a0[3]) * b0[3]);
                w.z = cvt_pk_bf16(silu_f(a1[0]) * b1[0], silu_f(a1[1]) * b1[1]); w.w = cvt_pk_bf16(silu_f(a1[2]) * b1[2], silu_f(a1[3]) * b1[3]);
                *(u32x4*)rowp = w; }
    }
};
struct EpiGate {
    static constexpr bool PERM = true, AFTER_DRAIN = false;
    bf16_t* Y; const float* gate;
    __device__ __forceinline__ void operator()(const f32x4 (&acc)[2][2][4][2], const Unit& u, int wr, int wc, int fr, int fq) const {
        const int row0 = u.pm * BM + wr * 64 + fr, col0 = (u.pn & 3) * BM + wc * 32 + 8 * fq;
#pragma unroll
        for (int ai = 0; ai < 2; ++ai)
#pragma unroll
            for (int m = 0; m < 4; ++m) { const int r = row0 + ai * HALF + m * 16; const float gt = gate[r]; bf16_t* rowp = Y + (size_t)r * 1024 + col0;
#pragma unroll
                for (int bj = 0; bj < 2; ++bj) { const f32x4 v0 = acc[ai][bj][m][0] * gt, v1 = acc[ai][bj][m][1] * gt;
                    u32x4 w; w.x = cvt_pk_bf16(v0[0], v0[1]); w.y = cvt_pk_bf16(v0[2], v0[3]); w.z = cvt_pk_bf16(v1[0], v1[1]); w.w = cvt_pk_bf16(v1[2], v1[3]);
                    *(u32x4*)(rowp + bj * HALF) = w; } }
    }
};

template <class Epi, class Sched, bool ALIGN_EPI = false, bool SP2 = false>
__device__ __forceinline__ void gemm_phase(PG8_LAS unsigned char* lds, const Gemm g, const Sched& S, const Epi& E) {
    int tid_ = threadIdx.x; asm volatile("" : "+v"(tid_));
    const int tid = tid_, wid = __builtin_amdgcn_readfirstlane(tid >> 6), lane = tid & 63, wr = wid >> 2, wc = wid & 3, fr = lane & 15, fq = lane >> 4;
    const int K = g.K, nt = K / BK;
    unsigned voffA[2], voffB[2];
#pragma unroll
    for (int i = 0; i < 2; ++i) { int R, C; stage_rc(tid * 16 + i * 8192, R, C); const int Rb = Epi::PERM ? ((R & ~31) + perm32(R & 31)) : R;
        voffA[i] = (unsigned)(R * K + C) * 2u; voffB[i] = (unsigned)(Rb * K + C) * 2u; }
    const size_t kstep = (size_t)(BK * 2);
    const size_t hstep = (size_t)HALF * K * 2;
    const size_t tstep = 2 * hstep;
    const unsigned ldsw = (unsigned)wid * 1024u;
    const int aoff = lds_byte(wr * 64 + fr, fq * 8), boff = lds_byte(wc * 32 + fr, fq * 8);
#define PG8_SA(b, h) (((b) * 2 + (h)) * HTB)
#define PG8_SB(b, h) ((4 + (b) * 2 + (h)) * HTB)
#define PG8_STAGE(bufoff, gbase, voff) do { _Pragma("unroll") for (int _i = 0; _i < 2; ++_i) \
        __builtin_amdgcn_global_load_lds((const unsigned*)((const char*)(gbase) + (voff)[_i]), (PG8_LAS unsigned*)(lds + (bufoff) + ldsw + _i * 8192), 16, 0, 0); } while (0)
#define PG8_LDA(dst, b, h) do { _Pragma("unroll") for (int m = 0; m < 4; ++m) _Pragma("unroll") for (int k = 0; k < 2; ++k) dst[m][k] = *(const PG8_LAS bf16x8*)(lds + PG8_SA(b, h) + aoff + m * 2048 + k * 1024); } while (0)
#define PG8_LDB(dst, b, h) do { _Pragma("unroll") for (int n = 0; n < 2; ++n) _Pragma("unroll") for (int k = 0; k < 2; ++k) dst[n][k] = *(const PG8_LAS bf16x8*)(lds + PG8_SB(b, h) + boff + n * 2048 + k * 1024); } while (0)
#define PG8_MMA(ai, bj, At, Bt) do { __builtin_amdgcn_s_setprio(1); _Pragma("unroll") for (int m = 0; m < 4; ++m) _Pragma("unroll") for (int n = 0; n < 2; ++n) _Pragma("unroll") for (int k = 0; k < 2; ++k) \
        acc[ai][bj][m][n] = __builtin_amdgcn_mfma_f32_16x16x32_bf16(Bt[n][k], At[m][k], acc[ai][bj][m][n], 0, 0, 0); __builtin_amdgcn_s_setprio(0); } while (0)
#define PG8_WAIT_V(n) asm volatile("s_waitcnt vmcnt(" #n ")" ::: "memory")
#define PG8_WAIT_L(n) asm volatile("s_waitcnt lgkmcnt(" #n ")" ::: "memory")
#define PG8_BAR __builtin_amdgcn_s_barrier()
#define PG8_SCHED __builtin_amdgcn_sched_barrier(0)
    Unit cur, nxt; int ui = 0;
    if (!S.next(0, cur)) return;
    f32x4 acc[2][2][4][2];
#pragma unroll
    for (int a = 0; a < 2; ++a)
#pragma unroll
        for (int b = 0; b < 2; ++b)
#pragma unroll
            for (int m = 0; m < 4; ++m)
#pragma unroll
                for (int n = 0; n < 2; ++n) acc[a][b][m][n] = (f32x4){0.f, 0.f, 0.f, 0.f};
    bf16x8 At[4][2], B0[2][2], B1[2][2];
    const char* cA = (const char*)g.A + (size_t)cur.pm * tstep; const char* cB = (const char*)g.Bt + (size_t)cur.pn * tstep;
    S.a_ready(cur);
    if constexpr (SP2) {
        PG8_STAGE(PG8_SB(0, 0), cB, voffB); PG8_STAGE(PG8_SB(0, 1), cB + hstep, voffB); PG8_STAGE(PG8_SA(0, 0), cA, voffA); PG8_STAGE(PG8_SA(0, 1), cA + hstep, voffA);
        if (wr == 1) PG8_BAR;
        PG8_WAIT_V(2); PG8_BAR;
        PG8_STAGE(PG8_SB(1, 0), cB + kstep, voffB); PG8_STAGE(PG8_SA(1, 0), cA + kstep, voffA); PG8_STAGE(PG8_SB(1, 1), cB + hstep + kstep, voffB);
        PG8_WAIT_V(6); PG8_BAR;
    } else {
        PG8_STAGE(PG8_SB(0, 0), cB, voffB); PG8_STAGE(PG8_SA(0, 0), cA, voffA); PG8_STAGE(PG8_SB(0, 1), cB + hstep, voffB); PG8_STAGE(PG8_SA(0, 1), cA + hstep, voffA);
        if (wr == 1) PG8_BAR;
        PG8_WAIT_V(4); PG8_BAR;
        PG8_STAGE(PG8_SB(1, 0), cB + kstep, voffB); PG8_STAGE(PG8_SA(1, 0), cA + kstep, voffA); PG8_STAGE(PG8_SB(1, 1), cB + hstep + kstep, voffB);
        PG8_WAIT_V(6); PG8_BAR;
    }
    for (;;) {
        const bool has_next = S.next(ui + 1, nxt);
        const char* nA = has_next ? (const char*)g.A + (size_t)nxt.pm * tstep : cA; const char* nB = has_next ? (const char*)g.Bt + (size_t)nxt.pn * tstep : cB;
        for (int t = 0; t < nt; t += 2) {
            const bool last = (t == nt - 2);
            const char* a1 = cA + (size_t)(t + 1) * kstep;
            const char* a2 = last ? nA : cA + (size_t)(t + 2) * kstep; const char* b2 = last ? nB : cB + (size_t)(t + 2) * kstep;
            const char* a3 = a2 + kstep; const char* b3 = b2 + kstep;
            if (last && has_next) S.a_ready(nxt);
            if constexpr (SP2) {
            PG8_LDB(B0, 0, 0); PG8_LDB(B1, 0, 1); PG8_SCHED; PG8_LDA(At, 0, 0); PG8_STAGE(PG8_SA(1, 1), a1 + hstep, voffA);
            PG8_WAIT_V(8); PG8_WAIT_L(0); PG8_BAR; PG8_MMA(0, 0, At, B0); PG8_MMA(0, 1, At, B1); PG8_BAR; PG8_SCHED;
            PG8_LDA(At, 0, 1); PG8_STAGE(PG8_SB(0, 0), b2, voffB); PG8_STAGE(PG8_SB(0, 1), b2 + hstep, voffB); PG8_STAGE(PG8_SA(0, 0), a2, voffA);
            PG8_WAIT_V(8); PG8_WAIT_L(0); PG8_BAR; PG8_MMA(1, 0, At, B0); PG8_MMA(1, 1, At, B1); PG8_BAR; PG8_SCHED;
            PG8_LDB(B0, 1, 0); PG8_LDB(B1, 1, 1); PG8_SCHED; PG8_LDA(At, 1, 0); PG8_STAGE(PG8_SA(0, 1), a2 + hstep, voffA);
            PG8_WAIT_V(8); PG8_WAIT_L(0); PG8_BAR; PG8_MMA(0, 0, At, B0); PG8_MMA(0, 1, At, B1); PG8_BAR; PG8_SCHED;
            PG8_LDA(At, 1, 1); PG8_STAGE(PG8_SB(1, 0), b3, voffB); PG8_STAGE(PG8_SB(1, 1), b3 + hstep, voffB); PG8_STAGE(PG8_SA(1, 0), a3, voffA);
            PG8_WAIT_V(8); PG8_WAIT_L(0); PG8_BAR; PG8_MMA(1, 0, At, B0); PG8_MMA(1, 1, At, B1); PG8_BAR; PG8_SCHED;
            } else {
            PG8_LDB(B0, 0, 0); PG8_SCHED; PG8_LDA(At, 0, 0); PG8_STAGE(PG8_SA(1, 1), a1 + hstep, voffA);
            PG8_WAIT_L(8); PG8_BAR; PG8_WAIT_L(0); PG8_MMA(0, 0, At, B0); PG8_BAR; PG8_SCHED;
            PG8_LDB(B1, 0, 1); PG8_STAGE(PG8_SB(0, 0), b2, voffB);
            PG8_BAR; PG8_WAIT_L(0); PG8_MMA(0, 1, At, B1); PG8_BAR;
            PG8_LDA(At, 0, 1); PG8_STAGE(PG8_SA(0, 0), a2, voffA);
            PG8_BAR; PG8_WAIT_L(0); PG8_MMA(1, 0, At, B0); PG8_BAR; PG8_SCHED;
            PG8_STAGE(PG8_SB(0, 1), b2 + hstep, voffB);
            PG8_WAIT_V(6); PG8_BAR; PG8_MMA(1, 1, At, B1); PG8_BAR;
            PG8_LDB(B0, 1, 0); PG8_SCHED; PG8_LDA(At, 1, 0); PG8_STAGE(PG8_SA(0, 1), a2 + hstep, voffA);
            PG8_WAIT_L(8); PG8_BAR; PG8_WAIT_L(0); PG8_MMA(0, 0, At, B0); PG8_BAR; PG8_SCHED;
            PG8_LDB(B1, 1, 1); PG8_STAGE(PG8_SB(1, 0), b3, voffB);
            PG8_BAR; PG8_WAIT_L(0); PG8_MMA(0, 1, At, B1); PG8_BAR;
            PG8_LDA(At, 1, 1); PG8_STAGE(PG8_SA(1, 0), a3, voffA);
            PG8_BAR; PG8_WAIT_L(0); PG8_MMA(1, 0, At, B0); PG8_BAR; PG8_SCHED;
            PG8_STAGE(PG8_SB(1, 1), b3 + hstep, voffB);
            PG8_WAIT_V(6); PG8_BAR; PG8_MMA(1, 1, At, B1); PG8_BAR;
            }
        }
        if constexpr (ALIGN_EPI) { if (wr == 0) PG8_BAR; }
        if constexpr (!Epi::AFTER_DRAIN) { E(acc, cur, wr, wc, fr, fq); S.done(cur); }
        if (!has_next) break;
#pragma unroll
        for (int a = 0; a < 2; ++a)
#pragma unroll
            for (int b = 0; b < 2; ++b)
#pragma unroll
                for (int m = 0; m < 4; ++m)
#pragma unroll
                    for (int n = 0; n < 2; ++n) acc[a][b][m][n] = (f32x4){0.f, 0.f, 0.f, 0.f};
        cur = nxt; cA = nA; cB = nB; ++ui;
        if constexpr (ALIGN_EPI) { if (wr == 1) PG8_BAR; }
    }
    PG8_WAIT_V(0);
    if constexpr (!ALIGN_EPI) { if (wr == 0) PG8_BAR; }
    PG8_BAR;
#undef PG8_SA
#undef PG8_SB
#undef PG8_STAGE
#undef PG8_LDA
#undef PG8_LDB
#undef PG8_MMA
#undef PG8_WAIT_V
#undef PG8_WAIT_L
#undef PG8_BAR
#undef PG8_SCHED
}
}

constexpr int NB = 8, SEQ = 4096, D = 1024, T = NB * SEQ;
constexpr int GW = 3072;
constexpr int NE = 16, CAP = 512, DE = 2048, NSLOT = NB * NE * CAP;
constexpr int QKVW = 4608, AW = 512;
constexpr float EPS = 1e-6f;

constexpr size_t MiB = 1u << 20;
constexpr size_t WS_CTL = 0, CTL_ZERO_BYTES = 1 * MiB;
constexpr size_t WS_WIN = 1 * MiB;
constexpr size_t WS_WOUT = 25 * MiB;
constexpr size_t WS_WQKV = 37 * MiB;
constexpr size_t WS_WO = 55 * MiB;
constexpr size_t WS_W13 = 57 * MiB;
constexpr size_t WS_W2 = 569 * MiB;
constexpr size_t WS_H = 825 * MiB;
constexpr size_t WS_AFF = 889 * MiB;
constexpr size_t WS_SMAP = 891 * MiB;
constexpr size_t WS_TOK = 893 * MiB;
constexpr size_t WS_GATE = 893 * MiB + 512 * 1024;
constexpr size_t WS_ACT = 894 * MiB;
constexpr size_t WS_U = WS_ACT, WS_VT = WS_ACT + 192 * MiB, WS_SSQ = WS_ACT + 384 * MiB;
constexpr size_t WS_QKV = WS_ACT, WS_O = WS_ACT + 288 * MiB;
constexpr size_t WS_XIN = WS_ACT, WS_HID = WS_ACT + 128 * MiB, WS_Y = WS_ACT + 384 * MiB;
constexpr size_t WS_END = WS_ACT + 512 * MiB;
constexpr int CW_BAR = 4096;

constexpr int RING_BYTES = 131072, LDSCTL_OFF = RING_BYTES, LDS_BYTES = 147456;

#define LAS __attribute__((address_space(3)))
typedef unsigned short bf16;
typedef unsigned v4u __attribute__((ext_vector_type(4)));
typedef unsigned v2u __attribute__((ext_vector_type(2)));
typedef float f32x4 __attribute__((ext_vector_type(4)));
typedef short bf16x8 __attribute__((ext_vector_type(8)));
#define LDS_WAIT() asm volatile("s_waitcnt lgkmcnt(0)" ::: "memory")
__device__ __forceinline__ unsigned f2bf(float f) { unsigned u = __builtin_bit_cast(unsigned, f); return (u + 0x7fffu + ((u >> 16) & 1u)) >> 16; }
__device__ __forceinline__ unsigned pk2(float lo, float hi) { return f2bf(lo) | (f2bf(hi) << 16); }
__device__ __forceinline__ float bf_lo(unsigned w) { return __builtin_bit_cast(float, w << 16); }
__device__ __forceinline__ float bf_hi(unsigned w) { return __builtin_bit_cast(float, w & 0xffff0000u); }

#define XB_TMO      128
#define XB_XCNT(j)  (256  + 64 * (j))
#define XB_XSUB(j)  (1280 + 64 * (j))
#define XB_XGEN(j)  (2304 + 64 * (j))
#define XB_TOP      3328
#define XB_TOPGEN   3392
#define XCD_BAR_WORDS 3456
#define XB_SPIN_CAP (1u << 22)
__device__ __forceinline__ unsigned xb_ld(unsigned* p)              { return __hip_atomic_load(p, __ATOMIC_RELAXED, __HIP_MEMORY_SCOPE_AGENT); }
__device__ __forceinline__ unsigned xb_add(unsigned* p, unsigned v) { return __hip_atomic_fetch_add(p, v, __ATOMIC_RELAXED, __HIP_MEMORY_SCOPE_AGENT); }
__device__ __forceinline__ unsigned xb_xcc_id() { return (unsigned)__builtin_amdgcn_s_getreg((3 << 11) | 20) & 0xFu; }
#define XB_SPIN(cond, bar) do { unsigned _sp = 0; while (cond) { __builtin_amdgcn_s_sleep(1); \
    if ((++_sp & 255u) == 0u) { if (xb_ld(&(bar)[XB_TMO])) break; if (_sp > XB_SPIN_CAP) { atomicAdd(&(bar)[XB_TMO], 1u); break; } } } } while (0)
struct XcdBarrier { unsigned* bar; unsigned x; volatile LAS unsigned* st; };
__device__ __forceinline__ XcdBarrier xcd_barrier_post(unsigned* bar, volatile LAS unsigned* st) {
    XcdBarrier b; b.bar = bar; b.x = xb_xcc_id(); b.st = st;
    if (threadIdx.x == 0) (void)xb_add(&bar[XB_XCNT(b.x)], 1u);
    return b;
}
__device__ __forceinline__ void xcd_barrier_complete(unsigned* bar, unsigned x, unsigned& nloc, unsigned& nx) {
    const unsigned G = gridDim.x * gridDim.y * gridDim.z;
    unsigned sum, cnt, mine, sp = 0u;
    for (;;) {
        sum = 0u; cnt = 0u; mine = 0u;
#pragma unroll
        for (unsigned j = 0; j < 16; ++j) { const unsigned c = xb_ld(&bar[XB_XCNT(j)]); sum += c; cnt += (c > 0u) ? 1u : 0u; mine = (j == x) ? c : mine; }
        if (sum == G) break;
        __builtin_amdgcn_s_sleep(1);
        if ((++sp & 255u) == 0u) { if (xb_ld(&bar[XB_TMO])) break; if (sp > XB_SPIN_CAP) { atomicAdd(&bar[XB_TMO], 1u); break; } }
    }
    nloc = mine > 0u ? mine : 1u; nx = cnt > 0u ? cnt : 1u;
}
__device__ __forceinline__ void xcd_barrier(const XcdBarrier& b) {
    asm volatile("s_waitcnt vmcnt(0)" ::: "memory");
    __syncthreads();
    if (threadIdx.x == 0) {
        unsigned* bar = b.bar;
        __builtin_amdgcn_s_waitcnt(0);
        unsigned nloc = b.st[0], nx = b.st[1];
        if (nloc == 0u) { xcd_barrier_complete(bar, b.x, nloc, nx); b.st[0] = nloc; b.st[1] = nx; }
        const unsigned old = xb_add(&bar[XB_XSUB(b.x)], 1u);
        const unsigned gen = old / nloc;
        if (old + 1u == (gen + 1u) * nloc) {
            __builtin_amdgcn_fence(__ATOMIC_RELEASE, "agent");
            asm volatile("s_waitcnt vmcnt(0)" ::: "memory");
            const unsigned og = xb_add(&bar[XB_TOP], 1u);
            const unsigned tg = og / nx;
            if (og + 1u == (tg + 1u) * nx) xb_add(&bar[XB_TOPGEN], 1u);
            else XB_SPIN(xb_ld(&bar[XB_TOPGEN]) == tg, bar);
            __builtin_amdgcn_fence(__ATOMIC_ACQUIRE, "agent");
            xb_add(&bar[XB_XGEN(b.x)], 1u);
            asm volatile("s_waitcnt vmcnt(0)" ::: "memory");
        } else {
            XB_SPIN(xb_ld(&bar[XB_XGEN(b.x)]) == gen, bar);
            __builtin_amdgcn_fence(__ATOMIC_ACQUIRE, "agent");
            asm volatile("s_waitcnt vmcnt(0)" ::: "memory");
        }
    }
    __syncthreads();
}

struct Args {
    const float* x; const float* mix_norm; const float* ffn_norm;
    const float* gm_w_in; const float* gm_b_in; const float* gm_v_norm; const float* gm_w_s; const float* gm_b_s; const float* gm_w_out; const float* gm_b_out;
    const float* at_w_qkv; const float* at_q_norm; const float* at_k_norm; const float* at_w_o;
    const float* moe_w_router; const float* moe_b_router; const float* moe_w1; const float* moe_w3; const float* moe_w2;
    float* out; unsigned char* ws; int ph_lo, ph_hi;
};

__device__ __forceinline__ float wave_sum(float v) {
#pragma unroll
    for (int o = 1; o < 64; o <<= 1) v += __shfl_xor(v, o);
    return v;
}

__device__ __forceinline__ void transpose_item(const float* __restrict__ W, int K, int N, bf16* WT, int k0, int n0, int drow0, LAS float* scr, int lane) {
#pragma unroll 8
    for (int i = 0; i < 32; ++i) { const int kk = 2 * i + (lane >> 5); scr[kk * 33 + (lane & 31)] = W[(size_t)(k0 + kk) * N + n0 + (lane & 31)]; }
    LDS_WAIT(); asm volatile("" ::: "memory");
    const int c = lane & 7;
#pragma unroll
    for (int j = 0; j < 4; ++j) { const int n = (lane >> 3) + 8 * j; const LAS float* s = scr + (8 * c) * 33 + n;
        v4u o; o.x = pk2(s[0 * 33], s[1 * 33]); o.y = pk2(s[2 * 33], s[3 * 33]); o.z = pk2(s[4 * 33], s[5 * 33]); o.w = pk2(s[6 * 33], s[7 * 33]);
        *(v4u*)(WT + (size_t)(drow0 + n) * K + k0 + 8 * c) = o; }
    LDS_WAIT(); asm volatile("" ::: "memory");
}

__device__ __forceinline__ void rms_row_to_bf16(const float* xrow, const float* gain, bf16* orow, int lane) {
    const f32x4* xr = (const f32x4*)xrow + lane; const f32x4* gr = (const f32x4*)gain + lane;
    f32x4 v[4]; float s = 0.f;
#pragma unroll
    for (int j = 0; j < 4; ++j) { v[j] = xr[64 * j]; s += (v[j].x * v[j].x + v[j].y * v[j].y) + (v[j].z * v[j].z + v[j].w * v[j].w); }
    const float rinv = 1.0f / sqrtf(wave_sum(s) * (1.f / D) + EPS);
    unsigned long long* o8 = (unsigned long long*)orow + lane;
#pragma unroll
    for (int j = 0; j < 4; ++j) { const f32x4 g = gr[64 * j]; const f32x4 y = v[j] * rinv * g;
        o8[64 * j] = (unsigned long long)pk2(y.x, y.y) | ((unsigned long long)pk2(y.z, y.w) << 32); }
}

__device__ __forceinline__ void prologue_phase(const Args& a, LAS unsigned char* lds) {
    int tid = threadIdx.x; asm volatile("" : "+v"(tid)); const int lane = tid & 63, wave = __builtin_amdgcn_readfirstlane(tid >> 6); (void)lane; (void)wave;
    LAS float* scr = (LAS float*)(lds + wave * 16384);
    const int gw = blockIdx.x * 8 + wave, NGW = gridDim.x * 8;
    unsigned char* ws = a.ws;
    constexpr int IT_MOE = 64 * 3 * 1024, NITEMS = IT_MOE + 6144 + 3072 + 4608 + 512;
    for (int it = gw; it < NITEMS; it += NGW) {
        const float* W; bf16* WT; int K, N, k0, n0, drow0;
        if (it < IT_MOE) {
            const int q = it >> 10, r = it & 1023, le = q / 3, which = q % 3;
            if (which < 2) { W = (which == 0 ? a.moe_w1 : a.moe_w3) + (size_t)le * 1024 * 2048; K = 1024; N = 2048; k0 = (r >> 6) * 64; n0 = (r & 63) * 32;
                drow0 = 256 * (n0 >> 7) + 128 * which + (n0 & 127); WT = (bf16*)(ws + WS_W13) + (size_t)le * 4096 * 1024; }
            else { W = a.moe_w2 + (size_t)le * 2048 * 1024; K = 2048; N = 1024; k0 = (r >> 5) * 64; n0 = (r & 31) * 32; drow0 = n0; WT = (bf16*)(ws + WS_W2) + (size_t)le * 1024 * 2048; }
        } else {
            int r = it - IT_MOE;
            if (r < 6144) { const int j = r / 3072, rr = r % 3072; W = a.gm_w_in + (size_t)j * 1024 * 6144; K = 1024; N = 6144; k0 = (rr / 192) * 64; n0 = (rr % 192) * 32; drow0 = n0; WT = (bf16*)(ws + WS_WIN) + (size_t)j * 6144 * 1024; }
            else if (r < 6144 + 3072) { r -= 6144; const int j = r / 1536, rr = r % 1536; W = a.gm_w_out + (size_t)j * 3072 * 1024; K = 3072; N = 1024; k0 = (rr >> 5) * 64; n0 = (rr & 31) * 32; drow0 = n0; WT = (bf16*)(ws + WS_WOUT) + (size_t)j * 1024 * 3072; }
            else if (r < 6144 + 3072 + 4608) { r -= 6144 + 3072; const int j = r / 2304, rr = r % 2304; W = a.at_w_qkv + (size_t)j * 1024 * 4608; K = 1024; N = 4608; k0 = (rr / 144) * 64; n0 = (rr % 144) * 32;
                const int tile = n0 >> 8, within = n0 & 255, wc = within >> 6, bj = (within & 63) >> 5; drow0 = tile * 256 + 128 * bj + 32 * wc; WT = (bf16*)(ws + WS_WQKV) + (size_t)j * 4608 * 1024; }
            else { r -= 6144 + 3072 + 4608; const int j = r >> 8, rr = r & 255; W = a.at_w_o + (size_t)j * 512 * 1024; K = 512; N = 1024; k0 = (rr >> 5) * 64; n0 = (rr & 31) * 32; drow0 = n0; WT = (bf16*)(ws + WS_WO) + (size_t)j * 1024 * 512; }
        }
        transpose_item(W, K, N, WT, k0, n0, drow0, scr, lane);
    }
    bf16* H = (bf16*)(ws + WS_H);
    for (int m = gw; m < T; m += NGW) rms_row_to_bf16(a.x + (size_t)m * D, a.mix_norm, H + (size_t)m * D, lane);
}

__device__ __forceinline__ void gating_phase(const Args& a, int j, LAS unsigned char* lds) {
    int tid = threadIdx.x; asm volatile("" : "+v"(tid)); const int lane = tid & 63, wave = __builtin_amdgcn_readfirstlane(tid >> 6); (void)lane; (void)wave;
    LAS unsigned short* Wl = (LAS unsigned short*)lds;
    LAS float* rinv = (LAS float*)(lds + 36864);
    const float* Ws = a.gm_w_s + (size_t)j * 8 * 128 * 128; const float* bs = a.gm_b_s + j * 8 * 128; const float* vg = a.gm_v_norm + j * GW;
    bf16* U = (bf16*)(a.ws + WS_U); const bf16* VT = (const bf16*)(a.ws + WS_VT); const float* SSQ = (const float*)(a.ws + WS_SSQ);
    const int fr = lane & 15, fq = lane >> 4;
    for (int unit = blockIdx.x; unit < 2048; unit += gridDim.x) {
        const int g = unit & 7, tok0 = (unit >> 3) * 128;
        __syncthreads();
        if (tid < 128) { float s = 0.f;
#pragma unroll
            for (int q = 0; q < 24; ++q) s += SSQ[(size_t)q * T + tok0 + tid];
            rinv[tid] = 1.0f / sqrtf(s * (1.0f / GW) + EPS); }
        __syncthreads();
#pragma unroll
        for (int i = 0; i < 8; ++i) { const int idx = (tid + 512 * i) * 4, t = idx >> 7, s0 = idx & 127;
            const f32x4 w = *(const f32x4*)(Ws + g * 16384 + idx); const f32x4 r4 = *(const LAS f32x4*)(rinv + s0);
            v2u o; o.x = pk2(w.x * r4.x, w.y * r4.y); o.y = pk2(w.z * r4.z, w.w * r4.w);
            *(LAS v2u*)(Wl + t * 136 + s0) = o; }
        __syncthreads();
        bf16x8 vf[3][4];
#pragma unroll
        for (int n = 0; n < 3; ++n)
#pragma unroll
            for (int ks = 0; ks < 4; ++ks) vf[n][ks] = *(const bf16x8*)(VT + (size_t)(g * 384 + 48 * wave + 16 * n + fr) * T + tok0 + 32 * ks + 8 * fq);
        f32x4 acc[8][3];
#pragma unroll
        for (int m = 0; m < 8; ++m)
#pragma unroll
            for (int n = 0; n < 3; ++n) acc[m][n] = (f32x4){0.f, 0.f, 0.f, 0.f};
#pragma unroll
        for (int ks = 0; ks < 4; ++ks)
#pragma unroll
            for (int m = 0; m < 8; ++m) { const bf16x8 wf = *(const LAS bf16x8*)(Wl + (16 * m + fr) * 136 + 32 * ks + 8 * fq);
#pragma unroll
                for (int n = 0; n < 3; ++n) acc[m][n] = __builtin_amdgcn_mfma_f32_16x16x32_bf16(vf[n][ks], wf, acc[m][n], 0, 0, 0); }
#pragma unroll
        for (int n = 0; n < 3; ++n) { const int e0 = g * 384 + 48 * wave + 16 * n + 4 * fq; const f32x4 gn = *(const f32x4*)(vg + e0);
#pragma unroll
            for (int m = 0; m < 8; ++m) { const int t = 16 * m + fr; const float bt = bs[g * 128 + t];
                v2u* ptr = (v2u*)(U + (size_t)(tok0 + t) * GW + e0); const v2u uu = *ptr;
                const f32x4 o = acc[m][n] * gn + bt;
                v2u w; w.x = pk2(o.x * bf_lo(uu.x), o.y * bf_hi(uu.x)); w.y = pk2(o.z * bf_lo(uu.y), o.w * bf_hi(uu.y));
                *ptr = w; } }
    }
}

__device__ __forceinline__ void attn_naive_phase(const Args& a) {
    int tid = threadIdx.x; asm volatile("" : "+v"(tid)); const int lane = tid & 63, wave = __builtin_amdgcn_readfirstlane(tid >> 6); (void)lane; (void)wave;
    const bf16* QKV = (const bf16*)(a.ws + WS_QKV); bf16* O = (bf16*)(a.ws + WS_O);
    const int nthr = gridDim.x * 512;
    for (int item = blockIdx.x * 512 + tid; item < T * 8; item += nthr) {
        const int s = item & 4095, h = (item >> 12) & 7, b = item >> 15;
        const float slope = exp2f(-(float)(h + 1));
        float mx = -1e30f, l = 0.f; float o[64];
#pragma unroll
        for (int d = 0; d < 64; ++d) o[d] = 0.f;
        for (int g = 0; g < 3; ++g) {
            const int dil = 1 << (2 * g);
            const size_t hb = (((size_t)g * 8 + b) * 8 + h) * 4096 * 64;
            const bf16* qrow = QKV + hb + (size_t)s * 64;
            const bf16* kb = QKV + (size_t)3 * 8 * 8 * 4096 * 64 + hb; const bf16* vb = QKV + (size_t)6 * 8 * 8 * 4096 * 64 + hb;
            v4u qv[8];
#pragma unroll
            for (int c = 0; c < 8; ++c) qv[c] = *(const v4u*)(qrow + 8 * c);
            for (int oo = -64; oo <= 64; ++oo) {
                const int kp = s + dil * oo; if (kp < 0 || kp >= 4096) continue;
                float dot = 0.f;
#pragma unroll
                for (int c = 0; c < 8; ++c) { const v4u kv = *(const v4u*)(kb + (size_t)kp * 64 + 8 * c);
                    dot += bf_lo(qv[c].x) * bf_lo(kv.x) + bf_hi(qv[c].x) * bf_hi(kv.x) + bf_lo(qv[c].y) * bf_lo(kv.y) + bf_hi(qv[c].y) * bf_hi(kv.y)
                         + bf_lo(qv[c].z) * bf_lo(kv.z) + bf_hi(qv[c].z) * bf_hi(kv.z) + bf_lo(qv[c].w) * bf_lo(kv.w) + bf_hi(qv[c].w) * bf_hi(kv.w); }
                const float sc = dot - slope * (float)(dil * (oo < 0 ? -oo : oo));
                const float mn = fmaxf(mx, sc), corr = __expf(mx - mn), p = __expf(sc - mn);
                l = l * corr + p; mx = mn;
#pragma unroll
                for (int c = 0; c < 8; ++c) { const v4u vv = *(const v4u*)(vb + (size_t)kp * 64 + 8 * c);
                    o[8 * c + 0] = o[8 * c + 0] * corr + p * bf_lo(vv.x); o[8 * c + 1] = o[8 * c + 1] * corr + p * bf_hi(vv.x);
                    o[8 * c + 2] = o[8 * c + 2] * corr + p * bf_lo(vv.y); o[8 * c + 3] = o[8 * c + 3] * corr + p * bf_hi(vv.y);
                    o[8 * c + 4] = o[8 * c + 4] * corr + p * bf_lo(vv.z); o[8 * c + 5] = o[8 * c + 5] * corr + p * bf_hi(vv.z);
                    o[8 * c + 6] = o[8 * c + 6] * corr + p * bf_lo(vv.w); o[8 * c + 7] = o[8 * c + 7] * corr + p * bf_hi(vv.w); }
            }
        }
        const float il = 1.0f / l;
        bf16* orow = O + (size_t)(b * 4096 + s) * AW + h * 64;
#pragma unroll
        for (int c = 0; c < 8; ++c) { v4u w; w.x = pk2(o[8 * c] * il, o[8 * c + 1] * il); w.y = pk2(o[8 * c + 2] * il, o[8 * c + 3] * il);
            w.z = pk2(o[8 * c + 4] * il, o[8 * c + 5] * il); w.w = pk2(o[8 * c + 6] * il, o[8 * c + 7] * il); *(v4u*)(orow + 8 * c) = w; }
    }
}

__device__ __forceinline__ void router_phase(const Args& a, int layer, LAS unsigned char* lds) {
    int tid = threadIdx.x; asm volatile("" : "+v"(tid)); const int lane = tid & 63, wave = __builtin_amdgcn_readfirstlane(tid >> 6); (void)lane; (void)wave;
    LAS float* wr = (LAS float*)lds;
    const float* Wr = a.moe_w_router + (size_t)layer * D * NE; const float* br = a.moe_b_router + layer * NE; const float* gain = a.ffn_norm + layer * D;
    __syncthreads();
    for (int i = tid; i < D * NE; i += 512) { const int d = i >> 4, e = i & 15; wr[e * 1024 + d] = Wr[i]; }
    __syncthreads();
    bf16* H = (bf16*)(a.ws + WS_H); float* AFF = (float*)(a.ws + WS_AFF);
    const int gw = blockIdx.x * 8 + wave, NGW = gridDim.x * 8;
    for (int row = gw; row < T; row += NGW) {
        const f32x4* xr = (const f32x4*)(a.out + (size_t)row * D) + lane; const f32x4* gr = (const f32x4*)gain + lane;
        f32x4 v[4]; float s = 0.f;
#pragma unroll
        for (int j = 0; j < 4; ++j) { v[j] = xr[64 * j]; s += (v[j].x * v[j].x + v[j].y * v[j].y) + (v[j].z * v[j].z + v[j].w * v[j].w); }
        const float rinv = 1.0f / sqrtf(wave_sum(s) * (1.f / D) + EPS);
        unsigned long long* o8 = (unsigned long long*)(H + (size_t)row * D) + lane;
#pragma unroll
        for (int j = 0; j < 4; ++j) { v[j] = v[j] * rinv * gr[64 * j];
            o8[64 * j] = (unsigned long long)pk2(v[j].x, v[j].y) | ((unsigned long long)pk2(v[j].z, v[j].w) << 32); }
        float mine = 0.f;
#pragma unroll 1
        for (int e = 0; e < 16; ++e) { float acc = 0.f;
#pragma unroll
            for (int j = 0; j < 4; ++j) { const f32x4 w = *(const LAS f32x4*)(wr + e * 1024 + 256 * j + 4 * lane); acc += (v[j].x * w.x + v[j].y * w.y) + (v[j].z * w.z + v[j].w * w.w); }
            const float lg = wave_sum(acc) + br[e]; mine = (lane == e) ? lg : mine; }
        float mx = mine;
#pragma unroll
        for (int o = 1; o < 16; o <<= 1) mx = fmaxf(mx, __shfl_xor(mx, o));
        mine = __expf(mine - mx);
        float den = mine;
#pragma unroll
        for (int o = 1; o < 16; o <<= 1) den += __shfl_xor(den, o);
        const float iden = 1.0f / den;
        if (lane < 16) AFF[((size_t)(row >> 12) * 16 + lane) * 4096 + (row & 4095)] = mine * iden;
    }
}

__device__ __forceinline__ void topk_phase(const Args& a, LAS unsigned char* lds) {
    int tid = threadIdx.x; asm volatile("" : "+v"(tid)); const int lane = tid & 63, wave = __builtin_amdgcn_readfirstlane(tid >> 6); (void)lane; (void)wave;
    LAS unsigned* hist = (LAS unsigned*)lds;
    LAS unsigned* sh = hist + 256;
    LAS unsigned* wtot = hist + 272;
    const float* AFF = (const float*)(a.ws + WS_AFF); int* SMAP = (int*)(a.ws + WS_SMAP); int* TOK = (int*)(a.ws + WS_TOK); float* GATE = (float*)(a.ws + WS_GATE);
    for (int prob = blockIdx.x; prob < NB * NE; prob += gridDim.x) {
        const int b = prob >> 4, e = prob & 15;
        const v4u* src = (const v4u*)(AFF + (size_t)prob * 4096) + 2 * tid;
        const v4u k0 = src[0], k1 = src[1];
        unsigned key[8] = {k0.x, k0.y, k0.z, k0.w, k1.x, k1.y, k1.z, k1.w};
        unsigned prefix = 0u, kk = CAP;
#pragma unroll
        for (int pass = 0; pass < 4; ++pass) {
            const int shift = 24 - 8 * pass; const unsigned mhi = pass == 0 ? 0u : (0xFFFFFFFFu << (shift + 8));
            __syncthreads();
            if (tid < 256) hist[tid] = 0u;
            __syncthreads();
#pragma unroll
            for (int i = 0; i < 8; ++i) if ((key[i] & mhi) == prefix) __hip_atomic_fetch_add(&hist[(key[i] >> shift) & 255u], 1u, __ATOMIC_RELAXED, __HIP_MEMORY_SCOPE_WORKGROUP);
            __syncthreads();
            if (wave == 0) {
                const unsigned c0 = hist[4 * lane], c1 = hist[4 * lane + 1], c2 = hist[4 * lane + 2], c3 = hist[4 * lane + 3];
                const unsigned tot = c0 + c1 + c2 + c3;
                unsigned suf = tot;
#pragma unroll
                for (int o = 1; o < 64; o <<= 1) { const unsigned t = __shfl_down(suf, o); if (lane + o < 64) suf += t; }
                unsigned gt = suf - tot;
                if (gt < kk && kk <= gt + c3) { sh[0] = 4 * lane + 3; sh[1] = kk - gt; } gt += c3;
                if (gt < kk && kk <= gt + c2) { sh[0] = 4 * lane + 2; sh[1] = kk - gt; } gt += c2;
                if (gt < kk && kk <= gt + c1) { sh[0] = 4 * lane + 1; sh[1] = kk - gt; } gt += c1;
                if (gt < kk && kk <= gt + c0) { sh[0] = 4 * lane + 0; sh[1] = kk - gt; }
            }
            __syncthreads();
            prefix |= sh[0] << shift; kk = sh[1];
        }
        unsigned cg = 0u, ce = 0u;
#pragma unroll
        for (int i = 0; i < 8; ++i) { cg += key[i] > prefix ? 1u : 0u; ce += key[i] == prefix ? 1u : 0u; }
        const unsigned mine = cg | (ce << 16);
        unsigned inc = mine;
#pragma unroll
        for (int o = 1; o < 64; o <<= 1) { const unsigned t = __shfl_up(inc, o); if (lane >= o) inc += t; }
        __syncthreads();
        if (lane == 63) wtot[wave] = inc;
        __syncthreads();
        unsigned base = 0u;
#pragma unroll
        for (int w = 0; w < 8; ++w) base += (w < wave) ? wtot[w] : 0u;
        const unsigned exc = base + inc - mine;
        unsigned gb = exc & 0xffffu, eb = exc >> 16;
        const int srow0 = (e * 8 + b) * CAP;
#pragma unroll
        for (int i = 0; i < 8; ++i) { const int s = 8 * tid + i; int slot = -1;
            if (key[i] > prefix) { slot = (int)(gb + (eb < kk ? eb : kk)); gb++; }
            else if (key[i] == prefix) { if (eb < kk) slot = (int)(gb + eb); eb++; }
            int sr = -1;
            if (slot >= 0) { sr = srow0 + slot; TOK[sr] = b * 4096 + s; GATE[sr] = __builtin_bit_cast(float, key[i]); }
            SMAP[(size_t)prob * 4096 + s] = sr; }
    }
}

__device__ __forceinline__ void gather_phase(const Args& a) {
    int tid = threadIdx.x; asm volatile("" : "+v"(tid)); const int lane = tid & 63, wave = __builtin_amdgcn_readfirstlane(tid >> 6); (void)lane; (void)wave;
    const bf16* H = (const bf16*)(a.ws + WS_H); bf16* XIN = (bf16*)(a.ws + WS_XIN); const int* TOK = (const int*)(a.ws + WS_TOK);
    const int gw = blockIdx.x * 8 + wave, NGW = gridDim.x * 8;
    for (int r = gw; r < NSLOT; r += NGW) { const int tok = TOK[r];
        const v4u* s = (const v4u*)(H + (size_t)tok * D) + lane; v4u* d = (v4u*)(XIN + (size_t)r * D) + lane;
        const v4u x0 = s[0], x1 = s[64]; d[0] = x0; d[64] = x1; }
}

__device__ __forceinline__ void combine_phase(const Args& a, int layer) {
    int tid = threadIdx.x; asm volatile("" : "+v"(tid)); const int lane = tid & 63, wave = __builtin_amdgcn_readfirstlane(tid >> 6); (void)lane; (void)wave;
    const bf16* Y = (const bf16*)(a.ws + WS_Y); const int* SMAP = (const int*)(a.ws + WS_SMAP); bf16* H = (bf16*)(a.ws + WS_H);
    const int gw = blockIdx.x * 8 + wave, NGW = gridDim.x * 8;
    for (int row = gw; row < T; row += NGW) {
        const int b = row >> 12, s = row & 4095;
        f32x4* xr = (f32x4*)(a.out + (size_t)row * D) + lane;
        f32x4 v[4];
#pragma unroll
        for (int j = 0; j < 4; ++j) v[j] = xr[64 * j];
#pragma unroll 4
        for (int e = 0; e < 16; ++e) { const int sr = __builtin_amdgcn_readfirstlane(SMAP[((size_t)b * 16 + e) * 4096 + s]);
            if (sr >= 0) { const v2u* yr = (const v2u*)(Y + (size_t)sr * D) + lane;
#pragma unroll
                for (int j = 0; j < 4; ++j) { const v2u y = yr[64 * j]; v[j].x += bf_lo(y.x); v[j].y += bf_hi(y.x); v[j].z += bf_lo(y.y); v[j].w += bf_hi(y.y); } } }
#pragma unroll
        for (int j = 0; j < 4; ++j) xr[64 * j] = v[j];
        if (layer < 3) {
            const f32x4* gr = (const f32x4*)(a.mix_norm + (layer + 1) * D) + lane; float ss = 0.f;
#pragma unroll
            for (int j = 0; j < 4; ++j) ss += (v[j].x * v[j].x + v[j].y * v[j].y) + (v[j].z * v[j].z + v[j].w * v[j].w);
            const float rinv = 1.0f / sqrtf(wave_sum(ss) * (1.f / D) + EPS);
            unsigned long long* o8 = (unsigned long long*)(H + (size_t)row * D) + lane;
#pragma unroll
            for (int j = 0; j < 4; ++j) { const f32x4 y = v[j] * rinv * gr[64 * j]; o8[64 * j] = (unsigned long long)pk2(y.x, y.y) | ((unsigned long long)pk2(y.z, y.w) << 32); }
        }
    }
}

constexpr int N_PHASES = 1 + 4 * 9;
__global__ void __launch_bounds__(512, 2) mega_fwd(Args a) {
    extern __shared__ __attribute__((aligned(16))) unsigned char lds_raw[];
    LAS unsigned char* lds = (LAS unsigned char*)lds_raw;
    const int tid = threadIdx.x, lane = tid & 63, wave = __builtin_amdgcn_readfirstlane(tid >> 6);
    const int G = gridDim.x, bid = blockIdx.x;
    unsigned char* ws = a.ws;
    volatile LAS unsigned* MISC = (volatile LAS unsigned*)(lds + LDSCTL_OFF);
    if (tid < 64) MISC[tid] = 0u;
    __syncthreads();
#if !MK_MULTI
    XcdBarrier bar = xcd_barrier_post((unsigned*)(ws + WS_CTL) + CW_BAR, MISC + 8);
#define GRID_BAR() xcd_barrier(bar)
#else
#define GRID_BAR() do {} while (0)
#endif
    const int lo = a.ph_lo, hi = a.ph_hi;
#ifndef PH_EN
#define PH_EN 0x1fff
#endif
#define EN(b) ((PH_EN >> (b)) & 1)
#define IN(k) (lo <= (k) && (k) < hi)
#define SEAM(k) do { if (IN((k) + 1)) GRID_BAR(); } while (0)
    bf16* H = (bf16*)(ws + WS_H);

    if (EN(12) && IN(0)) { prologue_phase(a, lds); SEAM(0); }

#pragma unroll
    for (int layer = 0; layer < 4; ++layer) {
        const int pb = 1 + 9 * layer, j = layer >> 1;
        const float* xbase = layer == 0 ? a.x : a.out;
        if ((layer & 1) == 0) {
            if (EN(0) && IN(pb + 0)) {
                { pg8::Gemm g{H, (const bf16*)(ws + WS_WIN) + (size_t)j * 6144 * 1024, T, GW, D}; pg8::StaticOrder S; S.init(T, GW, G, bid);
                  pg8::EpiGeluBf16 E{(bf16*)(ws + WS_U), GW, a.gm_b_in + j * 6144};
                  pg8::gemm_phase<pg8::EpiGeluBf16, pg8::StaticOrder, true, true>(lds, g, S, E); }
                { pg8::Gemm g{(const bf16*)(ws + WS_WIN) + (size_t)j * 6144 * 1024 + (size_t)GW * 1024, H, GW, T, D}; pg8::StaticOrder S; S.init(GW, T, G, bid);
                  pg8::EpiVT E{(bf16*)(ws + WS_VT), T, a.gm_b_in + j * 6144 + GW, (float*)(ws + WS_SSQ)};
                  pg8::gemm_phase<pg8::EpiVT, pg8::StaticOrder, true, true>(lds, g, S, E); }
                SEAM(pb + 0);
            }
            if (EN(1) && IN(pb + 1)) { gating_phase(a, j, lds); SEAM(pb + 1); }
            if (EN(2) && IN(pb + 2)) {
                pg8::Gemm g{(const bf16*)(ws + WS_U), (const bf16*)(ws + WS_WOUT) + (size_t)j * 1024 * 3072, T, D, GW}; pg8::StaticOrder S; S.init(T, D, G, bid);
                pg8::EpiResid E{xbase, a.out, D, a.gm_b_out + j * D};
                pg8::gemm_phase<pg8::EpiResid, pg8::StaticOrder, true, true>(lds, g, S, E);
                SEAM(pb + 2);
            }
        } else {
            if (EN(3) && IN(pb + 0)) {
                pg8::Gemm g{H, (const bf16*)(ws + WS_WQKV) + (size_t)j * QKVW * 1024, T, QKVW, D}; pg8::StaticOrder S; S.init(T, QKVW, G, bid);
                pg8::EpiQKV E{(bf16*)(ws + WS_QKV), a.at_q_norm + j * 192, a.at_k_norm + j * 192};
                pg8::gemm_phase<pg8::EpiQKV, pg8::StaticOrder, true, true>(lds, g, S, E);
                SEAM(pb + 0);
            }
            if (EN(4) && IN(pb + 1)) { attn_naive_phase(a); SEAM(pb + 1); }
            if (EN(5) && IN(pb + 2)) {
                pg8::Gemm g{(const bf16*)(ws + WS_O), (const bf16*)(ws + WS_WO) + (size_t)j * 1024 * 512, T, D, AW}; pg8::StaticOrder S; S.init(T, D, G, bid);
                pg8::EpiResid E{xbase, a.out, D, nullptr};
                pg8::gemm_phase<pg8::EpiResid, pg8::StaticOrder, true, true>(lds, g, S, E);
                SEAM(pb + 2);
            }
        }
        if (EN(6) && IN(pb + 3)) { router_phase(a, layer, lds); SEAM(pb + 3); }
        if (EN(7) && IN(pb + 4)) { topk_phase(a, lds); SEAM(pb + 4); }
        if (EN(8) && IN(pb + 5)) { gather_phase(a); SEAM(pb + 5); }
        if (EN(9) && IN(pb + 6)) {
            pg8::Gemm g{(const bf16*)(ws + WS_XIN), (const bf16*)(ws + WS_W13) + (size_t)layer * 16 * 4096 * 1024, NSLOT, 16 * 4096, D}; pg8::MoeOrder1 S{G, bid};
            pg8::EpiSwiGLU E{(bf16*)(ws + WS_HID)};
            pg8::gemm_phase<pg8::EpiSwiGLU, pg8::MoeOrder1, true, true>(lds, g, S, E);
            SEAM(pb + 6);
        }
        if (EN(10) && IN(pb + 7)) {
            pg8::Gemm g{(const bf16*)(ws + WS_HID), (const bf16*)(ws + WS_W2) + (size_t)layer * 16 * 1024 * 2048, NSLOT, 16 * 1024, DE}; pg8::MoeOrder2 S{G, bid};
            pg8::EpiGate E{(bf16*)(ws + WS_Y), (const float*)(ws + WS_GATE)};
            pg8::gemm_phase<pg8::EpiGate, pg8::MoeOrder2, true, true>(lds, g, S, E);
            SEAM(pb + 7);
        }
        if (EN(11) && IN(pb + 8)) { combine_phase(a, layer); if (layer < 3) SEAM(pb + 8); }
    }
#undef IN
#undef SEAM
}

extern "C" void kernel_launch(void* const* d_in, const int* in_sizes, int n_in, void* d_out, int out_size, void* d_ws, size_t ws_size, hipStream_t stream) {
    static int grid = 0;
    if (grid == 0) {
        if (n_in != 19 || out_size != T * D || ws_size < WS_END) { fprintf(stderr, "kernel_launch: unexpected shapes (n_in %d, out %d, ws %zu < %zu)\n", n_in, out_size, ws_size, (size_t)WS_END); grid = -1; return; }
        int dev = 0, cus = 0, per_cu = 0;
        if (hipGetDevice(&dev) != hipSuccess || hipDeviceGetAttribute(&cus, hipDeviceAttributeMultiprocessorCount, dev) != hipSuccess) { grid = -1; return; }
        if (hipFuncSetAttribute((const void*)mega_fwd, hipFuncAttributeMaxDynamicSharedMemorySize, LDS_BYTES) != hipSuccess) { fprintf(stderr, "kernel_launch: hipFuncSetAttribute failed\n"); grid = -1; return; }
        if (hipOccupancyMaxActiveBlocksPerMultiprocessor(&per_cu, (const void*)mega_fwd, 512, LDS_BYTES) != hipSuccess || per_cu < 1) { fprintf(stderr, "kernel_launch: occupancy query says %d\n", per_cu); }
        (void)hipGetLastError();
        grid = cus;
    }
    if (grid < 0) return;
    (void)hipMemsetAsync((char*)d_ws + WS_CTL, 0, CTL_ZERO_BYTES, stream);
    Args a{};
    const float** ap = (const float**)&a;
    for (int i = 0; i < 19; ++i) ap[i] = (const float*)d_in[i];
    a.out = (float*)d_out; a.ws = (unsigned char*)d_ws;
#if MK_MULTI
    for (int p = 0; p < N_PHASES; ++p) { a.ph_lo = p; a.ph_hi = p + 1; hipLaunchKernelGGL(mega_fwd, dim3(grid), dim3(512), LDS_BYTES, stream, a); }
#else
    a.ph_lo = 0; a.ph_hi = N_PHASES;
    hipLaunchKernelGGL(mega_fwd, dim3(grid), dim3(512), LDS_BYTES, stream, a);
#endif
}
```

```cpp
#include <hip/hip_runtime.h>
#include <cstdio>
#include <cstdint>

#ifndef MK_MULTI
#define MK_MULTI 0
#endif

namespace pg8 {
#define PG8_LAS __attribute__((address_space(3)))
typedef unsigned short bf16_t;
typedef short bf16x8 __attribute__((ext_vector_type(8)));
typedef float f32x4 __attribute__((ext_vector_type(4)));
typedef float f32x2 __attribute__((ext_vector_type(2)));
typedef unsigned u32x4 __attribute__((ext_vector_type(4)));
typedef unsigned u32x2 __attribute__((ext_vector_type(2)));
constexpr int BM = 256, BK = 64, HALF = 128, HTB = HALF * BK * 2, STAGE_BYTES = 8 * HTB, NXCD = 8, WGM = 8;

__host__ __device__ __forceinline__ int lds_byte(int r, int c) { const int st = (r >> 4) * 2 + (c >> 5), rr = r & 15, cc = c & 31, ob = rr * 64 + cc * 2; return st * 1024 + (ob ^ (((ob >> 9) & 1) << 5)); }
__host__ __device__ __forceinline__ void stage_rc(int b, int& R, int& C) { const int st = b / 1024, sb = b % 1024, swz = sb ^ (((sb >> 9) & 1) << 5); R = (st >> 1) * 16 + swz / 64; C = (st & 1) * 32 + (swz % 64) / 2; }
__host__ __device__ __forceinline__ int perm32(int rho) { const int n = rho >> 4, i = rho & 15; return 8 * (i >> 2) + 4 * n + (i & 3); }

struct Unit { int pm, pn; };
struct Gemm { const bf16_t* A; const bf16_t* Bt; int M, N, K; };

struct StaticOrder {
    int nM, nN, nwg, G, c;
    __host__ __device__ void init(int M, int N, int G_, int c_) { nM = M / BM; nN = N / BM; nwg = nM * nN; G = G_; c = c_; }
    __host__ __device__ bool next(int i, Unit& u) const {
        const long L = (long)i * G + c; if (L >= nwg) return false;
        int wgid = (int)L; { const int q = nwg / NXCD, r = nwg % NXCD, xcd = wgid % NXCD, off = wgid / NXCD; wgid = (xcd < r ? xcd * (q + 1) : r * (q + 1) + (xcd - r) * q) + off; }
        const int nig = WGM * nN, gid = wgid / nig, fm = gid * WGM, gsz = (nM - fm) < WGM ? (nM - fm) : WGM;
        u.pm = fm + ((wgid % nig) % gsz); u.pn = (wgid % nig) / gsz; return true;
    }
    __device__ __forceinline__ void a_ready(const Unit&) const {}
    __device__ __forceinline__ void done(const Unit&) const {}
};
struct MoeOrder1 {
    int G, c;
    __device__ bool next(int i, Unit& u) const {
        const int L = i * G + c; if (L >= 4096) return false;
        const int e = L >> 8, w = L & 255, x = w & 7, off = w >> 3;
        u.pm = e * 16 + 4 * (x >> 1) + (off & 3); u.pn = e * 16 + 8 * (x & 1) + (off >> 2); return true;
    }
    __device__ __forceinline__ void a_ready(const Unit&) const {}
    __device__ __forceinline__ void done(const Unit&) const {}
};
struct MoeOrder2 {
    int G, c;
    __device__ bool next(int i, Unit& u) const {
        const int L = i * G + c; if (L >= 1024) return false;
        const int r = L >> 8, w0 = L & 255, wg = (w0 & 7) * 32 + (w0 >> 3), e = r * 4 + (wg >> 6), w = wg & 63;
        u.pm = e * 16 + (w >> 2); u.pn = e * 4 + (w & 3); return true;
    }
    __device__ __forceinline__ void a_ready(const Unit&) const {}
    __device__ __forceinline__ void done(const Unit&) const {}
};

typedef __bf16 bf16x2_v __attribute__((ext_vector_type(2)));
__device__ __forceinline__ unsigned cvt_pk_bf16(float lo, float hi) { const f32x2 v = {lo, hi}; return __builtin_bit_cast(unsigned, __builtin_convertvector(v, bf16x2_v)); }
__device__ __forceinline__ float gelu_tanh(float x) {
    const float t = x * (1.0f + 0.044715f * x * x);
    const float e = __builtin_amdgcn_exp2f(t * (-2.0f * 0.7978845608f * 1.4426950409f));
    return x * __builtin_amdgcn_rcpf(1.0f + e);
}
__device__ __forceinline__ float silu_f(float a) { return a * __builtin_amdgcn_rcpf(1.0f + __builtin_amdgcn_exp2f(a * -1.4426950409f)); }

template <int CTRL> __device__ __forceinline__ float dpp_f(float v) { return __builtin_bit_cast(float, __builtin_amdgcn_update_dpp(0, __builtin_bit_cast(int, v), CTRL, 0xF, 0xF, true)); }
__device__ __forceinline__ float row16_sum(float v) { v += dpp_f<0xB1>(v); v += dpp_f<0x4E>(v); v += dpp_f<0x141>(v); v += dpp_f<0x140>(v); return v; }
__device__ __forceinline__ float xrow_sum(float v) {
    { auto rr = __builtin_amdgcn_permlane16_swap(__float_as_uint(v), __float_as_uint(v), false, false); v = __uint_as_float(rr[0]) + __uint_as_float(rr[1]); }
    { auto rr = __builtin_amdgcn_permlane32_swap(__float_as_uint(v), __float_as_uint(v), false, false); v = __uint_as_float(rr[0]) + __uint_as_float(rr[1]); }
    return v; }
template <class V4> __device__ __forceinline__ void xchg_rows(const V4& p0, const V4& p1, V4& s1, V4& s2) {
    const u32x4 a = __builtin_bit_cast(u32x4, p0), b = __builtin_bit_cast(u32x4, p1); u32x4 x, y;
#pragma unroll
    for (int k = 0; k < 4; ++k) { x[k] = (unsigned)__builtin_amdgcn_update_dpp((int)a[k], (int)b[k], 0x128, 0xF, 0xC, false);
                                  y[k] = (unsigned)__builtin_amdgcn_update_dpp((int)b[k], (int)a[k], 0x128, 0xF, 0x3, false); }
    s1 = __builtin_bit_cast(V4, x); s2 = __builtin_bit_cast(V4, y);
}
struct EpiGeluBf16 {
    static constexpr bool PERM = true, AFTER_DRAIN = false;
    bf16_t* O; int ldc; const float* bias;
    __device__ __forceinline__ void operator()(const f32x4 (&acc)[2][2][4][2], const Unit& u, int wr, int wc, int fr, int fq) const {
        const int rowb = u.pm * BM + wr * 64, colw = u.pn * BM + wc * 64;
        f32x4 bv[2][2];
#pragma unroll
        for (int bj = 0; bj < 2; ++bj)
#pragma unroll
            for (int n = 0; n < 2; ++n) bv[bj][n] = *(const f32x4*)(bias + colw + 32 * bj + 8 * fq + 4 * n);
        bf16_t* ob = O + (size_t)(rowb + (fr & 7)) * ldc + colw + (fr >> 3) * 32 + 8 * fq;
#pragma unroll
        for (int ai = 0; ai < 2; ++ai)
#pragma unroll
            for (int m = 0; m < 4; ++m) { u32x4 w[2];
#pragma unroll
                for (int bj = 0; bj < 2; ++bj) { const f32x4 v0 = acc[ai][bj][m][0] + bv[bj][0], v1 = acc[ai][bj][m][1] + bv[bj][1];
                    w[bj].x = cvt_pk_bf16(gelu_tanh(v0[0]), gelu_tanh(v0[1])); w[bj].y = cvt_pk_bf16(gelu_tanh(v0[2]), gelu_tanh(v0[3]));
                    w[bj].z = cvt_pk_bf16(gelu_tanh(v1[0]), gelu_tanh(v1[1])); w[bj].w = cvt_pk_bf16(gelu_tanh(v1[2]), gelu_tanh(v1[3])); }
                u32x4 s1, s2; xchg_rows(w[0], w[1], s1, s2);
                bf16_t* rp = ob + (size_t)(ai * HALF + m * 16) * ldc;
                *(u32x4*)rp = s1; *(u32x4*)(rp + (size_t)8 * ldc) = s2; }
    }
};
struct EpiVT {
    static constexpr bool PERM = true, AFTER_DRAIN = false;
    bf16_t* VT; int ldc; const float* bias; float* ssq;
    __device__ __forceinline__ void operator()(const f32x4 (&acc)[2][2][4][2], const Unit& u, int wr, int wc, int fr, int fq) const {
        const int rowb = u.pm * BM + wr * 64, colw = u.pn * BM + wc * 64;
        f32x4 cs[2][2];
#pragma unroll
        for (int bj = 0; bj < 2; ++bj)
#pragma unroll
            for (int n = 0; n < 2; ++n) cs[bj][n] = (f32x4){0.f, 0.f, 0.f, 0.f};
        bf16_t* ob = VT + ((size_t)(2 * u.pn + (wc >> 1)) * 3072 + rowb + (fr & 7)) * 128 + (wc & 1) * 64 + (fr >> 3) * 32 + 8 * fq;
#pragma unroll
        for (int ai = 0; ai < 2; ++ai)
#pragma unroll
            for (int m = 0; m < 4; ++m) { const int e = rowb + fr + ai * HALF + m * 16; const float b = bias[e]; u32x4 w[2];
#pragma unroll
                for (int bj = 0; bj < 2; ++bj) { f32x4 v0 = acc[ai][bj][m][0] + b, v1 = acc[ai][bj][m][1] + b;
#pragma unroll
                    for (int j = 0; j < 4; ++j) { v0[j] = gelu_tanh(v0[j]); v1[j] = gelu_tanh(v1[j]); }
                    cs[bj][0] += v0 * v0; cs[bj][1] += v1 * v1;
                    w[bj].x = cvt_pk_bf16(v0[0], v0[1]); w[bj].y = cvt_pk_bf16(v0[2], v0[3]); w[bj].z = cvt_pk_bf16(v1[0], v1[1]); w[bj].w = cvt_pk_bf16(v1[2], v1[3]); }
                u32x4 s1, s2; xchg_rows(w[0], w[1], s1, s2);
                bf16_t* rp = ob + (size_t)(ai * HALF + m * 16) * 128;
                *(u32x4*)rp = s1; *(u32x4*)(rp + 8 * 128) = s2; }
#pragma unroll
        for (int bj = 0; bj < 2; ++bj)
#pragma unroll
            for (int n = 0; n < 2; ++n)
#pragma unroll
                for (int j = 0; j < 4; ++j) cs[bj][n][j] = row16_sum(cs[bj][n][j]);
        if (fr == 0) {
            float* sp = ssq + (size_t)(2 * u.pm + wr) * ldc + colw + 8 * fq;
#pragma unroll
            for (int bj = 0; bj < 2; ++bj)
#pragma unroll
                for (int n = 0; n < 2; ++n) *(f32x4*)(sp + 32 * bj + 4 * n) = cs[bj][n];
        }
    }
};
struct EpiResid {
    static constexpr bool PERM = false, AFTER_DRAIN = false;
    const float* base; float* out; int ldc; const float* bias;
    __device__ __forceinline__ void operator()(const f32x4 (&acc)[2][2][4][2], const Unit& u, int wr, int wc, int fr, int fq) const {
        const int rowb = u.pm * BM + wr * 64, colw = u.pn * BM + wc * 64;
        const int cS = colw + (fr >> 3) * 16 + 4 * fq;
        f32x4 bv[2];
#pragma unroll
        for (int bj = 0; bj < 2; ++bj) bv[bj] = bias ? *(const f32x4*)(bias + cS + 32 * bj) : (f32x4){0.f, 0.f, 0.f, 0.f};
#pragma unroll
        for (int ai = 0; ai < 2; ++ai)
#pragma unroll
            for (int m = 0; m < 4; ++m) { const size_t off = (size_t)(rowb + ai * HALF + m * 16 + (fr & 7)) * ldc + cS;
#pragma unroll
                for (int bj = 0; bj < 2; ++bj) { f32x4 s1, s2; xchg_rows(acc[ai][bj][m][0], acc[ai][bj][m][1], s1, s2);
                    const f32x4 b1 = *(const f32x4*)(base + off + 32 * bj), b2 = *(const f32x4*)(base + off + (size_t)8 * ldc + 32 * bj);
                    *(f32x4*)(out + off + 32 * bj) = b1 + s1 + bv[bj]; *(f32x4*)(out + off + (size_t)8 * ldc + 32 * bj) = b2 + s2 + bv[bj]; }
                asm volatile("" ::: "memory"); }
    }
};
struct EpiQKV {
    static constexpr bool PERM = true, AFTER_DRAIN = false;
    bf16_t* QKV; const float* qg; const float* kg;
    __device__ __forceinline__ void operator()(const f32x4 (&acc)[2][2][4][2], const Unit& u, int wr, int wc, int fr, int fq) const {
        const int hd = u.pn * 4 + wc, which = hd / 24, g = (hd % 24) >> 3, h = hd & 7;
        f32x4 gv[2][2];
#pragma unroll
        for (int bj = 0; bj < 2; ++bj)
#pragma unroll
            for (int n = 0; n < 2; ++n) {
                if (which == 0) gv[bj][n] = *(const f32x4*)(qg + g * 64 + 32 * bj + 8 * fq + 4 * n) * (0.125f * 1.4426950408889634f);
                else if (which == 1) gv[bj][n] = *(const f32x4*)(kg + g * 64 + 32 * bj + 8 * fq + 4 * n);
                else gv[bj][n] = (f32x4){1.f, 1.f, 1.f, 1.f}; }
        bf16_t* hb = QKV + (size_t)(which * 3 + g) * (8 * 8 * 4096 * 64) + (size_t)h * (4096 * 64) + (fr >> 3) * 32 + 8 * fq;
#pragma unroll
        for (int ai = 0; ai < 2; ++ai)
#pragma unroll
            for (int m = 0; m < 4; ++m) {
                float ss = 0.f;
#pragma unroll
                for (int bj = 0; bj < 2; ++bj)
#pragma unroll
                    for (int n = 0; n < 2; ++n) { const f32x4 x = acc[ai][bj][m][n]; ss += (x[0] * x[0] + x[1] * x[1]) + (x[2] * x[2] + x[3] * x[3]); }
                ss = xrow_sum(ss);
                const float rinv = which < 2 ? __builtin_amdgcn_rsqf(ss * (1.0f / 64.0f) + 1e-6f) : 1.0f;
                u32x4 w[2];
#pragma unroll
                for (int bj = 0; bj < 2; ++bj) { const f32x4 v0 = acc[ai][bj][m][0] * rinv * gv[bj][0], v1 = acc[ai][bj][m][1] * rinv * gv[bj][1];
                    w[bj].x = cvt_pk_bf16(v0[0], v0[1]); w[bj].y = cvt_pk_bf16(v0[2], v0[3]); w[bj].z = cvt_pk_bf16(v1[0], v1[1]); w[bj].w = cvt_pk_bf16(v1[2], v1[3]); }
                u32x4 s1, s2; xchg_rows(w[0], w[1], s1, s2);
                const int row = u.pm * BM + ai * HALF + wr * 64 + m * 16 + (fr & 7), b = row >> 12, sq = row & 4095;
                bf16_t* dst = hb + (size_t)b * (8 * 4096 * 64) + (size_t)sq * 64;
                *(u32x4*)dst = s1; *(u32x4*)(dst + 8 * 64) = s2; }
    }
};
struct EpiSwiGLU {
    static constexpr bool PERM = true, AFTER_DRAIN = false;
    bf16_t* HID;
    __device__ __forceinline__ void operator()(const f32x4 (&acc)[2][2][4][2], const Unit& u, int wr, int wc, int fr, int fq) const {
        const int row0 = u.pm * BM + wr * 64 + fr, col0 = (u.pn & 15) * HALF + wc * 32 + 8 * fq;
#pragma unroll
        for (int ai = 0; ai < 2; ++ai)
#pragma unroll
            for (int m = 0; m < 4; ++m) { bf16_t* rowp = HID + (size_t)(row0 + ai * HALF + m * 16) * 2048 + col0;
                const f32x4 a0 = acc[ai][0][m][0], a1 = acc[ai][0][m][1], b0 = acc[ai][1][m][0], b1 = acc[ai][1][m][1];
                u32x4 w; w.x = cvt_pk_bf16(silu_f(a0[0]) * b0[0], silu_f(a0[1]) * b0[1]); w.y = cvt_pk_bf16(silu_f(a0[2]) * b0[2], silu_f(a0[3]) * b0[3]);
                w.z = cvt_pk_bf16(silu_f(a1[0]) * b1[0], silu_f(a1[1]) * b1[1]); w.w = cvt_pk_bf16(silu_f(a1[2]) * b1[2], silu_f(a1[3]) * b1[3]);
                *(u32x4*)rowp = w; }
    }
};
struct EpiGate {
    static constexpr bool PERM = true, AFTER_DRAIN = false;
    bf16_t* Y; const float* gate;
    __device__ __forceinline__ void operator()(const f32x4 (&acc)[2][2][4][2], const Unit& u, int wr, int wc, int fr, int fq) const {
        const int rowb = u.pm * BM + wr * 64, colw = (u.pn & 3) * BM + wc * 64;
        bf16_t* ob = Y + (size_t)(rowb + (fr & 7)) * 1024 + colw + (fr >> 3) * 32 + 8 * fq;
#pragma unroll
        for (int ai = 0; ai < 2; ++ai)
#pragma unroll
            for (int m = 0; m < 4; ++m) { const float gt = gate[rowb + fr + ai * HALF + m * 16]; u32x4 w[2];
#pragma unroll
                for (int bj = 0; bj < 2; ++bj) { const f32x4 v0 = acc[ai][bj][m][0] * gt, v1 = acc[ai][bj][m][1] * gt;
                    w[bj].x = cvt_pk_bf16(v0[0], v0[1]); w[bj].y = cvt_pk_bf16(v0[2], v0[3]); w[bj].z = cvt_pk_bf16(v1[0], v1[1]); w[bj].w = cvt_pk_bf16(v1[2], v1[3]); }
                u32x4 s1, s2; xchg_rows(w[0], w[1], s1, s2);
                bf16_t* rp = ob + (size_t)(ai * HALF + m * 16) * 1024;
                *(u32x4*)rp = s1; *(u32x4*)(rp + 8 * 1024) = s2; }
    }
};

template <class Epi, class Sched, bool ALIGN_EPI = false, bool SP2 = false>
__device__ __forceinline__ void gemm_phase(PG8_LAS unsigned char* lds, const Gemm g, const Sched& S, const Epi& E) {
    int tid_ = threadIdx.x; asm volatile("" : "+v"(tid_));
    const int tid = tid_, wid = __builtin_amdgcn_readfirstlane(tid >> 6), lane = tid & 63, wr = wid >> 2, wc = wid & 3, fr = lane & 15, fq = lane >> 4;
    const int K = g.K, nt = K / BK;
    unsigned voffA[2], voffB0[2], voffB1[2];
#pragma unroll
    for (int i = 0; i < 2; ++i) { int R, C; stage_rc(tid * 16 + i * 8192, R, C); const int Rb = 64 * (R >> 5) + (Epi::PERM ? perm32(R & 31) : (R & 31));
        voffA[i] = (unsigned)(R * K + C) * 2u; voffB0[i] = (unsigned)(Rb * K + C) * 2u; voffB1[i] = (unsigned)((Rb + 32) * K + C) * 2u; }
    const size_t kstep = (size_t)(BK * 2);
    const size_t hstep = (size_t)HALF * K * 2;
    const size_t tstep = 2 * hstep;
    const unsigned ldsw = (unsigned)wid * 1024u;
    const int aoff = lds_byte(wr * 64 + fr, fq * 8), boff = lds_byte(wc * 32 + fr, fq * 8);
#define PG8_SA(b, h) (((b) * 2 + (h)) * HTB)
#define PG8_SB(b, h) ((4 + (b) * 2 + (h)) * HTB)
#define PG8_STAGE(bufoff, gbase, voff) do { _Pragma("unroll") for (int _i = 0; _i < 2; ++_i) \
        __builtin_amdgcn_global_load_lds((const unsigned*)((const char*)(gbase) + (voff)[_i]), (PG8_LAS unsigned*)(lds + (bufoff) + ldsw + _i * 8192), 16, 0, 0); } while (0)
#define PG8_LDA(dst, b, h) do { _Pragma("unroll") for (int m = 0; m < 4; ++m) _Pragma("unroll") for (int k = 0; k < 2; ++k) dst[m][k] = *(const PG8_LAS bf16x8*)(lds + PG8_SA(b, h) + aoff + m * 2048 + k * 1024); } while (0)
#define PG8_LDB(dst, b, h) do { _Pragma("unroll") for (int n = 0; n < 2; ++n) _Pragma("unroll") for (int k = 0; k < 2; ++k) dst[n][k] = *(const PG8_LAS bf16x8*)(lds + PG8_SB(b, h) + boff + n * 2048 + k * 1024); } while (0)
#define PG8_MMA(ai, bj, At, Bt) do { __builtin_amdgcn_s_setprio(1); _Pragma("unroll") for (int m = 0; m < 4; ++m) _Pragma("unroll") for (int n = 0; n < 2; ++n) _Pragma("unroll") for (int k = 0; k < 2; ++k) \
        acc[ai][bj][m][n] = __builtin_amdgcn_mfma_f32_16x16x32_bf16(Bt[n][k], At[m][k], acc[ai][bj][m][n], 0, 0, 0); __builtin_amdgcn_s_setprio(0); } while (0)
#define PG8_WAIT_V(n) asm volatile("s_waitcnt vmcnt(" #n ")" ::: "memory")
#define PG8_WAIT_L(n) asm volatile("s_waitcnt lgkmcnt(" #n ")" ::: "memory")
#define PG8_BAR __builtin_amdgcn_s_barrier()
#define PG8_SCHED __builtin_amdgcn_sched_barrier(0)
    Unit cur, nxt; int ui = 0;
    if (!S.next(0, cur)) return;
    f32x4 acc[2][2][4][2];
#pragma unroll
    for (int a = 0; a < 2; ++a)
#pragma unroll
        for (int b = 0; b < 2; ++b)
#pragma unroll
            for (int m = 0; m < 4; ++m)
#pragma unroll
                for (int n = 0; n < 2; ++n) acc[a][b][m][n] = (f32x4){0.f, 0.f, 0.f, 0.f};
    bf16x8 At[4][2], B0[2][2], B1[2][2];
    const char* cA = (const char*)g.A + (size_t)cur.pm * tstep; const char* cB = (const char*)g.Bt + (size_t)cur.pn * tstep;
    S.a_ready(cur);
    if constexpr (SP2) {
        PG8_STAGE(PG8_SB(0, 0), cB, voffB0); PG8_STAGE(PG8_SB(0, 1), cB, voffB1); PG8_STAGE(PG8_SA(0, 0), cA, voffA); PG8_STAGE(PG8_SA(0, 1), cA + hstep, voffA);
        if (wr == 1) PG8_BAR;
        PG8_WAIT_V(2); PG8_BAR;
        PG8_STAGE(PG8_SB(1, 0), cB + kstep, voffB0); PG8_STAGE(PG8_SA(1, 0), cA + kstep, voffA); PG8_STAGE(PG8_SB(1, 1), cB + kstep, voffB1);
        PG8_WAIT_V(6); PG8_BAR;
    } else {
        PG8_STAGE(PG8_SB(0, 0), cB, voffB0); PG8_STAGE(PG8_SA(0, 0), cA, voffA); PG8_STAGE(PG8_SB(0, 1), cB, voffB1); PG8_STAGE(PG8_SA(0, 1), cA + hstep, voffA);
        if (wr == 1) PG8_BAR;
        PG8_WAIT_V(4); PG8_BAR;
        PG8_STAGE(PG8_SB(1, 0), cB + kstep, voffB0); PG8_STAGE(PG8_SA(1, 0), cA + kstep, voffA); PG8_STAGE(PG8_SB(1, 1), cB + kstep, voffB1);
        PG8_WAIT_V(6); PG8_BAR;
    }
    for (;;) {
        const bool has_next = S.next(ui + 1, nxt);
        const char* nA = has_next ? (const char*)g.A + (size_t)nxt.pm * tstep : cA; const char* nB = has_next ? (const char*)g.Bt + (size_t)nxt.pn * tstep : cB;
        for (int t = 0; t < nt; t += 2) {
            const bool last = (t == nt - 2);
            const char* a1 = cA + (size_t)(t + 1) * kstep;
            const char* a2 = last ? nA : cA + (size_t)(t + 2) * kstep; const char* b2 = last ? nB : cB + (size_t)(t + 2) * kstep;
            const char* a3 = a2 + kstep; const char* b3 = b2 + kstep;
            if (last && has_next) S.a_ready(nxt);
            if constexpr (SP2) {
            PG8_LDB(B0, 0, 0); PG8_LDB(B1, 0, 1); PG8_SCHED; PG8_LDA(At, 0, 0); PG8_STAGE(PG8_SA(1, 1), a1 + hstep, voffA);
            PG8_WAIT_V(8); PG8_WAIT_L(0); PG8_BAR; PG8_MMA(0, 0, At, B0); PG8_MMA(0, 1, At, B1); PG8_BAR; PG8_SCHED;
            PG8_LDA(At, 0, 1); PG8_STAGE(PG8_SB(0, 0), b2, voffB0); PG8_STAGE(PG8_SB(0, 1), b2, voffB1); PG8_STAGE(PG8_SA(0, 0), a2, voffA);
            PG8_WAIT_V(8); PG8_WAIT_L(0); PG8_BAR; PG8_MMA(1, 0, At, B0); PG8_MMA(1, 1, At, B1); PG8_BAR; PG8_SCHED;
            PG8_LDB(B0, 1, 0); PG8_LDB(B1, 1, 1); PG8_SCHED; PG8_LDA(At, 1, 0); PG8_STAGE(PG8_SA(0, 1), a2 + hstep, voffA);
            PG8_WAIT_V(8); PG8_WAIT_L(0); PG8_BAR; PG8_MMA(0, 0, At, B0); PG8_MMA(0, 1, At, B1); PG8_BAR; PG8_SCHED;
            PG8_LDA(At, 1, 1); PG8_STAGE(PG8_SB(1, 0), b3, voffB0); PG8_STAGE(PG8_SB(1, 1), b3, voffB1); PG8_STAGE(PG8_SA(1, 0), a3, voffA);
            PG8_WAIT_V(8); PG8_WAIT_L(0); PG8_BAR; PG8_MMA(1, 0, At, B0); PG8_MMA(1, 1, At, B1); PG8_BAR; PG8_SCHED;
            } else {
            PG8_LDB(B0, 0, 0); PG8_SCHED; PG8_LDA(At, 0, 0); PG8_STAGE(PG8_SA(1, 1), a1 + hstep, voffA);
            PG8_WAIT_L(8); PG8_BAR; PG8_WAIT_L(0); PG8_MMA(0, 0, At, B0); PG8_BAR; PG8_SCHED;
            PG8_LDB(B1, 0, 1); PG8_STAGE(PG8_SB(0, 0), b2, voffB0);
            PG8_BAR; PG8_WAIT_L(0); PG8_MMA(0, 1, At, B1); PG8_BAR;
            PG8_LDA(At, 0, 1); PG8_STAGE(PG8_SA(0, 0), a2, voffA);
            PG8_BAR; PG8_WAIT_L(0); PG8_MMA(1, 0, At, B0); PG8_BAR; PG8_SCHED;
            PG8_STAGE(PG8_SB(0, 1), b2, voffB1);
            PG8_WAIT_V(6); PG8_BAR; PG8_MMA(1, 1, At, B1); PG8_BAR;
            PG8_LDB(B0, 1, 0); PG8_SCHED; PG8_LDA(At, 1, 0); PG8_STAGE(PG8_SA(0, 1), a2 + hstep, voffA);
            PG8_WAIT_L(8); PG8_BAR; PG8_WAIT_L(0); PG8_MMA(0, 0, At, B0); PG8_BAR; PG8_SCHED;
            PG8_LDB(B1, 1, 1); PG8_STAGE(PG8_SB(1, 0), b3, voffB0);
            PG8_BAR; PG8_WAIT_L(0); PG8_MMA(0, 1, At, B1); PG8_BAR;
            PG8_LDA(At, 1, 1); PG8_STAGE(PG8_SA(1, 0), a3, voffA);
            PG8_BAR; PG8_WAIT_L(0); PG8_MMA(1, 0, At, B0); PG8_BAR; PG8_SCHED;
            PG8_STAGE(PG8_SB(1, 1), b3, voffB1);
            PG8_WAIT_V(6); PG8_BAR; PG8_MMA(1, 1, At, B1); PG8_BAR;
            }
        }
        if constexpr (ALIGN_EPI) { if (wr == 0) PG8_BAR; }
        if constexpr (!Epi::AFTER_DRAIN) { E(acc, cur, wr, wc, fr, fq); S.done(cur); }
        if (!has_next) break;
#pragma unroll
        for (int a = 0; a < 2; ++a)
#pragma unroll
            for (int b = 0; b < 2; ++b)
#pragma unroll
                for (int m = 0; m < 4; ++m)
#pragma unroll
                    for (int n = 0; n < 2; ++n) acc[a][b][m][n] = (f32x4){0.f, 0.f, 0.f, 0.f};
        cur = nxt; cA = nA; cB = nB; ++ui;
        if constexpr (ALIGN_EPI) { if (wr == 1) PG8_BAR; }
    }
    PG8_WAIT_V(0);
    if constexpr (!ALIGN_EPI) { if (wr == 0) PG8_BAR; }
    PG8_BAR;
#undef PG8_SA
#undef PG8_SB
#undef PG8_STAGE
#undef PG8_LDA
#undef PG8_LDB
#undef PG8_MMA
#undef PG8_WAIT_V
#undef PG8_WAIT_L
#undef PG8_BAR
#undef PG8_SCHED
}
template <class Epi, class Sched>
__device__ __forceinline__ void gemm_phase_gather(PG8_LAS unsigned char* lds, const Gemm g, const int* rowmap, const Sched& S, const Epi& E) {
    constexpr bool ALIGN_EPI = true, SP2 = true;
    int tid_ = threadIdx.x; asm volatile("" : "+v"(tid_));
    const int tid = tid_, wid = __builtin_amdgcn_readfirstlane(tid >> 6), lane = tid & 63, wr = wid >> 2, wc = wid & 3, fr = lane & 15, fq = lane >> 4;
    const int K = g.K, nt = K / BK;
    unsigned voffB0[2], voffB1[2]; int rA[2]; unsigned cA2[2];
#pragma unroll
    for (int i = 0; i < 2; ++i) { int R, C; stage_rc(tid * 16 + i * 8192, R, C); const int Rb = 64 * (R >> 5) + (Epi::PERM ? perm32(R & 31) : (R & 31));
        rA[i] = R; cA2[i] = (unsigned)C * 2u; voffB0[i] = (unsigned)(Rb * K + C) * 2u; voffB1[i] = (unsigned)((Rb + 32) * K + C) * 2u; }
    const unsigned rowb = (unsigned)K * 2u;
    const size_t kstep = (size_t)(BK * 2);
    const size_t hstep = (size_t)HALF * K * 2;
    const size_t tstep = 2 * hstep;
    const unsigned ldsw = (unsigned)wid * 1024u;
    const int aoff = lds_byte(wr * 64 + fr, fq * 8), boff = lds_byte(wc * 32 + fr, fq * 8);
#define PG8_SA(b, h) (((b) * 2 + (h)) * HTB)
#define PG8_SB(b, h) ((4 + (b) * 2 + (h)) * HTB)
#define PG8_STAGE(bufoff, gbase, voff) do { _Pragma("unroll") for (int _i = 0; _i < 2; ++_i) \
        __builtin_amdgcn_global_load_lds((const unsigned*)((const char*)(gbase) + (voff)[_i]), (PG8_LAS unsigned*)(lds + (bufoff) + ldsw + _i * 8192), 16, 0, 0); } while (0)
#define PG8_LDA(dst, b, h) do { _Pragma("unroll") for (int m = 0; m < 4; ++m) _Pragma("unroll") for (int k = 0; k < 2; ++k) dst[m][k] = *(const PG8_LAS bf16x8*)(lds + PG8_SA(b, h) + aoff + m * 2048 + k * 1024); } while (0)
#define PG8_LDB(dst, b, h) do { _Pragma("unroll") for (int n = 0; n < 2; ++n) _Pragma("unroll") for (int k = 0; k < 2; ++k) dst[n][k] = *(const PG8_LAS bf16x8*)(lds + PG8_SB(b, h) + boff + n * 2048 + k * 1024); } while (0)
#define PG8_MMA(ai, bj, At, Bt) do { __builtin_amdgcn_s_setprio(1); _Pragma("unroll") for (int m = 0; m < 4; ++m) _Pragma("unroll") for (int n = 0; n < 2; ++n) _Pragma("unroll") for (int k = 0; k < 2; ++k) \
        acc[ai][bj][m][n] = __builtin_amdgcn_mfma_f32_16x16x32_bf16(Bt[n][k], At[m][k], acc[ai][bj][m][n], 0, 0, 0); __builtin_amdgcn_s_setprio(0); } while (0)
#define PG8_WAIT_V(n) asm volatile("s_waitcnt vmcnt(" #n ")" ::: "memory")
#define PG8_WAIT_L(n) asm volatile("s_waitcnt lgkmcnt(" #n ")" ::: "memory")
#define PG8_BAR __builtin_amdgcn_s_barrier()
#define PG8_SCHED __builtin_amdgcn_sched_barrier(0)
    Unit cur, nxt; int ui = 0;
    if (!S.next(0, cur)) return;
    f32x4 acc[2][2][4][2];
#pragma unroll
    for (int a = 0; a < 2; ++a)
#pragma unroll
        for (int b = 0; b < 2; ++b)
#pragma unroll
            for (int m = 0; m < 4; ++m)
#pragma unroll
                for (int n = 0; n < 2; ++n) acc[a][b][m][n] = (f32x4){0.f, 0.f, 0.f, 0.f};
    bf16x8 At[4][2], B0[2][2], B1[2][2];
    const char* const gA = (const char*)g.A; const char* cB = (const char*)g.Bt + (size_t)cur.pn * tstep;
    unsigned va[2][2], vn[2][2]; unsigned nraw[2][2];
#pragma unroll
    for (int h = 0; h < 2; ++h)
#pragma unroll
        for (int i = 0; i < 2; ++i) { va[h][i] = (unsigned)rowmap[cur.pm * BM + h * HALF + rA[i]] * rowb + cA2[i]; vn[h][i] = va[h][i]; nraw[h][i] = 0u; }
    S.a_ready(cur);
    if constexpr (SP2) {
        PG8_STAGE(PG8_SB(0, 0), cB, voffB0); PG8_STAGE(PG8_SB(0, 1), cB, voffB1); PG8_STAGE(PG8_SA(0, 0), gA, va[0]); PG8_STAGE(PG8_SA(0, 1), gA, va[1]);
        if (wr == 1) PG8_BAR;
        PG8_WAIT_V(2); PG8_BAR;
        PG8_STAGE(PG8_SB(1, 0), cB + kstep, voffB0); PG8_STAGE(PG8_SA(1, 0), gA + kstep, va[0]); PG8_STAGE(PG8_SB(1, 1), cB + kstep, voffB1);
        PG8_WAIT_V(6); PG8_BAR;
    }
    for (;;) {
        const bool has_next = S.next(ui + 1, nxt);
        const char* nB = has_next ? (const char*)g.Bt + (size_t)nxt.pn * tstep : cB;
        if (has_next) {
#pragma unroll
            for (int h = 0; h < 2; ++h)
#pragma unroll
                for (int i = 0; i < 2; ++i) { const int* rp = rowmap + nxt.pm * BM + h * HALF + rA[i]; asm volatile("global_load_dword %0, %1, off" : "=v"(nraw[h][i]) : "v"(rp) : "memory"); } }
        for (int t = 0; t < nt; t += 2) {
            const bool last = (t == nt - 2);
            if (last && has_next) {
#pragma unroll
                for (int h = 0; h < 2; ++h)
#pragma unroll
                    for (int i = 0; i < 2; ++i) { unsigned x = nraw[h][i]; asm volatile("" : "+v"(x)); vn[h][i] = x * rowb + cA2[i]; } }
            const char* a1 = gA + (size_t)(t + 1) * kstep;
            const char* a2 = last ? gA : gA + (size_t)(t + 2) * kstep; const char* b2 = last ? nB : cB + (size_t)(t + 2) * kstep;
            const char* a3 = a2 + kstep; const char* b3 = b2 + kstep;
            unsigned v2[2][2];
#pragma unroll
            for (int h = 0; h < 2; ++h)
#pragma unroll
                for (int i = 0; i < 2; ++i) v2[h][i] = last ? vn[h][i] : va[h][i];
            if (last && has_next) S.a_ready(nxt);
            if constexpr (SP2) {
            PG8_LDB(B0, 0, 0); PG8_LDB(B1, 0, 1); PG8_SCHED; PG8_LDA(At, 0, 0); PG8_STAGE(PG8_SA(1, 1), a1, va[1]);
            PG8_WAIT_V(8); PG8_WAIT_L(0); PG8_BAR; PG8_MMA(0, 0, At, B0); PG8_MMA(0, 1, At, B1); PG8_BAR; PG8_SCHED;
            PG8_LDA(At, 0, 1); PG8_STAGE(PG8_SB(0, 0), b2, voffB0); PG8_STAGE(PG8_SB(0, 1), b2, voffB1); PG8_STAGE(PG8_SA(0, 0), a2, v2[0]);
            PG8_WAIT_V(8); PG8_WAIT_L(0); PG8_BAR; PG8_MMA(1, 0, At, B0); PG8_MMA(1, 1, At, B1); PG8_BAR; PG8_SCHED;
            PG8_LDB(B0, 1, 0); PG8_LDB(B1, 1, 1); PG8_SCHED; PG8_LDA(At, 1, 0); PG8_STAGE(PG8_SA(0, 1), a2, v2[1]);
            PG8_WAIT_V(8); PG8_WAIT_L(0); PG8_BAR; PG8_MMA(0, 0, At, B0); PG8_MMA(0, 1, At, B1); PG8_BAR; PG8_SCHED;
            PG8_LDA(At, 1, 1); PG8_STAGE(PG8_SB(1, 0), b3, voffB0); PG8_STAGE(PG8_SB(1, 1), b3, voffB1); PG8_STAGE(PG8_SA(1, 0), a3, v2[0]);
            PG8_WAIT_V(8); PG8_WAIT_L(0); PG8_BAR; PG8_MMA(1, 0, At, B0); PG8_MMA(1, 1, At, B1); PG8_BAR; PG8_SCHED;
            }
        }
        if constexpr (ALIGN_EPI) { if (wr == 0) PG8_BAR; }
        if constexpr (!Epi::AFTER_DRAIN) { E(acc, cur, wr, wc, fr, fq); S.done(cur); }
        if (!has_next) break;
#pragma unroll
        for (int a = 0; a < 2; ++a)
#pragma unroll
            for (int b = 0; b < 2; ++b)
#pragma unroll
                for (int m = 0; m < 4; ++m)
#pragma unroll
                    for (int n = 0; n < 2; ++n) acc[a][b][m][n] = (f32x4){0.f, 0.f, 0.f, 0.f};
        cur = nxt; cB = nB; ++ui;
#pragma unroll
        for (int h = 0; h < 2; ++h)
#pragma unroll
            for (int i = 0; i < 2; ++i) va[h][i] = vn[h][i];
        if constexpr (ALIGN_EPI) { if (wr == 1) PG8_BAR; }
    }
    PG8_WAIT_V(0);
    if constexpr (!ALIGN_EPI) { if (wr == 0) PG8_BAR; }
    PG8_BAR;
#undef PG8_SA
#undef PG8_SB
#undef PG8_STAGE
#undef PG8_LDA
#undef PG8_LDB
#undef PG8_MMA
#undef PG8_WAIT_V
#undef PG8_WAIT_L
#undef PG8_BAR
#undef PG8_SCHED
}
}

constexpr int NB = 8, SEQ = 4096, D = 1024, T = NB * SEQ;
constexpr int GW = 3072;
constexpr int NE = 16, CAP = 512, DE = 2048, NSLOT = NB * NE * CAP;
constexpr int QKVW = 4608, AW = 512;
constexpr float EPS = 1e-6f;

constexpr size_t MiB = 1u << 20;
constexpr size_t WS_CTL = 0, CTL_ZERO_BYTES = 1 * MiB;
constexpr size_t WS_WIN = 1 * MiB;
constexpr size_t WS_WOUT = 25 * MiB;
constexpr size_t WS_WQKV = 37 * MiB;
constexpr size_t WS_WO = 55 * MiB;
constexpr size_t WS_W13 = 57 * MiB;
constexpr size_t WS_W2 = 569 * MiB;
constexpr size_t WS_H = 825 * MiB;
constexpr size_t WS_AFF = 889 * MiB;
constexpr size_t WS_SMAP = 891 * MiB;
constexpr size_t WS_TOK = 893 * MiB;
constexpr size_t WS_GATE = 893 * MiB + 512 * 1024;
constexpr size_t WS_XB = 894 * MiB;
constexpr size_t WS_ACT = 1022 * MiB;
constexpr size_t WS_U = WS_ACT, WS_VT = WS_ACT + 192 * MiB, WS_SSQ = WS_ACT + 384 * MiB, WS_UV = WS_ACT + 388 * MiB;
constexpr size_t WS_QKV = WS_ACT, WS_OG = WS_ACT + 288 * MiB, WS_LSE = WS_ACT + 384 * MiB, WS_O = WS_ACT + 388 * MiB;
constexpr size_t WS_XIN = WS_ACT, WS_HID = WS_ACT + 128 * MiB, WS_Y = WS_ACT + 384 * MiB;
constexpr size_t WS_END = WS_ACT + 580 * MiB;
constexpr int CW_BAR = 4096;

constexpr int RING_BYTES = 131072, LDS_BYTES = 147456, LDSCTL_OFF = LDS_BYTES - 256;

#define LAS __attribute__((address_space(3)))
typedef unsigned short bf16;
typedef unsigned v4u __attribute__((ext_vector_type(4)));
typedef unsigned v2u __attribute__((ext_vector_type(2)));
typedef float f32x4 __attribute__((ext_vector_type(4)));
typedef short bf16x8 __attribute__((ext_vector_type(8)));
#define LDS_WAIT() asm volatile("s_waitcnt lgkmcnt(0)" ::: "memory")
__device__ __forceinline__ unsigned f2bf(float f) { unsigned u = __builtin_bit_cast(unsigned, f); return (u + 0x7fffu + ((u >> 16) & 1u)) >> 16; }
typedef float f32x2_t __attribute__((ext_vector_type(2))); typedef __bf16 bf16x2_t __attribute__((ext_vector_type(2)));
__device__ __forceinline__ unsigned pk2(float lo, float hi) { const f32x2_t v = {lo, hi}; return __builtin_bit_cast(unsigned, __builtin_convertvector(v, bf16x2_t)); }
__device__ __forceinline__ float bf_lo(unsigned w) { return __builtin_bit_cast(float, w << 16); }
__device__ __forceinline__ float bf_hi(unsigned w) { return __builtin_bit_cast(float, w & 0xffff0000u); }

#define XB_TMO      128
#define XB_XCNT(j)  (256  + 64 * (j))
#define XB_XSUB(j)  (1280 + 64 * (j))
#define XB_XGEN(j)  (2304 + 64 * (j))
#define XB_TOP      3328
#define XB_TOPGEN   3392
#define XCD_BAR_WORDS 3456
#define XB_SPIN_CAP (1u << 22)
__device__ __forceinline__ unsigned xb_ld(unsigned* p)              { return __hip_atomic_load(p, __ATOMIC_RELAXED, __HIP_MEMORY_SCOPE_AGENT); }
__device__ __forceinline__ unsigned xb_add(unsigned* p, unsigned v) { return __hip_atomic_fetch_add(p, v, __ATOMIC_RELAXED, __HIP_MEMORY_SCOPE_AGENT); }
__device__ __forceinline__ unsigned xb_xcc_id() { return (unsigned)__builtin_amdgcn_s_getreg((3 << 11) | 20) & 0xFu; }
#define XB_SPIN(cond, bar) do { unsigned _sp = 0; while (cond) { __builtin_amdgcn_s_sleep(1); \
    if ((++_sp & 255u) == 0u) { if (xb_ld(&(bar)[XB_TMO])) break; if (_sp > XB_SPIN_CAP) { atomicAdd(&(bar)[XB_TMO], 1u); break; } } } } while (0)
struct XcdBarrier { unsigned* bar; unsigned x; volatile LAS unsigned* st; };
__device__ __forceinline__ XcdBarrier xcd_barrier_post(unsigned* bar, volatile LAS unsigned* st) {
    XcdBarrier b; b.bar = bar; b.x = xb_xcc_id(); b.st = st;
    if (threadIdx.x == 0) (void)xb_add(&bar[XB_XCNT(b.x)], 1u);
    return b;
}
__device__ __forceinline__ void xcd_barrier_complete(unsigned* bar, unsigned x, unsigned& nloc, unsigned& nx) {
    const unsigned G = gridDim.x * gridDim.y * gridDim.z;
    unsigned sum, cnt, mine, sp = 0u;
    for (;;) {
        sum = 0u; cnt = 0u; mine = 0u;
#pragma unroll
        for (unsigned j = 0; j < 16; ++j) { const unsigned c = xb_ld(&bar[XB_XCNT(j)]); sum += c; cnt += (c > 0u) ? 1u : 0u; mine = (j == x) ? c : mine; }
        if (sum == G) break;
        __builtin_amdgcn_s_sleep(1);
        if ((++sp & 255u) == 0u) { if (xb_ld(&bar[XB_TMO])) break; if (sp > XB_SPIN_CAP) { atomicAdd(&bar[XB_TMO], 1u); break; } }
    }
    nloc = mine > 0u ? mine : 1u; nx = cnt > 0u ? cnt : 1u;
}
__device__ __forceinline__ void xcd_barrier(const XcdBarrier& b) {
    asm volatile("s_waitcnt vmcnt(0)" ::: "memory");
    __syncthreads();
    if (threadIdx.x == 0) {
        unsigned* bar = b.bar;
        __builtin_amdgcn_s_waitcnt(0);
        unsigned nloc = b.st[0], nx = b.st[1];
        if (nloc == 0u) { xcd_barrier_complete(bar, b.x, nloc, nx); b.st[0] = nloc; b.st[1] = nx; }
        const unsigned old = xb_add(&bar[XB_XSUB(b.x)], 1u);
        const unsigned gen = old / nloc;
        if (old + 1u == (gen + 1u) * nloc) {
            __builtin_amdgcn_fence(__ATOMIC_RELEASE, "agent");
            asm volatile("s_waitcnt vmcnt(0)" ::: "memory");
            const unsigned og = xb_add(&bar[XB_TOP], 1u);
            const unsigned tg = og / nx;
            if (og + 1u == (tg + 1u) * nx) xb_add(&bar[XB_TOPGEN], 1u);
            else XB_SPIN(xb_ld(&bar[XB_TOPGEN]) == tg, bar);
            __builtin_amdgcn_fence(__ATOMIC_ACQUIRE, "agent");
            xb_add(&bar[XB_XGEN(b.x)], 1u);
            asm volatile("s_waitcnt vmcnt(0)" ::: "memory");
        } else {
            XB_SPIN(xb_ld(&bar[XB_XGEN(b.x)]) == gen, bar);
            __builtin_amdgcn_fence(__ATOMIC_ACQUIRE, "agent");
            asm volatile("s_waitcnt vmcnt(0)" ::: "memory");
        }
    }
    __syncthreads();
}

struct Args {
    const float* x; const float* mix_norm; const float* ffn_norm;
    const float* gm_w_in; const float* gm_b_in; const float* gm_v_norm; const float* gm_w_s; const float* gm_b_s; const float* gm_w_out; const float* gm_b_out;
    const float* at_w_qkv; const float* at_q_norm; const float* at_k_norm; const float* at_w_o;
    const float* moe_w_router; const float* moe_b_router; const float* moe_w1; const float* moe_w3; const float* moe_w2;
    float* out; unsigned char* ws; int ph_lo, ph_hi;
};

template <int CTRL> __device__ __forceinline__ float dppf(float v) { return __builtin_bit_cast(float, __builtin_amdgcn_update_dpp(0, __builtin_bit_cast(int, v), CTRL, 0xF, 0xF, true)); }
__device__ __forceinline__ float row_sum(float v) { v += dppf<0xB1>(v); v += dppf<0x4E>(v); v += dppf<0x141>(v); v += dppf<0x140>(v); return v; }
__device__ __forceinline__ float row_max(float v) { v = fmaxf(v, dppf<0xB1>(v)); v = fmaxf(v, dppf<0x4E>(v)); v = fmaxf(v, dppf<0x141>(v)); v = fmaxf(v, dppf<0x140>(v)); return v; }
__device__ __forceinline__ float wave_sum(float v) {
    v = row_sum(v);
    { auto rr = __builtin_amdgcn_permlane16_swap(__float_as_uint(v), __float_as_uint(v), false, false); v = __uint_as_float(rr[0]) + __uint_as_float(rr[1]); }
    { auto rr = __builtin_amdgcn_permlane32_swap(__float_as_uint(v), __float_as_uint(v), false, false); v = __uint_as_float(rr[0]) + __uint_as_float(rr[1]); }
    return v;
}

template <int MAP> __device__ __forceinline__ int wt_drow(int n) {
    if (MAP == 2) return 256 * (n >> 7) + 64 * ((n >> 5) & 3) + (n & 31);
    if (MAP == 3) return 256 * (n >> 7) + 64 * ((n >> 5) & 3) + 32 + (n & 31);
    return n;
}
template <int MAP> __device__ __forceinline__ void transpose_item(const float* __restrict__ W, int K, int N, bf16* WT, int k0, int n0, LAS float* scr, int lane) {
    f32x4 x[16];
#pragma unroll
    for (int i = 0; i < 16; ++i) x[i] = *(const f32x4*)(W + (size_t)(k0 + 4 * i + (lane >> 4)) * N + n0 + 4 * (lane & 15));
#pragma unroll
    for (int i = 0; i < 16; ++i) { LAS float* d = scr + (4 * i + (lane >> 4)) * 65 + 4 * (lane & 15); d[0] = x[i].x; d[1] = x[i].y; d[2] = x[i].z; d[3] = x[i].w; }
    LDS_WAIT(); asm volatile("" ::: "memory");
    const int c = lane & 7;
#pragma unroll
    for (int j = 0; j < 8; ++j) { const int n = (lane >> 3) + 8 * j; const LAS float* sp = scr + (8 * c) * 65 + n;
        v4u o; o.x = pk2(sp[0 * 65], sp[1 * 65]); o.y = pk2(sp[2 * 65], sp[3 * 65]); o.z = pk2(sp[4 * 65], sp[5 * 65]); o.w = pk2(sp[6 * 65], sp[7 * 65]);
        *(v4u*)(WT + (size_t)wt_drow<MAP>(n0 + n) * K + k0 + 8 * c) = o; }
    LDS_WAIT(); asm volatile("" ::: "memory");
}

__device__ __forceinline__ void rms_row_to_bf16(const float* xrow, const float* gain, bf16* orow, int lane) {
    const f32x4* xr = (const f32x4*)xrow + lane; const f32x4* gr = (const f32x4*)gain + lane;
    f32x4 v[4]; float s = 0.f;
#pragma unroll
    for (int j = 0; j < 4; ++j) { v[j] = xr[64 * j]; s += (v[j].x * v[j].x + v[j].y * v[j].y) + (v[j].z * v[j].z + v[j].w * v[j].w); }
    const float rinv = 1.0f / sqrtf(wave_sum(s) * (1.f / D) + EPS);
    unsigned long long* o8 = (unsigned long long*)orow + lane;
#pragma unroll
    for (int j = 0; j < 4; ++j) { const f32x4 g = gr[64 * j]; const f32x4 y = v[j] * rinv * g;
        o8[64 * j] = (unsigned long long)pk2(y.x, y.y) | ((unsigned long long)pk2(y.z, y.w) << 32); }
}

__device__ __forceinline__ void prologue_phase(const Args& a, LAS unsigned char* lds) {
    int tid = threadIdx.x; asm volatile("" : "+v"(tid)); const int lane = tid & 63, wave = __builtin_amdgcn_readfirstlane(tid >> 6); (void)lane; (void)wave;
    LAS float* scr = (LAS float*)(lds + wave * 16640);
    const int gw = blockIdx.x * 8 + wave, NGW = gridDim.x * 8;
    unsigned char* ws = a.ws;
    constexpr int IT_MOE = 64 * 3 * 512, NITEMS = IT_MOE + 3072 + 1536 + 2304 + 256;
    for (int it = gw; it < NITEMS; it += NGW) {
        if (it < IT_MOE) {
            const int q = it >> 9, r = it & 511, le = q / 3, which = q % 3;
            if (which == 0) transpose_item<2>(a.moe_w1 + (size_t)le * 1024 * 2048, 1024, 2048, (bf16*)(ws + WS_W13) + (size_t)le * 4096 * 1024, (r >> 5) * 64, (r & 31) * 64, scr, lane);
            else if (which == 1) transpose_item<3>(a.moe_w3 + (size_t)le * 1024 * 2048, 1024, 2048, (bf16*)(ws + WS_W13) + (size_t)le * 4096 * 1024, (r >> 5) * 64, (r & 31) * 64, scr, lane);
            else transpose_item<0>(a.moe_w2 + (size_t)le * 2048 * 1024, 2048, 1024, (bf16*)(ws + WS_W2) + (size_t)le * 1024 * 2048, (r >> 4) * 64, (r & 15) * 64, scr, lane);
        } else {
            int r = it - IT_MOE;
            if (r < 3072) { const int j = r / 1536, rr = r % 1536; transpose_item<0>(a.gm_w_in + (size_t)j * 1024 * 6144, 1024, 6144, (bf16*)(ws + WS_WIN) + (size_t)j * 6144 * 1024, (rr / 96) * 64, (rr % 96) * 64, scr, lane); }
            else if (r < 3072 + 1536) { r -= 3072; const int j = r / 768, rr = r % 768; transpose_item<0>(a.gm_w_out + (size_t)j * 3072 * 1024, 3072, 1024, (bf16*)(ws + WS_WOUT) + (size_t)j * 1024 * 3072, (rr >> 4) * 64, (rr & 15) * 64, scr, lane); }
            else if (r < 3072 + 1536 + 2304) { r -= 3072 + 1536; const int j = r / 1152, rr = r % 1152; transpose_item<0>(a.at_w_qkv + (size_t)j * 1024 * 4608, 1024, 4608, (bf16*)(ws + WS_WQKV) + (size_t)j * 4608 * 1024, (rr / 72) * 64, (rr % 72) * 64, scr, lane); }
            else { r -= 3072 + 1536 + 2304; const int j = r >> 7, rr = r & 127; transpose_item<0>(a.at_w_o + (size_t)j * 512 * 1024, 512, 1024, (bf16*)(ws + WS_WO) + (size_t)j * 1024 * 512, (rr >> 4) * 64, (rr & 15) * 64, scr, lane); }
        }
    }
    bf16* H = (bf16*)(ws + WS_H);
    for (int m = gw; m < T; m += NGW) rms_row_to_bf16(a.x + (size_t)m * D, a.mix_norm, H + (size_t)m * D, lane);
}

__device__ __forceinline__ void gating_phase(const Args& a, int j, LAS unsigned char* lds) {
    int tid = threadIdx.x; asm volatile("" : "+v"(tid)); const int lane = tid & 63, wave = __builtin_amdgcn_readfirstlane(tid >> 6);
    LAS unsigned short* Wl = (LAS unsigned short*)lds;
    LAS float* rinv = (LAS float*)(lds + 36864);
    LAS float* part = (LAS float*)(lds + 37888);
    LAS unsigned char* stage = lds + 40960;
    const float* Ws = a.gm_w_s + (size_t)j * 8 * 128 * 128; const float* bs = a.gm_b_s + j * 8 * 128; const float* vg = a.gm_v_norm + j * GW;
    const bf16* U = (const bf16*)(a.ws + WS_U); bf16* UV = (bf16*)(a.ws + WS_UV); const bf16* VT = (const bf16*)(a.ws + WS_VT); const float* SSQ = (const float*)(a.ws + WS_SSQ);
    const int fr = lane & 15, fq = lane >> 4;
    int cur_g = -1;
    bf16x8 vf[3][4]; float ssum = 0.f;
#define GATE_REQUEST(unit_) do { const int g_ = (unit_) & 7, tok0_ = ((unit_) >> 3) * 128; \
        _Pragma("unroll") for (int n = 0; n < 3; ++n) _Pragma("unroll") for (int ks = 0; ks < 4; ++ks) \
            vf[n][ks] = *(const bf16x8*)(VT + ((size_t)(tok0_ >> 7) * 3072 + g_ * 384 + 48 * wave + 16 * n + fr) * 128 + 32 * ks + 8 * fq); \
        ssum = 0.f; _Pragma("unroll") for (int q = 0; q < 6; ++q) ssum += SSQ[(size_t)(6 * (tid >> 7) + q) * T + tok0_ + (tid & 127)]; } while (0)
    if (blockIdx.x < 2048) GATE_REQUEST(blockIdx.x);
    for (int unit = blockIdx.x; unit < 2048; unit += gridDim.x) {
        const int g = unit & 7, tok0 = (unit >> 3) * 128;
        __syncthreads();
        if (g != cur_g) {
            int tw = tid; asm volatile("" : "+v"(tw));
#pragma unroll
            for (int i = 0; i < 8; ++i) { const int idx = (tw + 512 * i) * 4, t = idx >> 7, s0 = idx & 127; const f32x4 w = *(const f32x4*)(Ws + g * 16384 + idx);
                v2u o; o.x = pk2(w.x, w.y); o.y = pk2(w.z, w.w); *(LAS v2u*)(Wl + t * 136 + s0) = o; }
            cur_g = g; }
        part[tid] = ssum;
        __syncthreads();
        if (tid < 128) rinv[tid] = 1.0f / sqrtf(((part[tid] + part[128 + tid]) + (part[256 + tid] + part[384 + tid])) * (1.0f / GW) + EPS);
        __syncthreads();
#pragma unroll
        for (int ks = 0; ks < 4; ++ks) { const f32x4 r0 = *(const LAS f32x4*)(rinv + 32 * ks + 8 * fq), r1 = *(const LAS f32x4*)(rinv + 32 * ks + 8 * fq + 4);
#pragma unroll
            for (int n = 0; n < 3; ++n) { const v4u x = __builtin_bit_cast(v4u, vf[n][ks]); v4u y;
                y.x = pk2(bf_lo(x.x) * r0.x, bf_hi(x.x) * r0.y); y.y = pk2(bf_lo(x.y) * r0.z, bf_hi(x.y) * r0.w);
                y.z = pk2(bf_lo(x.z) * r1.x, bf_hi(x.z) * r1.y); y.w = pk2(bf_lo(x.w) * r1.z, bf_hi(x.w) * r1.w);
                vf[n][ks] = __builtin_bit_cast(bf16x8, y); } }
#pragma unroll 1
        for (int mh = 0; mh < 2; ++mh) {
            v4u ug[6];
            int te = tid; asm volatile("" : "+v"(te));
#pragma unroll
            for (int k = 0; k < 6; ++k) { const int c = te + 512 * k, row = c / 48, c8 = c % 48; ug[k] = *(const v4u*)(U + (size_t)(tok0 + 64 * mh + row) * GW + g * 384 + c8 * 8); }
            f32x4 acc[4][3];
#pragma unroll
            for (int m = 0; m < 4; ++m)
#pragma unroll
                for (int n = 0; n < 3; ++n) acc[m][n] = (f32x4){0.f, 0.f, 0.f, 0.f};
#pragma unroll
            for (int ks = 0; ks < 4; ++ks)
#pragma unroll
                for (int m = 0; m < 4; ++m) { const bf16x8 wf = *(const LAS bf16x8*)(Wl + (64 * mh + 16 * m + fr) * 136 + 32 * ks + 8 * fq);
#pragma unroll
                    for (int n = 0; n < 3; ++n) acc[m][n] = __builtin_amdgcn_mfma_f32_16x16x32_bf16(vf[n][ks], wf, acc[m][n], 0, 0, 0); }
            if (mh == 1 && unit + (int)gridDim.x < 2048) { asm volatile("" ::: "memory"); GATE_REQUEST(unit + (int)gridDim.x); }
#pragma unroll
            for (int n = 0; n < 3; ++n) { const int el = 48 * wave + 16 * n + 4 * fq; const f32x4 gn = *(const f32x4*)(vg + g * 384 + el);
#pragma unroll
                for (int m = 0; m < 4; ++m) { const int tl = 16 * m + fr; const float bt = bs[g * 128 + 64 * mh + tl];
                    *(LAS f32x4*)(stage + tl * 1552 + el * 4) = acc[m][n] * gn + bt; } }
            __syncthreads();
#pragma unroll
            for (int k = 0; k < 6; ++k) { const int c = te + 512 * k, row = c / 48, c8 = c % 48;
                const f32x4 g0 = *(const LAS f32x4*)(stage + row * 1552 + c8 * 32), g1 = *(const LAS f32x4*)(stage + row * 1552 + c8 * 32 + 16);
                v4u w; w.x = pk2(g0.x * bf_lo(ug[k].x), g0.y * bf_hi(ug[k].x)); w.y = pk2(g0.z * bf_lo(ug[k].y), g0.w * bf_hi(ug[k].y));
                w.z = pk2(g1.x * bf_lo(ug[k].z), g1.y * bf_hi(ug[k].z)); w.w = pk2(g1.z * bf_lo(ug[k].w), g1.w * bf_hi(ug[k].w));
                *(v4u*)(UV + (size_t)(tok0 + 64 * mh + row) * GW + g * 384 + c8 * 8) = w; }
            if (mh == 0) __syncthreads();
        }
    }
#undef GATE_REQUEST
}

typedef float f32x16 __attribute__((ext_vector_type(16)));
typedef short s16x4 __attribute__((ext_vector_type(4)));
typedef short v4i16_t __attribute__((ext_vector_type(4)));
__device__ __forceinline__ s16x4 vtr(const LAS unsigned char* p) { return __builtin_bit_cast(s16x4, __builtin_amdgcn_ds_read_tr16_b64_v4i16((LAS v4i16_t*)p)); }
__device__ __forceinline__ void attn_phase(const Args& a, LAS unsigned char* lds) {
    int tid = threadIdx.x; asm volatile("" : "+v"(tid)); const int lane = tid & 63, wave = __builtin_amdgcn_readfirstlane(tid >> 6), r32 = lane & 31, hi = lane >> 5;
    const bf16* QKV = (const bf16*)(a.ws + WS_QKV); bf16* OG = (bf16*)(a.ws + WS_OG); float* LSE = (float*)(a.ws + WS_LSE);
    LAS unsigned char* Kl = lds; LAS unsigned char* Vl = lds + 49152;
    LAS unsigned char* Ql = lds + 98304;
    constexpr size_t HEADSZ = (size_t)4096 * 64, WHICHSZ = (size_t)3 * 64 * 4096 * 64;
    v4u kr[6], vr[6], qv[4];
#define ATTN_DECODE(u_) const int g = (u_) >> 10, v = (u_) & 1023, bh = v >> 4, w16 = v & 15, dsh = 2 * g, dil = 1 << dsh, r = w16 & (dil - 1), blk = w16 >> dsh, L = 4096 >> dsh, p0 = blk * 256; \
        const bf16* qb = QKV + ((size_t)g * 64 + bh) * HEADSZ; const bf16* kb = qb + WHICHSZ; const bf16* vb = qb + 2 * WHICHSZ; (void)dil; (void)kb; (void)vb;
#define ATTN_REQUEST(u_) do { ATTN_DECODE(u_) \
        _Pragma("unroll") for (int i = 0; i < 6; ++i) { const int wv = wave + 8 * i; \
            const int key = 8 * wv + (lane & 7), p = min(max(p0 - 64 + key, 0), L - 1);        \
            kr[i] = *(const v4u*)(kb + (size_t)(r + (p << dsh)) * 64 + (lane >> 3) * 8); \
            const int key2 = 8 * wv + (lane >> 3), p2 = min(max(p0 - 64 + key2, 0), L - 1); \
            vr[i] = *(const v4u*)(vb + (size_t)(r + (p2 << dsh)) * 64 + (lane & 7) * 8); } \
        _Pragma("unroll") for (int i = 0; i < 4; ++i) { const int qq = 8 * (wave + 8 * i) + (lane & 7); \
            qv[i] = *(const v4u*)(qb + (size_t)(r + ((p0 + qq) << dsh)) * 64 + (lane >> 3) * 8); } } while (0)
    const int G8 = (int)gridDim.x, u0 = (G8 % 8 == 0) ? ((int)blockIdx.x % 8) * (G8 / 8) + (int)blockIdx.x / 8 : (int)blockIdx.x;
    if (u0 < 3072) ATTN_REQUEST(u0);
    for (int u = u0; u < 3072; u += gridDim.x) {
        ATTN_DECODE(u)
        const int b = bh >> 3, h = bh & 7;
        __syncthreads();
#pragma unroll
        for (int i = 0; i < 6; ++i) { const int wv = wave + 8 * i; const v4u z4 = (v4u){0u, 0u, 0u, 0u};
            const bool ok = (unsigned)(p0 - 64 + 8 * wv + (lane & 7)) < (unsigned)L, ok2 = (unsigned)(p0 - 64 + 8 * wv + (lane >> 3)) < (unsigned)L;
            *(LAS v4u*)(Kl + (lane >> 3) * 6144 + (8 * wv + (lane & 7)) * 16) = ok ? kr[i] : z4;
            *(LAS v4u*)(Vl + ((lane & 7) >> 2) * 24576 + (8 * wv + (lane >> 3)) * 64 + (lane & 3) * 16) = ok2 ? vr[i] : z4; }
#pragma unroll
        for (int i = 0; i < 4; ++i) *(LAS v4u*)(Ql + (lane >> 3) * 4096 + (8 * (wave + 8 * i) + (lane & 7)) * 16) = qv[i];
        __syncthreads();
        if (u + (int)gridDim.x < 3072) ATTN_REQUEST(u + (int)gridDim.x);
        const int sq = r + ((p0 + 32 * wave + r32) << dsh);
        bf16x8 qr[4];
#pragma unroll
        for (int d0 = 0; d0 < 4; ++d0) qr[d0] = *(const LAS bf16x8*)(Ql + (2 * d0 + hi) * 4096 + (32 * wave + r32) * 16);
        f32x16 sc[5];
#pragma unroll
        for (int k2 = 0; k2 < 5; k2 += 2) {
            const LAS unsigned char* kp = Kl + hi * 6144 + (32 * (wave + k2) + r32) * 16;
            bf16x8 ka[4], kb2[4];
#pragma unroll
            for (int d0 = 0; d0 < 4; ++d0) { ka[d0] = *(const LAS bf16x8*)(kp + d0 * 12288); if (k2 + 1 < 5) kb2[d0] = *(const LAS bf16x8*)(kp + 512 + d0 * 12288); }
#pragma unroll
            for (int d0 = 0; d0 < 4; ++d0) {
                if (d0 == 0) { sc[k2] = __builtin_amdgcn_mfma_f32_32x32x16_bf16(ka[0], qr[0], (f32x16){}, 0, 0, 0); if (k2 + 1 < 5) sc[k2 + 1] = __builtin_amdgcn_mfma_f32_32x32x16_bf16(kb2[0], qr[0], (f32x16){}, 0, 0, 0); }
                else { sc[k2] = __builtin_amdgcn_mfma_f32_32x32x16_bf16(ka[d0], qr[d0], sc[k2], 0, 0, 0); if (k2 + 1 < 5) sc[k2 + 1] = __builtin_amdgcn_mfma_f32_32x32x16_bf16(kb2[d0], qr[d0], sc[k2 + 1], 0, 0, 0); } }
            asm volatile("" ::: "memory"); }
        const float cb = __builtin_ldexpf(1.4426950408889634f, dsh - (h + 1));
        const float t0f = (float)(4 * hi - r32);
        const bool first = (p0 == 0), lastb = (p0 + 256 == L);
        float mx = -INFINITY;
#pragma unroll
        for (int kt = 0; kt < 5; ++kt) {
            float base = t0f; asm volatile("" : "+v"(base));
            const bool dead = (first && wave + kt < 2) || (lastb && wave + kt >= 10);
            if (dead) {
#pragma unroll
                for (int rr = 0; rr < 16; ++rr) sc[kt][rr] = -INFINITY;
            } else {
#pragma unroll
                for (int rr = 0; rr < 16; ++rr) { const float rel = base + (float)(32 * kt - 64 + (rr & 3) + 8 * (rr >> 2));
                    float sv = sc[kt][rr] - cb * __builtin_fabsf(rel);
                    if (kt == 0) sv = rel >= -64.f ? sv : -INFINITY;
                    if (kt == 4) sv = rel <= 64.f ? sv : -INFINITY;
                    sc[kt][rr] = sv; mx = fmaxf(mx, sv); } } }
        { auto rr = __builtin_amdgcn_permlane32_swap(__float_as_uint(mx), __float_as_uint(mx), false, false); mx = fmaxf(__uint_as_float(rr[0]), __uint_as_float(rr[1])); }
        float l = 0.f;
#pragma unroll
        for (int kt = 0; kt < 5; ++kt)
#pragma unroll
            for (int rr = 0; rr < 16; ++rr) { const float p = __builtin_amdgcn_exp2f(sc[kt][rr] - mx); sc[kt][rr] = p; l += p; }
        { auto rr = __builtin_amdgcn_permlane32_swap(__float_as_uint(l), __float_as_uint(l), false, false); l = __uint_as_float(rr[0]) + __uint_as_float(rr[1]); }
        f32x16 o0 = (f32x16){}, o1 = (f32x16){};
        const LAS unsigned char* vp = Vl + ((lane >> 4) & 1) * 32 + (lane & 3) * 8 + (4 * hi + ((lane & 15) >> 2)) * 64;
#pragma unroll
        for (int kt = 0; kt < 5; ++kt)
#pragma unroll
            for (int ks = 0; ks < 2; ++ks) { const LAS unsigned char* ap = vp + (32 * (wave + kt) + 16 * ks) * 64;
                const s16x4 l0 = vtr(ap), h0 = vtr(ap + 512), l1 = vtr(ap + 24576), h1 = vtr(ap + 24576 + 512);
                pg8::u32x4 pw; pw.x = pg8::cvt_pk_bf16(sc[kt][8 * ks + 0], sc[kt][8 * ks + 1]); pw.y = pg8::cvt_pk_bf16(sc[kt][8 * ks + 2], sc[kt][8 * ks + 3]);
                pw.z = pg8::cvt_pk_bf16(sc[kt][8 * ks + 4], sc[kt][8 * ks + 5]); pw.w = pg8::cvt_pk_bf16(sc[kt][8 * ks + 6], sc[kt][8 * ks + 7]);
                const bf16x8 pf = __builtin_bit_cast(bf16x8, pw);
                o0 = __builtin_amdgcn_mfma_f32_32x32x16_bf16((bf16x8){l0[0], l0[1], l0[2], l0[3], h0[0], h0[1], h0[2], h0[3]}, pf, o0, 0, 0, 0);
                o1 = __builtin_amdgcn_mfma_f32_32x32x16_bf16((bf16x8){l1[0], l1[1], l1[2], l1[3], h1[0], h1[1], h1[2], h1[3]}, pf, o1, 0, 0, 0);
                asm volatile("" ::: "memory"); }
        const float inv = 1.0f / l; const size_t row = (size_t)g * T + (size_t)b * 4096 + sq;
        LAS unsigned char* ow = Ql + (32 * wave) * 16;
#pragma unroll
        for (int aa = 0; aa < 4; ++aa) {
            v2u w0; w0.x = pk2(o0[4 * aa] * inv, o0[4 * aa + 1] * inv); w0.y = pk2(o0[4 * aa + 2] * inv, o0[4 * aa + 3] * inv);
            *(LAS v2u*)(ow + aa * 4096 + (r32 ^ aa) * 16 + 8 * hi) = w0;
            v2u w1; w1.x = pk2(o1[4 * aa] * inv, o1[4 * aa + 1] * inv); w1.y = pk2(o1[4 * aa + 2] * inv, o1[4 * aa + 3] * inv);
            *(LAS v2u*)(ow + (4 + aa) * 4096 + (r32 ^ (4 + aa)) * 16 + 8 * hi) = w1; }
        {   const int piece = lane & 7; bf16* ob = OG + ((size_t)g * T + (size_t)b * 4096) * AW + h * 64 + piece * 8;
#pragma unroll
            for (int i = 0; i < 4; ++i) { const int rw = (lane >> 3) + 8 * i;
                const v4u ov = *(const LAS v4u*)(ow + piece * 4096 + (rw ^ piece) * 16);
                *(v4u*)(ob + (size_t)(r + ((p0 + 32 * wave + rw) << dsh)) * AW) = ov; } }
        if (hi == 0) LSE[row * 8 + h] = mx + __builtin_log2f(l);
    }
#undef ATTN_DECODE
#undef ATTN_REQUEST
}
__device__ __forceinline__ void attn_merge_phase(const Args& a) {
    int tid = threadIdx.x; asm volatile("" : "+v"(tid)); const int lane = tid & 63, wave = __builtin_amdgcn_readfirstlane(tid >> 6);
    const bf16* OG = (const bf16*)(a.ws + WS_OG); const float* LSE = (const float*)(a.ws + WS_LSE); bf16* O = (bf16*)(a.ws + WS_O);
    const int gw = blockIdx.x * 8 + wave, NGW = gridDim.x * 8;
    for (int row = gw; row < T; row += NGW) {
        float ls[3]; v4u og[3];
#pragma unroll
        for (int g = 0; g < 3; ++g) { ls[g] = LSE[((size_t)g * T + row) * 8 + (lane >> 3)]; og[g] = *(const v4u*)(OG + ((size_t)g * T + row) * AW + lane * 8); }
        const float M = fmaxf(fmaxf(ls[0], ls[1]), ls[2]);
        float w[3]; float den = 0.f;
#pragma unroll
        for (int g = 0; g < 3; ++g) { w[g] = __builtin_amdgcn_exp2f(ls[g] - M); den += w[g]; }
        const float iden = 1.0f / den;
        float acc[8];
#pragma unroll
        for (int i = 0; i < 8; ++i) acc[i] = 0.f;
#pragma unroll
        for (int g = 0; g < 3; ++g) { const float wg = w[g] * iden; const unsigned ww[4] = {og[g].x, og[g].y, og[g].z, og[g].w};
#pragma unroll
            for (int i = 0; i < 4; ++i) { acc[2 * i] += wg * bf_lo(ww[i]); acc[2 * i + 1] += wg * bf_hi(ww[i]); } }
        v4u o; o.x = pk2(acc[0], acc[1]); o.y = pk2(acc[2], acc[3]); o.z = pk2(acc[4], acc[5]); o.w = pk2(acc[6], acc[7]);
        *(v4u*)(O + (size_t)row * AW + lane * 8) = o;
    }
}

__device__ __forceinline__ void router_phase(const Args& a, int layer, LAS unsigned char* lds) {
    int tid = threadIdx.x; asm volatile("" : "+v"(tid)); const int lane = tid & 63, wave = __builtin_amdgcn_readfirstlane(tid >> 6);
    LAS float* wr = (LAS float*)lds;
    constexpr int WRS = 1028;
    const float* Wr = a.moe_w_router + (size_t)layer * D * NE; const float* br = a.moe_b_router + layer * NE; const float* gain = a.ffn_norm + layer * D;
    __syncthreads();
    {   f32x4 wq[8];
#pragma unroll
        for (int k = 0; k < 8; ++k) wq[k] = *(const f32x4*)(Wr + (size_t)(tid + 512 * k) * 4);
#pragma unroll
        for (int k = 0; k < 8; ++k) { const int i4 = tid + 512 * k, d = i4 >> 2, e0 = 4 * (i4 & 3);
            wr[(e0 + 0) * WRS + d] = wq[k].x; wr[(e0 + 1) * WRS + d] = wq[k].y; wr[(e0 + 2) * WRS + d] = wq[k].z; wr[(e0 + 3) * WRS + d] = wq[k].w; } }
    __syncthreads();
    bf16* H = (bf16*)(a.ws + WS_H); float* AFF = (float*)(a.ws + WS_AFF); const float* XB = (const float*)(a.ws + WS_XB);
    const int gw = blockIdx.x * 8 + wave, NGW = gridDim.x * 8;
    const f32x4* gr = (const f32x4*)gain + lane;
    constexpr int RT = 4;
    f32x4 nx[RT][4];
    if (gw < T / RT) {
#pragma unroll
        for (int t = 0; t < RT; ++t) { const f32x4* xr = (const f32x4*)(XB + (size_t)(RT * gw + t) * D) + lane;
#pragma unroll
            for (int j = 0; j < 4; ++j) nx[t][j] = xr[64 * j]; } }
    for (int rp = gw; rp < T / RT; rp += NGW) {
        const int row = RT * rp;
        f32x4 v[RT][4]; float ss[RT];
#pragma unroll
        for (int t = 0; t < RT; ++t) { ss[t] = 0.f;
#pragma unroll
            for (int j = 0; j < 4; ++j) { v[t][j] = nx[t][j]; ss[t] += (v[t][j].x * v[t][j].x + v[t][j].y * v[t][j].y) + (v[t][j].z * v[t][j].z + v[t][j].w * v[t][j].w); } }
        if (rp + NGW < T / RT) {
#pragma unroll
            for (int t = 0; t < RT; ++t) { const f32x4* xr = (const f32x4*)(XB + (size_t)(RT * (rp + NGW) + t) * D) + lane;
#pragma unroll
                for (int j = 0; j < 4; ++j) nx[t][j] = xr[64 * j]; } }
#pragma unroll
        for (int t = 0; t < RT; ++t) { const float rinv = 1.0f / sqrtf(wave_sum(ss[t]) * (1.f / D) + EPS);
            unsigned long long* o8 = (unsigned long long*)(H + (size_t)(row + t) * D) + lane;
#pragma unroll
            for (int j = 0; j < 4; ++j) { v[t][j] = v[t][j] * rinv * gr[64 * j];
                o8[64 * j] = (unsigned long long)pk2(v[t][j].x, v[t][j].y) | ((unsigned long long)pk2(v[t][j].z, v[t][j].w) << 32); } }
        float mine[RT];
#pragma unroll
        for (int t = 0; t < RT; ++t) mine[t] = 0.f;
#pragma unroll 2
        for (int e = 0; e < 16; ++e) { float ac[RT];
#pragma unroll
            for (int t = 0; t < RT; ++t) ac[t] = 0.f;
#pragma unroll
            for (int j = 0; j < 4; ++j) { const f32x4 w = *(const LAS f32x4*)(wr + e * WRS + 256 * j + 4 * lane);
#pragma unroll
                for (int t = 0; t < RT; ++t) ac[t] += (v[t][j].x * w.x + v[t][j].y * w.y) + (v[t][j].z * w.z + v[t][j].w * w.w); }
            const float be = br[e];
#pragma unroll
            for (int t = 0; t < RT; ++t) { const float lg = wave_sum(ac[t]) + be; mine[t] = (lane == e) ? lg : mine[t]; } }
        float pr[RT];
#pragma unroll
        for (int t = 0; t < RT; ++t) { const float m = row_max(mine[t]); const float ex = __expf(mine[t] - m); pr[t] = ex / row_sum(ex); }
        if (lane < 16) { float* ap = AFF + ((size_t)(row >> 12) * 16 + lane) * 4096 + (row & 4095); *(f32x4*)ap = (f32x4){pr[0], pr[1], pr[2], pr[3]}; }
    }
}

__device__ __forceinline__ void topk_phase(const Args& a, LAS unsigned char* lds) {
    int tid = threadIdx.x; asm volatile("" : "+v"(tid)); const int lane = tid & 63, wave = __builtin_amdgcn_readfirstlane(tid >> 6); (void)lane; (void)wave;
    LAS unsigned* hist = (LAS unsigned*)lds;
    LAS unsigned* sh = hist + 256;
    LAS unsigned* wtot = hist + 272;
    const float* AFF = (const float*)(a.ws + WS_AFF); int* SMAP = (int*)(a.ws + WS_SMAP); int* TOK = (int*)(a.ws + WS_TOK); float* GATE = (float*)(a.ws + WS_GATE);
    for (int prob = blockIdx.x; prob < NB * NE; prob += gridDim.x) {
        const int b = prob >> 4, e = prob & 15;
        const v4u* src = (const v4u*)(AFF + (size_t)prob * 4096) + 2 * tid;
        const v4u k0 = src[0], k1 = src[1];
        unsigned key[8] = {k0.x, k0.y, k0.z, k0.w, k1.x, k1.y, k1.z, k1.w};
        unsigned prefix = 0u, kk = CAP;
#pragma unroll
        for (int pass = 0; pass < 4; ++pass) {
            const int shift = 24 - 8 * pass; const unsigned mhi = pass == 0 ? 0u : (0xFFFFFFFFu << (shift + 8));
            __syncthreads();
            if (tid < 256) hist[tid] = 0u;
            __syncthreads();
#pragma unroll
            for (int i = 0; i < 8; ++i) if ((key[i] & mhi) == prefix) __hip_atomic_fetch_add(&hist[(key[i] >> shift) & 255u], 1u, __ATOMIC_RELAXED, __HIP_MEMORY_SCOPE_WORKGROUP);
            __syncthreads();
            if (wave == 0) {
                const unsigned c0 = hist[4 * lane], c1 = hist[4 * lane + 1], c2 = hist[4 * lane + 2], c3 = hist[4 * lane + 3];
                const unsigned tot = c0 + c1 + c2 + c3;
                unsigned suf = tot;
#pragma unroll
                for (int o = 1; o < 64; o <<= 1) { const unsigned t = __shfl_down(suf, o); if (lane + o < 64) suf += t; }
                unsigned gt = suf - tot;
                if (gt < kk && kk <= gt + c3) { sh[0] = 4 * lane + 3; sh[1] = kk - gt; } gt += c3;
                if (gt < kk && kk <= gt + c2) { sh[0] = 4 * lane + 2; sh[1] = kk - gt; } gt += c2;
                if (gt < kk && kk <= gt + c1) { sh[0] = 4 * lane + 1; sh[1] = kk - gt; } gt += c1;
                if (gt < kk && kk <= gt + c0) { sh[0] = 4 * lane + 0; sh[1] = kk - gt; }
            }
            __syncthreads();
            prefix |= sh[0] << shift; kk = sh[1];
        }
        unsigned cg = 0u, ce = 0u;
#pragma unroll
        for (int i = 0; i < 8; ++i) { cg += key[i] > prefix ? 1u : 0u; ce += key[i] == prefix ? 1u : 0u; }
        const unsigned mine = cg | (ce << 16);
        unsigned inc = mine;
#pragma unroll
        for (int o = 1; o < 64; o <<= 1) { const unsigned t = __shfl_up(inc, o); if (lane >= o) inc += t; }
        __syncthreads();
        if (lane == 63) wtot[wave] = inc;
        __syncthreads();
        unsigned base = 0u;
#pragma unroll
        for (int w = 0; w < 8; ++w) base += (w < wave) ? wtot[w] : 0u;
        const unsigned exc = base + inc - mine;
        unsigned gb = exc & 0xffffu, eb = exc >> 16;
        const int srow0 = (e * 8 + b) * CAP;
#pragma unroll
        for (int i = 0; i < 8; ++i) { const int s = 8 * tid + i; int slot = -1;
            if (key[i] > prefix) { slot = (int)(gb + (eb < kk ? eb : kk)); gb++; }
            else if (key[i] == prefix) { if (eb < kk) slot = (int)(gb + eb); eb++; }
            int sr = -1;
            if (slot >= 0) { sr = srow0 + slot; TOK[sr] = b * 4096 + s; GATE[sr] = __builtin_bit_cast(float, key[i]); }
            SMAP[(size_t)prob * 4096 + s] = sr; }
    }
}

__device__ __forceinline__ void gather_phase(const Args& a) {
    int tid = threadIdx.x; asm volatile("" : "+v"(tid)); const int lane = tid & 63, wave = __builtin_amdgcn_readfirstlane(tid >> 6);
    const bf16* H = (const bf16*)(a.ws + WS_H); bf16* XIN = (bf16*)(a.ws + WS_XIN); const int* TOK = (const int*)(a.ws + WS_TOK);
    const int gw = blockIdx.x * 8 + wave, NGW = gridDim.x * 8;
    for (int blk = gw; blk < NSLOT / 64; blk += NGW) {
        const int r0 = blk * 64; const int tokv = TOK[r0 + lane];
#pragma unroll 1
        for (int i0 = 0; i0 < 64; i0 += 8) {
            v4u x[8][2];
#pragma unroll
            for (int i = 0; i < 8; ++i) { const int tok = __builtin_amdgcn_readlane(tokv, i0 + i); const v4u* sp = (const v4u*)(H + (size_t)tok * D) + lane; x[i][0] = sp[0]; x[i][1] = sp[64]; }
#pragma unroll
            for (int i = 0; i < 8; ++i) { v4u* dp = (v4u*)(XIN + (size_t)(r0 + i0 + i) * D) + lane; dp[0] = x[i][0]; dp[64] = x[i][1]; }
        }
    }
}

__device__ __forceinline__ void combine_phase(const Args& a, int layer) {
    int tid = threadIdx.x; asm volatile("" : "+v"(tid)); const int lane = tid & 63, wave = __builtin_amdgcn_readfirstlane(tid >> 6);
    const bf16* Y = (const bf16*)(a.ws + WS_Y); const int* SMAP = (const int*)(a.ws + WS_SMAP); bf16* H = (bf16*)(a.ws + WS_H);
    const int gw = blockIdx.x * 8 + wave, NGW = gridDim.x * 8;
    for (int row = gw; row < T; row += NGW) {
        const int b = row >> 12, s = row & 4095;
        const int srv = SMAP[((size_t)b * 16 + (lane & 15)) * 4096 + s];
        const f32x4* xi = (const f32x4*)((const float*)(a.ws + WS_XB) + (size_t)row * D) + lane; f32x4* xr = (f32x4*)(a.out + (size_t)row * D) + lane;
        f32x4 v[4];
#pragma unroll
        for (int j = 0; j < 4; ++j) v[j] = xi[64 * j];
        unsigned mask = (unsigned)(__builtin_amdgcn_ballot_w64(srv >= 0) & 0xffffull);
        while (mask) {
            int sr[4]; bool on[4];
#pragma unroll
            for (int k = 0; k < 4; ++k) { on[k] = mask != 0u; const int e = on[k] ? __builtin_ctz(mask) : 0; sr[k] = __builtin_amdgcn_readlane(srv, e); if (on[k]) mask &= mask - 1u; }
            v2u y[4][4];
#pragma unroll
            for (int k = 0; k < 4; ++k) { if (on[k]) { const v2u* yr = (const v2u*)(Y + (size_t)sr[k] * D) + lane;
#pragma unroll
                for (int j = 0; j < 4; ++j) y[k][j] = yr[64 * j]; } else {
#pragma unroll
                for (int j = 0; j < 4; ++j) y[k][j] = (v2u){0u, 0u}; } }
#pragma unroll
            for (int k = 0; k < 4; ++k)
#pragma unroll
                for (int j = 0; j < 4; ++j) { v[j].x += bf_lo(y[k][j].x); v[j].y += bf_hi(y[k][j].x); v[j].z += bf_lo(y[k][j].y); v[j].w += bf_hi(y[k][j].y); }
        }
#pragma unroll
        for (int j = 0; j < 4; ++j) xr[64 * j] = v[j];
        if (layer < 3) {
            const f32x4* gr = (const f32x4*)(a.mix_norm + (layer + 1) * D) + lane; float ss = 0.f;
#pragma unroll
            for (int j = 0; j < 4; ++j) ss += (v[j].x * v[j].x + v[j].y * v[j].y) + (v[j].z * v[j].z + v[j].w * v[j].w);
            const float rinv = 1.0f / sqrtf(wave_sum(ss) * (1.f / D) + EPS);
            unsigned long long* o8 = (unsigned long long*)(H + (size_t)row * D) + lane;
#pragma unroll
            for (int j = 0; j < 4; ++j) { const f32x4 y = v[j] * rinv * gr[64 * j]; o8[64 * j] = (unsigned long long)pk2(y.x, y.y) | ((unsigned long long)pk2(y.z, y.w) << 32); }
        }
    }
}

constexpr int N_PHASES = 1 + 4 * 9;
__global__ void __launch_bounds__(512, 2) mega_fwd(Args a) {
    extern __shared__ __attribute__((aligned(16))) unsigned char lds_raw[];
    LAS unsigned char* lds = (LAS unsigned char*)lds_raw;
    const int tid = threadIdx.x, lane = tid & 63, wave = __builtin_amdgcn_readfirstlane(tid >> 6);
    const int G = gridDim.x, bid = blockIdx.x;
    unsigned char* ws = a.ws;
    volatile LAS unsigned* MISC = (volatile LAS unsigned*)(lds + LDSCTL_OFF);
    if (tid < 64) MISC[tid] = 0u;
    __syncthreads();
#if !MK_MULTI
    XcdBarrier bar = xcd_barrier_post((unsigned*)(ws + WS_CTL) + CW_BAR, MISC + 8);
#define GRID_BAR() xcd_barrier(bar)
#else
#define GRID_BAR() do {} while (0)
#endif
    const int lo = a.ph_lo, hi = a.ph_hi;
#ifndef PH_EN
#define PH_EN 0x1fff
#endif
#define EN(b) ((PH_EN >> (b)) & 1)
#ifndef PH_REP
#define PH_REP 0
#endif
#define NREP(b) (1 + ((PH_REP >> (b)) & 1))
#define IN(k) (lo <= (k) && (k) < hi)
#define SEAM(k) do { if (IN((k) + 1)) GRID_BAR(); } while (0)
    bf16* H = (bf16*)(ws + WS_H);

#define PHASE(bit, k, seam, ...) do { if (EN(bit) && IN(k)) { for (int rep_ = 0; rep_ < NREP(bit); ++rep_) { if (rep_) GRID_BAR(); __VA_ARGS__ } if (seam) SEAM(k); } } while (0)
    PHASE(12, 0, true, prologue_phase(a, lds););

    for (int layer = 0; layer < 4; ++layer) {
        const int pb = 1 + 9 * layer, j = layer >> 1;
        const float* xbase = layer == 0 ? a.x : a.out;
        if ((layer & 1) == 0) {
            PHASE(0, pb + 0, true,
                { pg8::Gemm g{H, (const bf16*)(ws + WS_WIN) + (size_t)j * 6144 * 1024, T, GW, D}; pg8::StaticOrder S; S.init(T, GW, G, bid);
                  pg8::EpiGeluBf16 E{(bf16*)(ws + WS_U), GW, a.gm_b_in + j * 6144};
                  pg8::gemm_phase<pg8::EpiGeluBf16, pg8::StaticOrder, true, true>(lds, g, S, E); }
                { pg8::Gemm g{(const bf16*)(ws + WS_WIN) + (size_t)j * 6144 * 1024 + (size_t)GW * 1024, H, GW, T, D}; pg8::StaticOrder S; S.init(GW, T, G, bid);
                  pg8::EpiVT E{(bf16*)(ws + WS_VT), T, a.gm_b_in + j * 6144 + GW, (float*)(ws + WS_SSQ)};
                  pg8::gemm_phase<pg8::EpiVT, pg8::StaticOrder, true, true>(lds, g, S, E); });
            PHASE(1, pb + 1, true, gating_phase(a, j, lds););
            PHASE(2, pb + 2, true,
                pg8::Gemm g{(const bf16*)(ws + WS_UV), (const bf16*)(ws + WS_WOUT) + (size_t)j * 1024 * 3072, T, D, GW}; pg8::StaticOrder S; S.init(T, D, G, bid);
                pg8::EpiResid E{xbase, (float*)(ws + WS_XB), D, a.gm_b_out + j * D};
                pg8::gemm_phase<pg8::EpiResid, pg8::StaticOrder, true, true>(lds, g, S, E););
        } else {
            PHASE(3, pb + 0, true,
                pg8::Gemm g{H, (const bf16*)(ws + WS_WQKV) + (size_t)j * QKVW * 1024, T, QKVW, D}; pg8::StaticOrder S; S.init(T, QKVW, G, bid);
                pg8::EpiQKV E{(bf16*)(ws + WS_QKV), a.at_q_norm + j * 192, a.at_k_norm + j * 192};
                pg8::gemm_phase<pg8::EpiQKV, pg8::StaticOrder, true, true>(lds, g, S, E););
            PHASE(4, pb + 1, true, for (int q_ = 0; q_ < NREP(13); ++q_) { if (q_) GRID_BAR(); attn_phase(a, lds); } GRID_BAR(); for (int q_ = 0; q_ < NREP(14); ++q_) { if (q_) GRID_BAR(); attn_merge_phase(a); });
            PHASE(5, pb + 2, true,
                pg8::Gemm g{(const bf16*)(ws + WS_O), (const bf16*)(ws + WS_WO) + (size_t)j * 1024 * 512, T, D, AW}; pg8::StaticOrder S; S.init(T, D, G, bid);
                pg8::EpiResid E{xbase, (float*)(ws + WS_XB), D, nullptr};
                pg8::gemm_phase<pg8::EpiResid, pg8::StaticOrder, true, true>(lds, g, S, E););
        }
        PHASE(6, pb + 3, true, router_phase(a, layer, lds););
        PHASE(7, pb + 4, true, topk_phase(a, lds););
        PHASE(9, pb + 6, true,
            pg8::Gemm g{H, (const bf16*)(ws + WS_W13) + (size_t)layer * 16 * 4096 * 1024, NSLOT, 16 * 4096, D}; pg8::MoeOrder1 S{G, bid};
            pg8::EpiSwiGLU E{(bf16*)(ws + WS_HID)};
            pg8::gemm_phase_gather<pg8::EpiSwiGLU, pg8::MoeOrder1>(lds, g, (const int*)(ws + WS_TOK), S, E););
        PHASE(10, pb + 7, true,
            pg8::Gemm g{(const bf16*)(ws + WS_HID), (const bf16*)(ws + WS_W2) + (size_t)layer * 16 * 1024 * 2048, NSLOT, 16 * 1024, DE}; pg8::MoeOrder2 S{G, bid};
            pg8::EpiGate E{(bf16*)(ws + WS_Y), (const float*)(ws + WS_GATE)};
            pg8::gemm_phase<pg8::EpiGate, pg8::MoeOrder2, true, true>(lds, g, S, E););
        PHASE(11, pb + 8, layer < 3, combine_phase(a, layer););
    }
#undef PHASE
#undef IN
#undef SEAM
}

extern "C" void kernel_launch(void* const* d_in, const int* in_sizes, int n_in, void* d_out, int out_size, void* d_ws, size_t ws_size, hipStream_t stream) {
    static int grid = 0;
    if (grid == 0) {
        if (n_in != 19 || out_size != T * D || ws_size < WS_END) { fprintf(stderr, "kernel_launch: unexpected shapes (n_in %d, out %d, ws %zu < %zu)\n", n_in, out_size, ws_size, (size_t)WS_END); grid = -1; return; }
        int dev = 0, cus = 0, per_cu = 0;
        if (hipGetDevice(&dev) != hipSuccess || hipDeviceGetAttribute(&cus, hipDeviceAttributeMultiprocessorCount, dev) != hipSuccess) { grid = -1; return; }
        if (hipFuncSetAttribute((const void*)mega_fwd, hipFuncAttributeMaxDynamicSharedMemorySize, LDS_BYTES) != hipSuccess) { fprintf(stderr, "kernel_launch: hipFuncSetAttribute failed\n"); grid = -1; return; }
        if (hipOccupancyMaxActiveBlocksPerMultiprocessor(&per_cu, (const void*)mega_fwd, 512, LDS_BYTES) != hipSuccess || per_cu < 1) { fprintf(stderr, "kernel_launch: occupancy query says %d\n", per_cu); }
        (void)hipGetLastError();
        grid = cus;
    }
    if (grid < 0) return;
    (void)hipMemsetAsync((char*)d_ws + WS_CTL, 0, CTL_ZERO_BYTES, stream);
    Args a{};
    const float** ap = (const float**)&a;
    for (int i = 0; i < 19; ++i) ap[i] = (const float*)d_in[i];
    a.out = (float*)d_out; a.ws = (unsigned char*)d_ws;
#if MK_MULTI
    for (int p = 0; p < N_PHASES; ++p) { a.ph_lo = p; a.ph_hi = p + 1; hipLaunchKernelGGL(mega_fwd, dim3(grid), dim3(512), LDS_BYTES, stream, a); }
#else
    a.ph_lo = 0; a.ph_hi = N_PHASES;
    hipLaunchKernelGGL(mega_fwd, dim3(grid), dim3(512), LDS_BYTES, stream, a);
#endif
}
```

```cpp
#include <hip/hip_runtime.h>
#include <cstdio>
#include <cstdint>

#ifndef MK_MULTI
#define MK_MULTI 0
#endif

namespace pg8 {
#define PG8_LAS __attribute__((address_space(3)))
typedef unsigned short bf16_t;
typedef short bf16x8 __attribute__((ext_vector_type(8)));
typedef float f32x4 __attribute__((ext_vector_type(4)));
typedef float f32x2 __attribute__((ext_vector_type(2)));
typedef unsigned u32x4 __attribute__((ext_vector_type(4)));
typedef unsigned u32x2 __attribute__((ext_vector_type(2)));
constexpr int BM = 256, BK = 64, HALF = 128, HTB = HALF * BK * 2, STAGE_BYTES = 8 * HTB, NXCD = 8, WGM = 8;

__host__ __device__ __forceinline__ int lds_byte(int r, int c) { const int st = (r >> 4) * 2 + (c >> 5), rr = r & 15, cc = c & 31, ob = rr * 64 + cc * 2; return st * 1024 + (ob ^ (((ob >> 9) & 1) << 5)); }
__host__ __device__ __forceinline__ void stage_rc(int b, int& R, int& C) { const int st = b / 1024, sb = b % 1024, swz = sb ^ (((sb >> 9) & 1) << 5); R = (st >> 1) * 16 + swz / 64; C = (st & 1) * 32 + (swz % 64) / 2; }
__host__ __device__ __forceinline__ int perm32(int rho) { const int n = rho >> 4, i = rho & 15; return 8 * (i >> 2) + 4 * n + (i & 3); }

struct Unit { int pm, pn; };
struct Gemm { const bf16_t* A; const bf16_t* Bt; int M, N, K; };

struct StaticOrder {
    int nM, nN, nwg, G, c;
    __host__ __device__ void init(int M, int N, int G_, int c_) { nM = M / BM; nN = N / BM; nwg = nM * nN; G = G_; c = c_; }
    __host__ __device__ bool next(int i, Unit& u) const {
        const long L = (long)i * G + c; if (L >= nwg) return false;
        int wgid = (int)L; { const int q = nwg / NXCD, r = nwg % NXCD, xcd = wgid % NXCD, off = wgid / NXCD; wgid = (xcd < r ? xcd * (q + 1) : r * (q + 1) + (xcd - r) * q) + off; }
        const int nig = WGM * nN, gid = wgid / nig, fm = gid * WGM, gsz = (nM - fm) < WGM ? (nM - fm) : WGM;
        u.pm = fm + ((wgid % nig) % gsz); u.pn = (wgid % nig) / gsz; return true;
    }
    __device__ __forceinline__ void a_ready(const Unit&) const {}
    __device__ __forceinline__ void done(const Unit&) const {}
};
struct MoeOrder1 {
    int G, c;
    __device__ bool next(int i, Unit& u) const {
        const int L = i * G + c; if (L >= 4096) return false;
        const int e = L >> 8, w = L & 255, x = w & 7, off = w >> 3;
        u.pm = e * 16 + 4 * (x >> 1) + (off & 3); u.pn = e * 16 + 8 * (x & 1) + (off >> 2); return true;
    }
    __device__ __forceinline__ void a_ready(const Unit&) const {}
    __device__ __forceinline__ void done(const Unit&) const {}
};
struct MoeOrder2 {
    int G, c;
    __device__ bool next(int i, Unit& u) const {
        const int L = i * G + c; if (L >= 1024) return false;
        const int r = L >> 8, w0 = L & 255, wg = (w0 & 7) * 32 + (w0 >> 3), e = r * 4 + (wg >> 6), w = wg & 63;
        u.pm = e * 16 + (w >> 2); u.pn = e * 4 + (w & 3); return true;
    }
    __device__ __forceinline__ void a_ready(const Unit&) const {}
    __device__ __forceinline__ void done(const Unit&) const {}
};

typedef __bf16 bf16x2_v __attribute__((ext_vector_type(2)));
__device__ __forceinline__ unsigned cvt_pk_bf16(float lo, float hi) { const f32x2 v = {lo, hi}; return __builtin_bit_cast(unsigned, __builtin_convertvector(v, bf16x2_v)); }
__device__ __forceinline__ float gelu_tanh(float x) {
    const float t = x * (1.0f + 0.044715f * x * x);
    const float e = __builtin_amdgcn_exp2f(t * (-2.0f * 0.7978845608f * 1.4426950409f));
    return x * __builtin_amdgcn_rcpf(1.0f + e);
}
__device__ __forceinline__ float silu_f(float a) { return a * __builtin_amdgcn_rcpf(1.0f + __builtin_amdgcn_exp2f(a * -1.4426950409f)); }

template <int CTRL> __device__ __forceinline__ float dpp_f(float v) { return __builtin_bit_cast(float, __builtin_amdgcn_update_dpp(0, __builtin_bit_cast(int, v), CTRL, 0xF, 0xF, true)); }
__device__ __forceinline__ float row16_sum(float v) { v += dpp_f<0xB1>(v); v += dpp_f<0x4E>(v); v += dpp_f<0x141>(v); v += dpp_f<0x140>(v); return v; }
__device__ __forceinline__ float xrow_sum(float v) {
    { auto rr = __builtin_amdgcn_permlane16_swap(__float_as_uint(v), __float_as_uint(v), false, false); v = __uint_as_float(rr[0]) + __uint_as_float(rr[1]); }
    { auto rr = __builtin_amdgcn_permlane32_swap(__float_as_uint(v), __float_as_uint(v), false, false); v = __uint_as_float(rr[0]) + __uint_as_float(rr[1]); }
    return v; }
template <class V4> __device__ __forceinline__ void xchg_rows(const V4& p0, const V4& p1, V4& s1, V4& s2) {
    const u32x4 a = __builtin_bit_cast(u32x4, p0), b = __builtin_bit_cast(u32x4, p1); u32x4 x, y;
#pragma unroll
    for (int k = 0; k < 4; ++k) { x[k] = (unsigned)__builtin_amdgcn_update_dpp((int)a[k], (int)b[k], 0x128, 0xF, 0xC, false);
                                  y[k] = (unsigned)__builtin_amdgcn_update_dpp((int)b[k], (int)a[k], 0x128, 0xF, 0x3, false); }
    s1 = __builtin_bit_cast(V4, x); s2 = __builtin_bit_cast(V4, y);
}
struct EpiGeluBf16 {
    static constexpr bool PERM = true, AFTER_DRAIN = false;
    bf16_t* O; int ldc; const float* bias;
    __device__ __forceinline__ void operator()(const f32x4 (&acc)[2][2][4][2], const Unit& u, int wr, int wc, int fr, int fq) const {
        const int rowb = u.pm * BM + wr * 64, colw = u.pn * BM + wc * 64;
        f32x4 bv[2][2];
#pragma unroll
        for (int bj = 0; bj < 2; ++bj)
#pragma unroll
            for (int n = 0; n < 2; ++n) bv[bj][n] = *(const f32x4*)(bias + colw + 32 * bj + 8 * fq + 4 * n);
        bf16_t* ob = O + (size_t)(rowb + (fr & 7)) * ldc + colw + (fr >> 3) * 32 + 8 * fq;
#pragma unroll
        for (int ai = 0; ai < 2; ++ai)
#pragma unroll
            for (int m = 0; m < 4; ++m) { u32x4 w[2];
#pragma unroll
                for (int bj = 0; bj < 2; ++bj) { const f32x4 v0 = acc[ai][bj][m][0] + bv[bj][0], v1 = acc[ai][bj][m][1] + bv[bj][1];
                    w[bj].x = cvt_pk_bf16(gelu_tanh(v0[0]), gelu_tanh(v0[1])); w[bj].y = cvt_pk_bf16(gelu_tanh(v0[2]), gelu_tanh(v0[3]));
                    w[bj].z = cvt_pk_bf16(gelu_tanh(v1[0]), gelu_tanh(v1[1])); w[bj].w = cvt_pk_bf16(gelu_tanh(v1[2]), gelu_tanh(v1[3])); }
                u32x4 s1, s2; xchg_rows(w[0], w[1], s1, s2);
                bf16_t* rp = ob + (size_t)(ai * HALF + m * 16) * ldc;
                *(u32x4*)rp = s1; *(u32x4*)(rp + (size_t)8 * ldc) = s2; }
    }
};
struct EpiVT {
    static constexpr bool PERM = true, AFTER_DRAIN = false;
    bf16_t* VT; int ldc; const float* bias; float* ssq;
    __device__ __forceinline__ void operator()(const f32x4 (&acc)[2][2][4][2], const Unit& u, int wr, int wc, int fr, int fq) const {
        const int rowb = u.pm * BM + wr * 64, colw = u.pn * BM + wc * 64;
        f32x4 cs[2][2];
#pragma unroll
        for (int bj = 0; bj < 2; ++bj)
#pragma unroll
            for (int n = 0; n < 2; ++n) cs[bj][n] = (f32x4){0.f, 0.f, 0.f, 0.f};
        bf16_t* ob = VT + ((size_t)(2 * u.pn + (wc >> 1)) * 3072 + rowb + (fr & 7)) * 128 + (wc & 1) * 64 + (fr >> 3) * 32 + 8 * fq;
#pragma unroll
        for (int ai = 0; ai < 2; ++ai)
#pragma unroll
            for (int m = 0; m < 4; ++m) { const int e = rowb + fr + ai * HALF + m * 16; const float b = bias[e]; u32x4 w[2];
#pragma unroll
                for (int bj = 0; bj < 2; ++bj) { f32x4 v0 = acc[ai][bj][m][0] + b, v1 = acc[ai][bj][m][1] + b;
#pragma unroll
                    for (int j = 0; j < 4; ++j) { v0[j] = gelu_tanh(v0[j]); v1[j] = gelu_tanh(v1[j]); }
                    cs[bj][0] += v0 * v0; cs[bj][1] += v1 * v1;
                    w[bj].x = cvt_pk_bf16(v0[0], v0[1]); w[bj].y = cvt_pk_bf16(v0[2], v0[3]); w[bj].z = cvt_pk_bf16(v1[0], v1[1]); w[bj].w = cvt_pk_bf16(v1[2], v1[3]); }
                u32x4 s1, s2; xchg_rows(w[0], w[1], s1, s2);
                bf16_t* rp = ob + (size_t)(ai * HALF + m * 16) * 128;
                *(u32x4*)rp = s1; *(u32x4*)(rp + 8 * 128) = s2; }
#pragma unroll
        for (int bj = 0; bj < 2; ++bj)
#pragma unroll
            for (int n = 0; n < 2; ++n)
#pragma unroll
                for (int j = 0; j < 4; ++j) cs[bj][n][j] = row16_sum(cs[bj][n][j]);
        if (fr == 0) {
            float* sp = ssq + (size_t)(2 * u.pm + wr) * ldc + colw + 8 * fq;
#pragma unroll
            for (int bj = 0; bj < 2; ++bj)
#pragma unroll
                for (int n = 0; n < 2; ++n) *(f32x4*)(sp + 32 * bj + 4 * n) = cs[bj][n];
        }
    }
};
struct EpiResid {
    static constexpr bool PERM = false, AFTER_DRAIN = false;
    const float* base; float* out; int ldc; const float* bias;
    __device__ __forceinline__ void operator()(const f32x4 (&acc)[2][2][4][2], const Unit& u, int wr, int wc, int fr, int fq) const {
        const int rowb = u.pm * BM + wr * 64, colw = u.pn * BM + wc * 64;
        const int cS = colw + (fr >> 3) * 16 + 4 * fq;
        f32x4 bv[2];
#pragma unroll
        for (int bj = 0; bj < 2; ++bj) bv[bj] = bias ? *(const f32x4*)(bias + cS + 32 * bj) : (f32x4){0.f, 0.f, 0.f, 0.f};
#pragma unroll
        for (int ai = 0; ai < 2; ++ai)
#pragma unroll
            for (int m = 0; m < 4; ++m) { const size_t off = (size_t)(rowb + ai * HALF + m * 16 + (fr & 7)) * ldc + cS;
#pragma unroll
                for (int bj = 0; bj < 2; ++bj) { f32x4 s1, s2; xchg_rows(acc[ai][bj][m][0], acc[ai][bj][m][1], s1, s2);
                    const f32x4 b1 = *(const f32x4*)(base + off + 32 * bj), b2 = *(const f32x4*)(base + off + (size_t)8 * ldc + 32 * bj);
                    *(f32x4*)(out + off + 32 * bj) = b1 + s1 + bv[bj]; *(f32x4*)(out + off + (size_t)8 * ldc + 32 * bj) = b2 + s2 + bv[bj]; }
                asm volatile("" ::: "memory"); }
    }
};
struct EpiQKV {
    static constexpr bool PERM = true, AFTER_DRAIN = false;
    bf16_t* QKV; const float* qg; const float* kg;
    __device__ __forceinline__ void operator()(const f32x4 (&acc)[2][2][4][2], const Unit& u, int wr, int wc, int fr, int fq) const {
        const int hd = u.pn * 4 + wc, which = hd / 24, g = (hd % 24) >> 3, h = hd & 7;
        f32x4 gv[2][2];
#pragma unroll
        for (int bj = 0; bj < 2; ++bj)
#pragma unroll
            for (int n = 0; n < 2; ++n) {
                if (which == 0) gv[bj][n] = *(const f32x4*)(qg + g * 64 + 32 * bj + 8 * fq + 4 * n) * (0.125f * 1.4426950408889634f);
                else if (which == 1) gv[bj][n] = *(const f32x4*)(kg + g * 64 + 32 * bj + 8 * fq + 4 * n);
                else gv[bj][n] = (f32x4){1.f, 1.f, 1.f, 1.f}; }
        bf16_t* hb = QKV + (size_t)(which * 3 + g) * (8 * 8 * 4096 * 64) + (size_t)h * (4096 * 64) + (fr >> 3) * 32 + 8 * fq;
#pragma unroll
        for (int ai = 0; ai < 2; ++ai)
#pragma unroll
            for (int m = 0; m < 4; ++m) {
                float ss = 0.f;
#pragma unroll
                for (int bj = 0; bj < 2; ++bj)
#pragma unroll
                    for (int n = 0; n < 2; ++n) { const f32x4 x = acc[ai][bj][m][n]; ss += (x[0] * x[0] + x[1] * x[1]) + (x[2] * x[2] + x[3] * x[3]); }
                ss = xrow_sum(ss);
                const float rinv = which < 2 ? __builtin_amdgcn_rsqf(ss * (1.0f / 64.0f) + 1e-6f) : 1.0f;
                u32x4 w[2];
#pragma unroll
                for (int bj = 0; bj < 2; ++bj) { const f32x4 v0 = acc[ai][bj][m][0] * rinv * gv[bj][0], v1 = acc[ai][bj][m][1] * rinv * gv[bj][1];
                    w[bj].x = cvt_pk_bf16(v0[0], v0[1]); w[bj].y = cvt_pk_bf16(v0[2], v0[3]); w[bj].z = cvt_pk_bf16(v1[0], v1[1]); w[bj].w = cvt_pk_bf16(v1[2], v1[3]); }
                u32x4 s1, s2; xchg_rows(w[0], w[1], s1, s2);
                const int row = u.pm * BM + ai * HALF + wr * 64 + m * 16 + (fr & 7), b = row >> 12, sq = row & 4095;
                bf16_t* dst = hb + (size_t)b * (8 * 4096 * 64) + (size_t)sq * 64;
                *(u32x4*)dst = s1; *(u32x4*)(dst + 8 * 64) = s2; }
    }
};
struct EpiSwiGLU {
    static constexpr bool PERM = true, AFTER_DRAIN = false;
    bf16_t* HID;
    __device__ __forceinline__ void operator()(const f32x4 (&acc)[2][2][4][2], const Unit& u, int wr, int wc, int fr, int fq) const {
        const int row0 = u.pm * BM + wr * 64 + fr, col0 = (u.pn & 15) * HALF + wc * 32 + 8 * fq;
#pragma unroll
        for (int ai = 0; ai < 2; ++ai)
#pragma unroll
            for (int m = 0; m < 4; ++m) { bf16_t* rowp = HID + (size_t)(row0 + ai * HALF + m * 16) * 2048 + col0;
                const f32x4 a0 = acc[ai][0][m][0], a1 = acc[ai][0][m][1], b0 = acc[ai][1][m][0], b1 = acc[ai][1][m][1];
                u32x4 w; w.x = cvt_pk_bf16(silu_f(a0[0]) * b0[0], silu_f(a0[1]) * b0[1]); w.y = cvt_pk_bf16(silu_f(a0[2]) * b0[2], silu_f(a0[3]) * b0[3]);
                w.z = cvt_pk_bf16(silu_f(a1[0]) * b1[0], silu_f(a1[1]) * b1[1]); w.w = cvt_pk_bf16(silu_f(a1[2]) * b1[2], silu_f(a1[3]) * b1[3]);
                *(u32x4*)rowp = w; }
    }
};
struct EpiGate {
    static constexpr bool PERM = true, AFTER_DRAIN = false;
    bf16_t* Y; const float* gate;
    __device__ __forceinline__ void operator()(const f32x4 (&acc)[2][2][4][2], const Unit& u, int wr, int wc, int fr, int fq) const {
        const int rowb = u.pm * BM + wr * 64, colw = (u.pn & 3) * BM + wc * 64;
        bf16_t* ob = Y + (size_t)(rowb + (fr & 7)) * 1024 + colw + (fr >> 3) * 32 + 8 * fq;
#pragma unroll
        for (int ai = 0; ai < 2; ++ai)
#pragma unroll
            for (int m = 0; m < 4; ++m) { const float gt = gate[rowb + fr + ai * HALF + m * 16]; u32x4 w[2];
#pragma unroll
                for (int bj = 0; bj < 2; ++bj) { const f32x4 v0 = acc[ai][bj][m][0] * gt, v1 = acc[ai][bj][m][1] * gt;
                    w[bj].x = cvt_pk_bf16(v0[0], v0[1]); w[bj].y = cvt_pk_bf16(v0[2], v0[3]); w[bj].z = cvt_pk_bf16(v1[0], v1[1]); w[bj].w = cvt_pk_bf16(v1[2], v1[3]); }
                u32x4 s1, s2; xchg_rows(w[0], w[1], s1, s2);
                bf16_t* rp = ob + (size_t)(ai * HALF + m * 16) * 1024;
                *(u32x4*)rp = s1; *(u32x4*)(rp + 8 * 1024) = s2; }
    }
};

template <class Epi, class Sched, bool ALIGN_EPI = false, bool SP2 = false>
__device__ __forceinline__ void gemm_phase(PG8_LAS unsigned char* lds, const Gemm g, const Sched& S, const Epi& E) {
    int tid_ = threadIdx.x; asm volatile("" : "+v"(tid_));
    const int tid = tid_, wid = __builtin_amdgcn_readfirstlane(tid >> 6), lane = tid & 63, wr = wid >> 2, wc = wid & 3, fr = lane & 15, fq = lane >> 4;
    const int K = g.K, nt = K / BK;
    unsigned voffA[2], voffB0[2], voffB1[2];
#pragma unroll
    for (int i = 0; i < 2; ++i) { int R, C; stage_rc(tid * 16 + i * 8192, R, C); const int Rb = 64 * (R >> 5) + (Epi::PERM ? perm32(R & 31) : (R & 31));
        voffA[i] = (unsigned)(R * K + C) * 2u; voffB0[i] = (unsigned)(Rb * K + C) * 2u; voffB1[i] = (unsigned)((Rb + 32) * K + C) * 2u; }
    const size_t kstep = (size_t)(BK * 2);
    const size_t hstep = (size_t)HALF * K * 2;
    const size_t tstep = 2 * hstep;
    const unsigned ldsw = (unsigned)wid * 1024u;
    const int aoff = lds_byte(wr * 64 + fr, fq * 8), boff = lds_byte(wc * 32 + fr, fq * 8);
#define PG8_SA(b, h) (((b) * 2 + (h)) * HTB)
#define PG8_SB(b, h) ((4 + (b) * 2 + (h)) * HTB)
#define PG8_STAGE(bufoff, gbase, voff) do { _Pragma("unroll") for (int _i = 0; _i < 2; ++_i) \
        __builtin_amdgcn_global_load_lds((const unsigned*)((const char*)(gbase) + (voff)[_i]), (PG8_LAS unsigned*)(lds + (bufoff) + ldsw + _i * 8192), 16, 0, 0); } while (0)
#define PG8_LDA(dst, b, h) do { _Pragma("unroll") for (int m = 0; m < 4; ++m) _Pragma("unroll") for (int k = 0; k < 2; ++k) dst[m][k] = *(const PG8_LAS bf16x8*)(lds + PG8_SA(b, h) + aoff + m * 2048 + k * 1024); } while (0)
#define PG8_LDB(dst, b, h) do { _Pragma("unroll") for (int n = 0; n < 2; ++n) _Pragma("unroll") for (int k = 0; k < 2; ++k) dst[n][k] = *(const PG8_LAS bf16x8*)(lds + PG8_SB(b, h) + boff + n * 2048 + k * 1024); } while (0)
#define PG8_MMA(ai, bj, At, Bt) do { __builtin_amdgcn_s_setprio(1); _Pragma("unroll") for (int m = 0; m < 4; ++m) _Pragma("unroll") for (int n = 0; n < 2; ++n) _Pragma("unroll") for (int k = 0; k < 2; ++k) \
        acc[ai][bj][m][n] = __builtin_amdgcn_mfma_f32_16x16x32_bf16(Bt[n][k], At[m][k], acc[ai][bj][m][n], 0, 0, 0); __builtin_amdgcn_s_setprio(0); } while (0)
#define PG8_WAIT_V(n) asm volatile("s_waitcnt vmcnt(" #n ")" ::: "memory")
#define PG8_WAIT_L(n) asm volatile("s_waitcnt lgkmcnt(" #n ")" ::: "memory")
#define PG8_BAR __builtin_amdgcn_s_barrier()
#define PG8_SCHED __builtin_amdgcn_sched_barrier(0)
    Unit cur, nxt; int ui = 0;
    if (!S.next(0, cur)) return;
    f32x4 acc[2][2][4][2];
#pragma unroll
    for (int a = 0; a < 2; ++a)
#pragma unroll
        for (int b = 0; b < 2; ++b)
#pragma unroll
            for (int m = 0; m < 4; ++m)
#pragma unroll
                for (int n = 0; n < 2; ++n) acc[a][b][m][n] = (f32x4){0.f, 0.f, 0.f, 0.f};
    bf16x8 At[4][2], B0[2][2], B1[2][2];
    const char* cA = (const char*)g.A + (size_t)cur.pm * tstep; const char* cB = (const char*)g.Bt + (size_t)cur.pn * tstep;
    S.a_ready(cur);
    if constexpr (SP2) {
        PG8_STAGE(PG8_SB(0, 0), cB, voffB0); PG8_STAGE(PG8_SB(0, 1), cB, voffB1); PG8_STAGE(PG8_SA(0, 0), cA, voffA); PG8_STAGE(PG8_SA(0, 1), cA + hstep, voffA);
        if (wr == 1) PG8_BAR;
        PG8_WAIT_V(2); PG8_BAR;
        PG8_STAGE(PG8_SB(1, 0), cB + kstep, voffB0); PG8_STAGE(PG8_SA(1, 0), cA + kstep, voffA); PG8_STAGE(PG8_SB(1, 1), cB + kstep, voffB1);
        PG8_WAIT_V(6); PG8_BAR;
    } else {
        PG8_STAGE(PG8_SB(0, 0), cB, voffB0); PG8_STAGE(PG8_SA(0, 0), cA, voffA); PG8_STAGE(PG8_SB(0, 1), cB, voffB1); PG8_STAGE(PG8_SA(0, 1), cA + hstep, voffA);
        if (wr == 1) PG8_BAR;
        PG8_WAIT_V(4); PG8_BAR;
        PG8_STAGE(PG8_SB(1, 0), cB + kstep, voffB0); PG8_STAGE(PG8_SA(1, 0), cA + kstep, voffA); PG8_STAGE(PG8_SB(1, 1), cB + kstep, voffB1);
        PG8_WAIT_V(6); PG8_BAR;
    }
    for (;;) {
        const bool has_next = S.next(ui + 1, nxt);
        const char* nA = has_next ? (const char*)g.A + (size_t)nxt.pm * tstep : cA; const char* nB = has_next ? (const char*)g.Bt + (size_t)nxt.pn * tstep : cB;
        for (int t = 0; t < nt; t += 2) {
            const bool last = (t == nt - 2);
            const char* a1 = cA + (size_t)(t + 1) * kstep;
            const char* a2 = last ? nA : cA + (size_t)(t + 2) * kstep; const char* b2 = last ? nB : cB + (size_t)(t + 2) * kstep;
            const char* a3 = a2 + kstep; const char* b3 = b2 + kstep;
            if (last && has_next) S.a_ready(nxt);
            if constexpr (SP2) {
            PG8_LDB(B0, 0, 0); PG8_LDB(B1, 0, 1); PG8_SCHED; PG8_LDA(At, 0, 0); PG8_STAGE(PG8_SA(1, 1), a1 + hstep, voffA);
            PG8_WAIT_V(8); PG8_WAIT_L(0); PG8_BAR; PG8_MMA(0, 0, At, B0); PG8_MMA(0, 1, At, B1); PG8_BAR; PG8_SCHED;
            PG8_LDA(At, 0, 1); PG8_STAGE(PG8_SB(0, 0), b2, voffB0); PG8_STAGE(PG8_SB(0, 1), b2, voffB1); PG8_STAGE(PG8_SA(0, 0), a2, voffA);
            PG8_WAIT_V(8); PG8_WAIT_L(0); PG8_BAR; PG8_MMA(1, 0, At, B0); PG8_MMA(1, 1, At, B1); PG8_BAR; PG8_SCHED;
            PG8_LDB(B0, 1, 0); PG8_LDB(B1, 1, 1); PG8_SCHED; PG8_LDA(At, 1, 0); PG8_STAGE(PG8_SA(0, 1), a2 + hstep, voffA);
            PG8_WAIT_V(8); PG8_WAIT_L(0); PG8_BAR; PG8_MMA(0, 0, At, B0); PG8_MMA(0, 1, At, B1); PG8_BAR; PG8_SCHED;
            PG8_LDA(At, 1, 1); PG8_STAGE(PG8_SB(1, 0), b3, voffB0); PG8_STAGE(PG8_SB(1, 1), b3, voffB1); PG8_STAGE(PG8_SA(1, 0), a3, voffA);
            PG8_WAIT_V(8); PG8_WAIT_L(0); PG8_BAR; PG8_MMA(1, 0, At, B0); PG8_MMA(1, 1, At, B1); PG8_BAR; PG8_SCHED;
            } else {
            PG8_LDB(B0, 0, 0); PG8_SCHED; PG8_LDA(At, 0, 0); PG8_STAGE(PG8_SA(1, 1), a1 + hstep, voffA);
            PG8_WAIT_L(8); PG8_BAR; PG8_WAIT_L(0); PG8_MMA(0, 0, At, B0); PG8_BAR; PG8_SCHED;
            PG8_LDB(B1, 0, 1); PG8_STAGE(PG8_SB(0, 0), b2, voffB0);
            PG8_BAR; PG8_WAIT_L(0); PG8_MMA(0, 1, At, B1); PG8_BAR;
            PG8_LDA(At, 0, 1); PG8_STAGE(PG8_SA(0, 0), a2, voffA);
            PG8_BAR; PG8_WAIT_L(0); PG8_MMA(1, 0, At, B0); PG8_BAR; PG8_SCHED;
            PG8_STAGE(PG8_SB(0, 1), b2, voffB1);
            PG8_WAIT_V(6); PG8_BAR; PG8_MMA(1, 1, At, B1); PG8_BAR;
            PG8_LDB(B0, 1, 0); PG8_SCHED; PG8_LDA(At, 1, 0); PG8_STAGE(PG8_SA(0, 1), a2 + hstep, voffA);
            PG8_WAIT_L(8); PG8_BAR; PG8_WAIT_L(0); PG8_MMA(0, 0, At, B0); PG8_BAR; PG8_SCHED;
            PG8_LDB(B1, 1, 1); PG8_STAGE(PG8_SB(1, 0), b3, voffB0);
            PG8_BAR; PG8_WAIT_L(0); PG8_MMA(0, 1, At, B1); PG8_BAR;
            PG8_LDA(At, 1, 1); PG8_STAGE(PG8_SA(1, 0), a3, voffA);
            PG8_BAR; PG8_WAIT_L(0); PG8_MMA(1, 0, At, B0); PG8_BAR; PG8_SCHED;
            PG8_STAGE(PG8_SB(1, 1), b3, voffB1);
            PG8_WAIT_V(6); PG8_BAR; PG8_MMA(1, 1, At, B1); PG8_BAR;
            }
        }
        if constexpr (ALIGN_EPI) { if (wr == 0) PG8_BAR; }
        if constexpr (!Epi::AFTER_DRAIN) { E(acc, cur, wr, wc, fr, fq); S.done(cur); }
        if (!has_next) break;
#pragma unroll
        for (int a = 0; a < 2; ++a)
#pragma unroll
            for (int b = 0; b < 2; ++b)
#pragma unroll
                for (int m = 0; m < 4; ++m)
#pragma unroll
                    for (int n = 0; n < 2; ++n) acc[a][b][m][n] = (f32x4){0.f, 0.f, 0.f, 0.f};
        cur = nxt; cA = nA; cB = nB; ++ui;
        if constexpr (ALIGN_EPI) { if (wr == 1) PG8_BAR; }
    }
    PG8_WAIT_V(0);
    if constexpr (!ALIGN_EPI) { if (wr == 0) PG8_BAR; }
    PG8_BAR;
#undef PG8_SA
#undef PG8_SB
#undef PG8_STAGE
#undef PG8_LDA
#undef PG8_LDB
#undef PG8_MMA
#undef PG8_WAIT_V
#undef PG8_WAIT_L
#undef PG8_BAR
#undef PG8_SCHED
}
template <class Epi, class Sched>
__device__ __forceinline__ void gemm_phase_gather(PG8_LAS unsigned char* lds, const Gemm g, const int* rowmap, const Sched& S, const Epi& E) {
    constexpr bool ALIGN_EPI = true, SP2 = true;
    int tid_ = threadIdx.x; asm volatile("" : "+v"(tid_));
    const int tid = tid_, wid = __builtin_amdgcn_readfirstlane(tid >> 6), lane = tid & 63, wr = wid >> 2, wc = wid & 3, fr = lane & 15, fq = lane >> 4;
    const int K = g.K, nt = K / BK;
    unsigned voffB0[2], voffB1[2]; int rA[2]; unsigned cA2[2];
#pragma unroll
    for (int i = 0; i < 2; ++i) { int R, C; stage_rc(tid * 16 + i * 8192, R, C); const int Rb = 64 * (R >> 5) + (Epi::PERM ? perm32(R & 31) : (R & 31));
        rA[i] = R; cA2[i] = (unsigned)C * 2u; voffB0[i] = (unsigned)(Rb * K + C) * 2u; voffB1[i] = (unsigned)((Rb + 32) * K + C) * 2u; }
    const unsigned rowb = (unsigned)K * 2u;
    const size_t kstep = (size_t)(BK * 2);
    const size_t hstep = (size_t)HALF * K * 2;
    const size_t tstep = 2 * hstep;
    const unsigned ldsw = (unsigned)wid * 1024u;
    const int aoff = lds_byte(wr * 64 + fr, fq * 8), boff = lds_byte(wc * 32 + fr, fq * 8);
#define PG8_SA(b, h) (((b) * 2 + (h)) * HTB)
#define PG8_SB(b, h) ((4 + (b) * 2 + (h)) * HTB)
#define PG8_STAGE(bufoff, gbase, voff) do { _Pragma("unroll") for (int _i = 0; _i < 2; ++_i) \
        __builtin_amdgcn_global_load_lds((const unsigned*)((const char*)(gbase) + (voff)[_i]), (PG8_LAS unsigned*)(lds + (bufoff) + ldsw + _i * 8192), 16, 0, 0); } while (0)
#define PG8_LDA(dst, b, h) do { _Pragma("unroll") for (int m = 0; m < 4; ++m) _Pragma("unroll") for (int k = 0; k < 2; ++k) dst[m][k] = *(const PG8_LAS bf16x8*)(lds + PG8_SA(b, h) + aoff + m * 2048 + k * 1024); } while (0)
#define PG8_LDB(dst, b, h) do { _Pragma("unroll") for (int n = 0; n < 2; ++n) _Pragma("unroll") for (int k = 0; k < 2; ++k) dst[n][k] = *(const PG8_LAS bf16x8*)(lds + PG8_SB(b, h) + boff + n * 2048 + k * 1024); } while (0)
#define PG8_MMA(ai, bj, At, Bt) do { __builtin_amdgcn_s_setprio(1); _Pragma("unroll") for (int m = 0; m < 4; ++m) _Pragma("unroll") for (int n = 0; n < 2; ++n) _Pragma("unroll") for (int k = 0; k < 2; ++k) \
        acc[ai][bj][m][n] = __builtin_amdgcn_mfma_f32_16x16x32_bf16(Bt[n][k], At[m][k], acc[ai][bj][m][n], 0, 0, 0); __builtin_amdgcn_s_setprio(0); } while (0)
#define PG8_WAIT_V(n) asm volatile("s_waitcnt vmcnt(" #n ")" ::: "memory")
#define PG8_WAIT_L(n) asm volatile("s_waitcnt lgkmcnt(" #n ")" ::: "memory")
#define PG8_BAR __builtin_amdgcn_s_barrier()
#define PG8_SCHED __builtin_amdgcn_sched_barrier(0)
    Unit cur, nxt; int ui = 0;
    if (!S.next(0, cur)) return;
    f32x4 acc[2][2][4][2];
#pragma unroll
    for (int a = 0; a < 2; ++a)
#pragma unroll
        for (int b = 0; b < 2; ++b)
#pragma unroll
            for (int m = 0; m < 4; ++m)
#pragma unroll
                for (int n = 0; n < 2; ++n) acc[a][b][m][n] = (f32x4){0.f, 0.f, 0.f, 0.f};
    bf16x8 At[4][2], B0[2][2], B1[2][2];
    const char* const gA = (const char*)g.A; const char* cB = (const char*)g.Bt + (size_t)cur.pn * tstep;
    unsigned va[2][2], vn[2][2]; unsigned nraw[2][2];
#pragma unroll
    for (int h = 0; h < 2; ++h)
#pragma unroll
        for (int i = 0; i < 2; ++i) { va[h][i] = (unsigned)rowmap[cur.pm * BM + h * HALF + rA[i]] * rowb + cA2[i]; vn[h][i] = va[h][i]; nraw[h][i] = 0u; }
    S.a_ready(cur);
    if constexpr (SP2) {
        PG8_STAGE(PG8_SB(0, 0), cB, voffB0); PG8_STAGE(PG8_SB(0, 1), cB, voffB1); PG8_STAGE(PG8_SA(0, 0), gA, va[0]); PG8_STAGE(PG8_SA(0, 1), gA, va[1]);
        if (wr == 1) PG8_BAR;
        PG8_WAIT_V(2); PG8_BAR;
        PG8_STAGE(PG8_SB(1, 0), cB + kstep, voffB0); PG8_STAGE(PG8_SA(1, 0), gA + kstep, va[0]); PG8_STAGE(PG8_SB(1, 1), cB + kstep, voffB1);
        PG8_WAIT_V(6); PG8_BAR;
    }
    for (;;) {
        const bool has_next = S.next(ui + 1, nxt);
        const char* nB = has_next ? (const char*)g.Bt + (size_t)nxt.pn * tstep : cB;
        if (has_next) {
#pragma unroll
            for (int h = 0; h < 2; ++h)
#pragma unroll
                for (int i = 0; i < 2; ++i) { const int* rp = rowmap + nxt.pm * BM + h * HALF + rA[i]; asm volatile("global_load_dword %0, %1, off" : "=v"(nraw[h][i]) : "v"(rp) : "memory"); } }
        for (int t = 0; t < nt; t += 2) {
            const bool last = (t == nt - 2);
            if (last && has_next) {
#pragma unroll
                for (int h = 0; h < 2; ++h)
#pragma unroll
                    for (int i = 0; i < 2; ++i) { unsigned x = nraw[h][i]; asm volatile("" : "+v"(x)); vn[h][i] = x * rowb + cA2[i]; } }
            const char* a1 = gA + (size_t)(t + 1) * kstep;
            const char* a2 = last ? gA : gA + (size_t)(t + 2) * kstep; const char* b2 = last ? nB : cB + (size_t)(t + 2) * kstep;
            const char* a3 = a2 + kstep; const char* b3 = b2 + kstep;
            unsigned v2[2][2];
#pragma unroll
            for (int h = 0; h < 2; ++h)
#pragma unroll
                for (int i = 0; i < 2; ++i) v2[h][i] = last ? vn[h][i] : va[h][i];
            if (last && has_next) S.a_ready(nxt);
            if constexpr (SP2) {
            PG8_LDB(B0, 0, 0); PG8_LDB(B1, 0, 1); PG8_SCHED; PG8_LDA(At, 0, 0); PG8_STAGE(PG8_SA(1, 1), a1, va[1]);
            PG8_WAIT_V(8); PG8_WAIT_L(0); PG8_BAR; PG8_MMA(0, 0, At, B0); PG8_MMA(0, 1, At, B1); PG8_BAR; PG8_SCHED;
            PG8_LDA(At, 0, 1); PG8_STAGE(PG8_SB(0, 0), b2, voffB0); PG8_STAGE(PG8_SB(0, 1), b2, voffB1); PG8_STAGE(PG8_SA(0, 0), a2, v2[0]);
            PG8_WAIT_V(8); PG8_WAIT_L(0); PG8_BAR; PG8_MMA(1, 0, At, B0); PG8_MMA(1, 1, At, B1); PG8_BAR; PG8_SCHED;
            PG8_LDB(B0, 1, 0); PG8_LDB(B1, 1, 1); PG8_SCHED; PG8_LDA(At, 1, 0); PG8_STAGE(PG8_SA(0, 1), a2, v2[1]);
            PG8_WAIT_V(8); PG8_WAIT_L(0); PG8_BAR; PG8_MMA(0, 0, At, B0); PG8_MMA(0, 1, At, B1); PG8_BAR; PG8_SCHED;
            PG8_LDA(At, 1, 1); PG8_STAGE(PG8_SB(1, 0), b3, voffB0); PG8_STAGE(PG8_SB(1, 1), b3, voffB1); PG8_STAGE(PG8_SA(1, 0), a3, v2[0]);
            PG8_WAIT_V(8); PG8_WAIT_L(0); PG8_BAR; PG8_MMA(1, 0, At, B0); PG8_MMA(1, 1, At, B1); PG8_BAR; PG8_SCHED;
            }
        }
        if constexpr (ALIGN_EPI) { if (wr == 0) PG8_BAR; }
        if constexpr (!Epi::AFTER_DRAIN) { E(acc, cur, wr, wc, fr, fq); S.done(cur); }
        if (!has_next) break;
#pragma unroll
        for (int a = 0; a < 2; ++a)
#pragma unroll
            for (int b = 0; b < 2; ++b)
#pragma unroll
                for (int m = 0; m < 4; ++m)
#pragma unroll
                    for (int n = 0; n < 2; ++n) acc[a][b][m][n] = (f32x4){0.f, 0.f, 0.f, 0.f};
        cur = nxt; cB = nB; ++ui;
#pragma unroll
        for (int h = 0; h < 2; ++h)
#pragma unroll
            for (int i = 0; i < 2; ++i) va[h][i] = vn[h][i];
        if constexpr (ALIGN_EPI) { if (wr == 1) PG8_BAR; }
    }
    PG8_WAIT_V(0);
    if constexpr (!ALIGN_EPI) { if (wr == 0) PG8_BAR; }
    PG8_BAR;
#undef PG8_SA
#undef PG8_SB
#undef PG8_STAGE
#undef PG8_LDA
#undef PG8_LDB
#undef PG8_MMA
#undef PG8_WAIT_V
#undef PG8_WAIT_L
#undef PG8_BAR
#undef PG8_SCHED
}
}

constexpr int NB = 8, SEQ = 4096, D = 1024, T = NB * SEQ;
constexpr int GW = 3072;
constexpr int NE = 16, CAP = 512, DE = 2048, NSLOT = NB * NE * CAP;
constexpr int QKVW = 4608, AW = 512;
constexpr float EPS = 1e-6f;

constexpr size_t MiB = 1u << 20;
constexpr size_t WS_CTL = 0, CTL_ZERO_BYTES = 1 * MiB;
constexpr size_t WS_WIN = 1 * MiB;
constexpr size_t WS_WOUT = 25 * MiB;
constexpr size_t WS_WQKV = 37 * MiB;
constexpr size_t WS_WO = 55 * MiB;
constexpr size_t WS_W13 = 57 * MiB;
constexpr size_t WS_W2 = 569 * MiB;
constexpr size_t WS_H = 825 * MiB;
constexpr size_t WS_AFF = 889 * MiB;
constexpr size_t WS_SMAP = 891 * MiB;
constexpr size_t WS_TOK = 893 * MiB;
constexpr size_t WS_GATE = 893 * MiB + 512 * 1024;
constexpr size_t WS_XB = 894 * MiB;
constexpr size_t WS_ACT = 1022 * MiB;
constexpr size_t WS_U = WS_ACT, WS_VT = WS_ACT + 192 * MiB, WS_SSQ = WS_ACT + 384 * MiB, WS_UV = WS_ACT + 388 * MiB;
constexpr size_t WS_QKV = WS_ACT, WS_OG = WS_ACT + 288 * MiB, WS_LSE = WS_ACT + 384 * MiB, WS_O = WS_ACT + 388 * MiB;
constexpr size_t WS_XIN = WS_ACT, WS_HID = WS_ACT + 128 * MiB, WS_Y = WS_ACT + 384 * MiB;
constexpr size_t WS_END = WS_ACT + 580 * MiB;
constexpr int CW_BAR = 4096;

constexpr int RING_BYTES = 131072, LDS_BYTES = 147456, LDSCTL_OFF = LDS_BYTES - 256;

#define LAS __attribute__((address_space(3)))
typedef unsigned short bf16;
typedef unsigned v4u __attribute__((ext_vector_type(4)));
typedef unsigned v2u __attribute__((ext_vector_type(2)));
typedef float f32x4 __attribute__((ext_vector_type(4)));
typedef short bf16x8 __attribute__((ext_vector_type(8)));
#define LDS_WAIT() asm volatile("s_waitcnt lgkmcnt(0)" ::: "memory")
__device__ __forceinline__ unsigned f2bf(float f) { unsigned u = __builtin_bit_cast(unsigned, f); return (u + 0x7fffu + ((u >> 16) & 1u)) >> 16; }
typedef float f32x2_t __attribute__((ext_vector_type(2))); typedef __bf16 bf16x2_t __attribute__((ext_vector_type(2)));
__device__ __forceinline__ unsigned pk2(float lo, float hi) { const f32x2_t v = {lo, hi}; return __builtin_bit_cast(unsigned, __builtin_convertvector(v, bf16x2_t)); }
__device__ __forceinline__ float bf_lo(unsigned w) { return __builtin_bit_cast(float, w << 16); }
__device__ __forceinline__ float bf_hi(unsigned w) { return __builtin_bit_cast(float, w & 0xffff0000u); }

#define XB_TMO      128
#define XB_XCNT(j)  (256  + 64 * (j))
#define XB_XSUB(j)  (1280 + 64 * (j))
#define XB_XGEN(j)  (2304 + 64 * (j))
#define XB_TOP      3328
#define XB_TOPGEN   3392
#define XCD_BAR_WORDS 3456
#define XB_SPIN_CAP (1u << 22)
__device__ __forceinline__ unsigned xb_ld(unsigned* p)              { return __hip_atomic_load(p, __ATOMIC_RELAXED, __HIP_MEMORY_SCOPE_AGENT); }
__device__ __forceinline__ unsigned xb_add(unsigned* p, unsigned v) { return __hip_atomic_fetch_add(p, v, __ATOMIC_RELAXED, __HIP_MEMORY_SCOPE_AGENT); }
__device__ __forceinline__ unsigned xb_xcc_id() { return (unsigned)__builtin_amdgcn_s_getreg((3 << 11) | 20) & 0xFu; }
#define XB_SPIN(cond, bar) do { unsigned _sp = 0; while (cond) { __builtin_amdgcn_s_sleep(1); \
    if ((++_sp & 255u) == 0u) { if (xb_ld(&(bar)[XB_TMO])) break; if (_sp > XB_SPIN_CAP) { atomicAdd(&(bar)[XB_TMO], 1u); break; } } } } while (0)
struct XcdBarrier { unsigned* bar; unsigned x; volatile LAS unsigned* st; };
__device__ __forceinline__ XcdBarrier xcd_barrier_post(unsigned* bar, volatile LAS unsigned* st) {
    XcdBarrier b; b.bar = bar; b.x = xb_xcc_id(); b.st = st;
    if (threadIdx.x == 0) (void)xb_add(&bar[XB_XCNT(b.x)], 1u);
    return b;
}
__device__ __forceinline__ void xcd_barrier_complete(unsigned* bar, unsigned x, unsigned& nloc, unsigned& nx) {
    const unsigned G = gridDim.x * gridDim.y * gridDim.z;
    unsigned sum, cnt, mine, sp = 0u;
    for (;;) {
        sum = 0u; cnt = 0u; mine = 0u;
#pragma unroll
        for (unsigned j = 0; j < 16; ++j) { const unsigned c = xb_ld(&bar[XB_XCNT(j)]); sum += c; cnt += (c > 0u) ? 1u : 0u; mine = (j == x) ? c : mine; }
        if (sum == G) break;
        __builtin_amdgcn_s_sleep(1);
        if ((++sp & 255u) == 0u) { if (xb_ld(&bar[XB_TMO])) break; if (sp > XB_SPIN_CAP) { atomicAdd(&bar[XB_TMO], 1u); break; } }
    }
    nloc = mine > 0u ? mine : 1u; nx = cnt > 0u ? cnt : 1u;
}
__device__ __forceinline__ void xcd_barrier(const XcdBarrier& b) {
    asm volatile("s_waitcnt vmcnt(0)" ::: "memory");
    __syncthreads();
    if (threadIdx.x == 0) {
        unsigned* bar = b.bar;
        __builtin_amdgcn_s_waitcnt(0);
        unsigned nloc = b.st[0], nx = b.st[1];
        if (nloc == 0u) { xcd_barrier_complete(bar, b.x, nloc, nx); b.st[0] = nloc; b.st[1] = nx; }
        const unsigned old = xb_add(&bar[XB_XSUB(b.x)], 1u);
        const unsigned gen = old / nloc;
        if (old + 1u == (gen + 1u) * nloc) {
            __builtin_amdgcn_fence(__ATOMIC_RELEASE, "agent");
            asm volatile("s_waitcnt vmcnt(0)" ::: "memory");
            const unsigned og = xb_add(&bar[XB_TOP], 1u);
            const unsigned tg = og / nx;
            if (og + 1u == (tg + 1u) * nx) xb_add(&bar[XB_TOPGEN], 1u);
            else XB_SPIN(xb_ld(&bar[XB_TOPGEN]) == tg, bar);
            __builtin_amdgcn_fence(__ATOMIC_ACQUIRE, "agent");
            xb_add(&bar[XB_XGEN(b.x)], 1u);
            asm volatile("s_waitcnt vmcnt(0)" ::: "memory");
        } else {
            XB_SPIN(xb_ld(&bar[XB_XGEN(b.x)]) == gen, bar);
            __builtin_amdgcn_fence(__ATOMIC_ACQUIRE, "agent");
            asm volatile("s_waitcnt vmcnt(0)" ::: "memory");
        }
    }
    __syncthreads();
}

struct Args {
    const float* x; const float* mix_norm; const float* ffn_norm;
    const float* gm_w_in; const float* gm_b_in; const float* gm_v_norm; const float* gm_w_s; const float* gm_b_s; const float* gm_w_out; const float* gm_b_out;
    const float* at_w_qkv; const float* at_q_norm; const float* at_k_norm; const float* at_w_o;
    const float* moe_w_router; const float* moe_b_router; const float* moe_w1; const float* moe_w3; const float* moe_w2;
    float* out; unsigned char* ws; int ph_lo, ph_hi;
};

template <int CTRL> __device__ __forceinline__ float dppf(float v) { return __builtin_bit_cast(float, __builtin_amdgcn_update_dpp(0, __builtin_bit_cast(int, v), CTRL, 0xF, 0xF, true)); }
__device__ __forceinline__ float row_sum(float v) { v += dppf<0xB1>(v); v += dppf<0x4E>(v); v += dppf<0x141>(v); v += dppf<0x140>(v); return v; }
__device__ __forceinline__ float row_max(float v) { v = fmaxf(v, dppf<0xB1>(v)); v = fmaxf(v, dppf<0x4E>(v)); v = fmaxf(v, dppf<0x141>(v)); v = fmaxf(v, dppf<0x140>(v)); return v; }
__device__ __forceinline__ float wave_sum(float v) {
    v = row_sum(v);
    { auto rr = __builtin_amdgcn_permlane16_swap(__float_as_uint(v), __float_as_uint(v), false, false); v = __uint_as_float(rr[0]) + __uint_as_float(rr[1]); }
    { auto rr = __builtin_amdgcn_permlane32_swap(__float_as_uint(v), __float_as_uint(v), false, false); v = __uint_as_float(rr[0]) + __uint_as_float(rr[1]); }
    return v;
}

template <int MAP> __device__ __forceinline__ int wt_drow(int n) {
    if (MAP == 2) return 256 * (n >> 7) + 64 * ((n >> 5) & 3) + (n & 31);
    if (MAP == 3) return 256 * (n >> 7) + 64 * ((n >> 5) & 3) + 32 + (n & 31);
    return n;
}
template <int MAP> __device__ __forceinline__ void transpose_item(const float* __restrict__ W, int K, int N, bf16* WT, int k0, int n0, LAS float* scr, int lane) {
    f32x4 x[16];
#pragma unroll
    for (int i = 0; i < 16; ++i) x[i] = *(const f32x4*)(W + (size_t)(k0 + 4 * i + (lane >> 4)) * N + n0 + 4 * (lane & 15));
#pragma unroll
    for (int i = 0; i < 16; ++i) { LAS float* d = scr + (4 * i + (lane >> 4)) * 65 + 4 * (lane & 15); d[0] = x[i].x; d[1] = x[i].y; d[2] = x[i].z; d[3] = x[i].w; }
    LDS_WAIT(); asm volatile("" ::: "memory");
    const int c = lane & 7;
#pragma unroll
    for (int j = 0; j < 8; ++j) { const int n = (lane >> 3) + 8 * j; const LAS float* sp = scr + (8 * c) * 65 + n;
        v4u o; o.x = pk2(sp[0 * 65], sp[1 * 65]); o.y = pk2(sp[2 * 65], sp[3 * 65]); o.z = pk2(sp[4 * 65], sp[5 * 65]); o.w = pk2(sp[6 * 65], sp[7 * 65]);
        *(v4u*)(WT + (size_t)wt_drow<MAP>(n0 + n) * K + k0 + 8 * c) = o; }
    LDS_WAIT(); asm volatile("" ::: "memory");
}

__device__ __forceinline__ void rms_row_to_bf16(const float* xrow, const float* gain, bf16* orow, int lane) {
    const f32x4* xr = (const f32x4*)xrow + lane; const f32x4* gr = (const f32x4*)gain + lane;
    f32x4 v[4]; float s = 0.f;
#pragma unroll
    for (int j = 0; j < 4; ++j) { v[j] = xr[64 * j]; s += (v[j].x * v[j].x + v[j].y * v[j].y) + (v[j].z * v[j].z + v[j].w * v[j].w); }
    const float rinv = 1.0f / sqrtf(wave_sum(s) * (1.f / D) + EPS);
    unsigned long long* o8 = (unsigned long long*)orow + lane;
#pragma unroll
    for (int j = 0; j < 4; ++j) { const f32x4 g = gr[64 * j]; const f32x4 y = v[j] * rinv * g;
        o8[64 * j] = (unsigned long long)pk2(y.x, y.y) | ((unsigned long long)pk2(y.z, y.w) << 32); }
}

__device__ __forceinline__ void moe_convert_item(const Args& a, int layer, int it, LAS float* scr, int lane) {
    unsigned char* ws = a.ws;
    const int q = it >> 9, r = it & 511, le = layer * 16 + q / 3, which = q % 3;
    if (which == 0) transpose_item<2>(a.moe_w1 + (size_t)le * 1024 * 2048, 1024, 2048, (bf16*)(ws + WS_W13) + (size_t)le * 4096 * 1024, (r >> 5) * 64, (r & 31) * 64, scr, lane);
    else if (which == 1) transpose_item<3>(a.moe_w3 + (size_t)le * 1024 * 2048, 1024, 2048, (bf16*)(ws + WS_W13) + (size_t)le * 4096 * 1024, (r >> 5) * 64, (r & 31) * 64, scr, lane);
    else transpose_item<0>(a.moe_w2 + (size_t)le * 2048 * 1024, 2048, 1024, (bf16*)(ws + WS_W2) + (size_t)le * 1024 * 2048, (r >> 4) * 64, (r & 15) * 64, scr, lane);
}
constexpr int MOE_ITEMS_PER_LAYER = 16 * 3 * 512;
__device__ __forceinline__ void moe_convert_layer(const Args& a, int layer, LAS unsigned char* lds, int w, int nw) {
    int tid = threadIdx.x; asm volatile("" : "+v"(tid)); const int lane = tid & 63, wave = __builtin_amdgcn_readfirstlane(tid >> 6);
    LAS float* scr = (LAS float*)(lds + wave * 16640);
    for (int it = w; it < MOE_ITEMS_PER_LAYER; it += nw) moe_convert_item(a, layer, it, scr, lane);
}
__device__ __forceinline__ void prologue_phase(const Args& a, LAS unsigned char* lds, int nmoe) {
    int tid = threadIdx.x; asm volatile("" : "+v"(tid)); const int lane = tid & 63, wave = __builtin_amdgcn_readfirstlane(tid >> 6); (void)lane; (void)wave;
    LAS float* scr = (LAS float*)(lds + wave * 16640);
    const int gw = blockIdx.x * 8 + wave, NGW = gridDim.x * 8;
    unsigned char* ws = a.ws;
    const int IT_MOE = nmoe * MOE_ITEMS_PER_LAYER, NITEMS = IT_MOE + 3072 + 1536 + 2304 + 256;
    for (int it = gw; it < NITEMS; it += NGW) {
        if (it < IT_MOE) { moe_convert_item(a, it / MOE_ITEMS_PER_LAYER, it % MOE_ITEMS_PER_LAYER, scr, lane);
        } else {
            int r = it - IT_MOE;
            if (r < 3072) { const int j = r / 1536, rr = r % 1536; transpose_item<0>(a.gm_w_in + (size_t)j * 1024 * 6144, 1024, 6144, (bf16*)(ws + WS_WIN) + (size_t)j * 6144 * 1024, (rr / 96) * 64, (rr % 96) * 64, scr, lane); }
            else if (r < 3072 + 1536) { r -= 3072; const int j = r / 768, rr = r % 768; transpose_item<0>(a.gm_w_out + (size_t)j * 3072 * 1024, 3072, 1024, (bf16*)(ws + WS_WOUT) + (size_t)j * 1024 * 3072, (rr >> 4) * 64, (rr & 15) * 64, scr, lane); }
            else if (r < 3072 + 1536 + 2304) { r -= 3072 + 1536; const int j = r / 1152, rr = r % 1152; transpose_item<0>(a.at_w_qkv + (size_t)j * 1024 * 4608, 1024, 4608, (bf16*)(ws + WS_WQKV) + (size_t)j * 4608 * 1024, (rr / 72) * 64, (rr % 72) * 64, scr, lane); }
            else { r -= 3072 + 1536 + 2304; const int j = r >> 7, rr = r & 127; transpose_item<0>(a.at_w_o + (size_t)j * 512 * 1024, 512, 1024, (bf16*)(ws + WS_WO) + (size_t)j * 1024 * 512, (rr >> 4) * 64, (rr & 15) * 64, scr, lane); }
        }
    }
    bf16* H = (bf16*)(ws + WS_H);
    for (int m = gw; m < T; m += NGW) rms_row_to_bf16(a.x + (size_t)m * D, a.mix_norm, H + (size_t)m * D, lane);
}

__device__ __forceinline__ void gating_phase(const Args& a, int j, LAS unsigned char* lds) {
    int tid = threadIdx.x; asm volatile("" : "+v"(tid)); const int lane = tid & 63, wave = __builtin_amdgcn_readfirstlane(tid >> 6);
    LAS unsigned short* Wl = (LAS unsigned short*)lds;
    LAS float* rinv = (LAS float*)(lds + 36864);
    LAS float* part = (LAS float*)(lds + 37888);
    LAS unsigned char* stage = lds + 40960;
    const float* Ws = a.gm_w_s + (size_t)j * 8 * 128 * 128; const float* bs = a.gm_b_s + j * 8 * 128; const float* vg = a.gm_v_norm + j * GW;
    const bf16* U = (const bf16*)(a.ws + WS_U); bf16* UV = (bf16*)(a.ws + WS_UV); const bf16* VT = (const bf16*)(a.ws + WS_VT); const float* SSQ = (const float*)(a.ws + WS_SSQ);
    const int fr = lane & 15, fq = lane >> 4;
    int cur_g = -1;
    bf16x8 vf[3][4]; float ssum = 0.f;
#define GATE_REQUEST(unit_) do { const int g_ = (unit_) & 7, tok0_ = ((unit_) >> 3) * 128; \
        _Pragma("unroll") for (int n = 0; n < 3; ++n) _Pragma("unroll") for (int ks = 0; ks < 4; ++ks) \
            vf[n][ks] = *(const bf16x8*)(VT + ((size_t)(tok0_ >> 7) * 3072 + g_ * 384 + 48 * wave + 16 * n + fr) * 128 + 32 * ks + 8 * fq); \
        ssum = 0.f; _Pragma("unroll") for (int q = 0; q < 6; ++q) ssum += SSQ[(size_t)(6 * (tid >> 7) + q) * T + tok0_ + (tid & 127)]; } while (0)
    if (blockIdx.x < 2048) GATE_REQUEST(blockIdx.x);
    for (int unit = blockIdx.x; unit < 2048; unit += gridDim.x) {
        const int g = unit & 7, tok0 = (unit >> 3) * 128;
        __syncthreads();
        if (g != cur_g) {
            int tw = tid; asm volatile("" : "+v"(tw));
#pragma unroll
            for (int i = 0; i < 8; ++i) { const int idx = (tw + 512 * i) * 4, t = idx >> 7, s0 = idx & 127; const f32x4 w = *(const f32x4*)(Ws + g * 16384 + idx);
                v2u o; o.x = pk2(w.x, w.y); o.y = pk2(w.z, w.w); *(LAS v2u*)(Wl + t * 136 + s0) = o; }
            cur_g = g; }
        part[tid] = ssum;
        __syncthreads();
        if (tid < 128) rinv[tid] = 1.0f / sqrtf(((part[tid] + part[128 + tid]) + (part[256 + tid] + part[384 + tid])) * (1.0f / GW) + EPS);
        __syncthreads();
#pragma unroll
        for (int ks = 0; ks < 4; ++ks) { const f32x4 r0 = *(const LAS f32x4*)(rinv + 32 * ks + 8 * fq), r1 = *(const LAS f32x4*)(rinv + 32 * ks + 8 * fq + 4);
#pragma unroll
            for (int n = 0; n < 3; ++n) { const v4u x = __builtin_bit_cast(v4u, vf[n][ks]); v4u y;
                y.x = pk2(bf_lo(x.x) * r0.x, bf_hi(x.x) * r0.y); y.y = pk2(bf_lo(x.y) * r0.z, bf_hi(x.y) * r0.w);
                y.z = pk2(bf_lo(x.z) * r1.x, bf_hi(x.z) * r1.y); y.w = pk2(bf_lo(x.w) * r1.z, bf_hi(x.w) * r1.w);
                vf[n][ks] = __builtin_bit_cast(bf16x8, y); } }
#pragma unroll 1
        for (int mh = 0; mh < 2; ++mh) {
            v4u ug[6];
            int te = tid; asm volatile("" : "+v"(te));
#pragma unroll
            for (int k = 0; k < 6; ++k) { const int c = te + 512 * k, row = c / 48, c8 = c % 48; ug[k] = *(const v4u*)(U + (size_t)(tok0 + 64 * mh + row) * GW + g * 384 + c8 * 8); }
            f32x4 acc[4][3];
#pragma unroll
            for (int m = 0; m < 4; ++m)
#pragma unroll
                for (int n = 0; n < 3; ++n) acc[m][n] = (f32x4){0.f, 0.f, 0.f, 0.f};
#pragma unroll
            for (int ks = 0; ks < 4; ++ks)
#pragma unroll
                for (int m = 0; m < 4; ++m) { const bf16x8 wf = *(const LAS bf16x8*)(Wl + (64 * mh + 16 * m + fr) * 136 + 32 * ks + 8 * fq);
#pragma unroll
                    for (int n = 0; n < 3; ++n) acc[m][n] = __builtin_amdgcn_mfma_f32_16x16x32_bf16(vf[n][ks], wf, acc[m][n], 0, 0, 0); }
            if (mh == 1 && unit + (int)gridDim.x < 2048) { asm volatile("" ::: "memory"); GATE_REQUEST(unit + (int)gridDim.x); }
#pragma unroll
            for (int n = 0; n < 3; ++n) { const int el = 48 * wave + 16 * n + 4 * fq; const f32x4 gn = *(const f32x4*)(vg + g * 384 + el);
#pragma unroll
                for (int m = 0; m < 4; ++m) { const int tl = 16 * m + fr; const float bt = bs[g * 128 + 64 * mh + tl];
                    *(LAS f32x4*)(stage + tl * 1552 + el * 4) = acc[m][n] * gn + bt; } }
            __syncthreads();
#pragma unroll
            for (int k = 0; k < 6; ++k) { const int c = te + 512 * k, row = c / 48, c8 = c % 48;
                const f32x4 g0 = *(const LAS f32x4*)(stage + row * 1552 + c8 * 32), g1 = *(const LAS f32x4*)(stage + row * 1552 + c8 * 32 + 16);
                v4u w; w.x = pk2(g0.x * bf_lo(ug[k].x), g0.y * bf_hi(ug[k].x)); w.y = pk2(g0.z * bf_lo(ug[k].y), g0.w * bf_hi(ug[k].y));
                w.z = pk2(g1.x * bf_lo(ug[k].z), g1.y * bf_hi(ug[k].z)); w.w = pk2(g1.z * bf_lo(ug[k].w), g1.w * bf_hi(ug[k].w));
                *(v4u*)(UV + (size_t)(tok0 + 64 * mh + row) * GW + g * 384 + c8 * 8) = w; }
            if (mh == 0) __syncthreads();
        }
    }
#undef GATE_REQUEST
}

typedef float f32x16 __attribute__((ext_vector_type(16)));
typedef short s16x4 __attribute__((ext_vector_type(4)));
typedef short v4i16_t __attribute__((ext_vector_type(4)));
__device__ __forceinline__ s16x4 vtr(const LAS unsigned char* p) { return __builtin_bit_cast(s16x4, __builtin_amdgcn_ds_read_tr16_b64_v4i16((LAS v4i16_t*)p)); }
__device__ __forceinline__ void attn_phase(const Args& a, LAS unsigned char* lds) {
    int tid = threadIdx.x; asm volatile("" : "+v"(tid)); const int lane = tid & 63, wave = __builtin_amdgcn_readfirstlane(tid >> 6), r32 = lane & 31, hi = lane >> 5;
    const bf16* QKV = (const bf16*)(a.ws + WS_QKV); bf16* OG = (bf16*)(a.ws + WS_OG); float* LSE = (float*)(a.ws + WS_LSE);
    LAS unsigned char* Kl = lds; LAS unsigned char* Vl = lds + 49152;
    LAS unsigned char* Ql = lds + 98304;
    constexpr size_t HEADSZ = (size_t)4096 * 64, WHICHSZ = (size_t)3 * 64 * 4096 * 64;
    v4u kr[6], vr[6], qv[4];
#define ATTN_DECODE(u_) const int g = (u_) >> 10, v = (u_) & 1023, bh = v >> 4, w16 = v & 15, dsh = 2 * g, dil = 1 << dsh, r = w16 & (dil - 1), blk = w16 >> dsh, L = 4096 >> dsh, p0 = blk * 256; \
        const bf16* qb = QKV + ((size_t)g * 64 + bh) * HEADSZ; const bf16* kb = qb + WHICHSZ; const bf16* vb = qb + 2 * WHICHSZ; (void)dil; (void)kb; (void)vb;
#define ATTN_REQUEST(u_) do { ATTN_DECODE(u_) \
        _Pragma("unroll") for (int i = 0; i < 6; ++i) { const int wv = wave + 8 * i; \
            const int key = 8 * wv + (lane & 7), p = min(max(p0 - 64 + key, 0), L - 1);        \
            kr[i] = *(const v4u*)(kb + (size_t)(r + (p << dsh)) * 64 + (lane >> 3) * 8); \
            const int key2 = 8 * wv + (lane >> 3), p2 = min(max(p0 - 64 + key2, 0), L - 1); \
            vr[i] = *(const v4u*)(vb + (size_t)(r + (p2 << dsh)) * 64 + (lane & 7) * 8); } \
        _Pragma("unroll") for (int i = 0; i < 4; ++i) { const int qq = 8 * (wave + 8 * i) + (lane & 7); \
            qv[i] = *(const v4u*)(qb + (size_t)(r + ((p0 + qq) << dsh)) * 64 + (lane >> 3) * 8); } } while (0)
    const int G8 = (int)gridDim.x, u0 = (G8 % 8 == 0) ? ((int)blockIdx.x % 8) * (G8 / 8) + (int)blockIdx.x / 8 : (int)blockIdx.x;
    if (u0 < 3072) ATTN_REQUEST(u0);
    for (int u = u0; u < 3072; u += gridDim.x) {
        ATTN_DECODE(u)
        const int b = bh >> 3, h = bh & 7;
        __syncthreads();
#pragma unroll
        for (int i = 0; i < 6; ++i) { const int wv = wave + 8 * i; const v4u z4 = (v4u){0u, 0u, 0u, 0u};
            const bool ok = (unsigned)(p0 - 64 + 8 * wv + (lane & 7)) < (unsigned)L, ok2 = (unsigned)(p0 - 64 + 8 * wv + (lane >> 3)) < (unsigned)L;
            *(LAS v4u*)(Kl + (lane >> 3) * 6144 + (8 * wv + (lane & 7)) * 16) = ok ? kr[i] : z4;
            *(LAS v4u*)(Vl + ((lane & 7) >> 2) * 24576 + (8 * wv + (lane >> 3)) * 64 + (lane & 3) * 16) = ok2 ? vr[i] : z4; }
#pragma unroll
        for (int i = 0; i < 4; ++i) *(LAS v4u*)(Ql + (lane >> 3) * 4096 + (8 * (wave + 8 * i) + (lane & 7)) * 16) = qv[i];
        __syncthreads();
        if (u + (int)gridDim.x < 3072) ATTN_REQUEST(u + (int)gridDim.x);
        const int sq = r + ((p0 + 32 * wave + r32) << dsh);
        bf16x8 qr[4];
#pragma unroll
        for (int d0 = 0; d0 < 4; ++d0) qr[d0] = *(const LAS bf16x8*)(Ql + (2 * d0 + hi) * 4096 + (32 * wave + r32) * 16);
        f32x16 sc[5];
#pragma unroll
        for (int k2 = 0; k2 < 5; k2 += 2) {
            const LAS unsigned char* kp = Kl + hi * 6144 + (32 * (wave + k2) + r32) * 16;
            bf16x8 ka[4], kb2[4];
#pragma unroll
            for (int d0 = 0; d0 < 4; ++d0) { ka[d0] = *(const LAS bf16x8*)(kp + d0 * 12288); if (k2 + 1 < 5) kb2[d0] = *(const LAS bf16x8*)(kp + 512 + d0 * 12288); }
#pragma unroll
            for (int d0 = 0; d0 < 4; ++d0) {
                if (d0 == 0) { sc[k2] = __builtin_amdgcn_mfma_f32_32x32x16_bf16(ka[0], qr[0], (f32x16){}, 0, 0, 0); if (k2 + 1 < 5) sc[k2 + 1] = __builtin_amdgcn_mfma_f32_32x32x16_bf16(kb2[0], qr[0], (f32x16){}, 0, 0, 0); }
                else { sc[k2] = __builtin_amdgcn_mfma_f32_32x32x16_bf16(ka[d0], qr[d0], sc[k2], 0, 0, 0); if (k2 + 1 < 5) sc[k2 + 1] = __builtin_amdgcn_mfma_f32_32x32x16_bf16(kb2[d0], qr[d0], sc[k2 + 1], 0, 0, 0); } }
            asm volatile("" ::: "memory"); }
        const float cb = __builtin_ldexpf(1.4426950408889634f, dsh - (h + 1));
        const float t0f = (float)(4 * hi - r32);
        const bool first = (p0 == 0), lastb = (p0 + 256 == L);
        float mx = -INFINITY;
#pragma unroll
        for (int kt = 0; kt < 5; ++kt) {
            float base = t0f; asm volatile("" : "+v"(base));
            const bool dead = (first && wave + kt < 2) || (lastb && wave + kt >= 10);
            if (dead) {
#pragma unroll
                for (int rr = 0; rr < 16; ++rr) sc[kt][rr] = -INFINITY;
            } else {
#pragma unroll
                for (int rr = 0; rr < 16; ++rr) { const float rel = base + (float)(32 * kt - 64 + (rr & 3) + 8 * (rr >> 2));
                    float sv = sc[kt][rr] - cb * __builtin_fabsf(rel);
                    if (kt == 0) sv = rel >= -64.f ? sv : -INFINITY;
                    if (kt == 4) sv = rel <= 64.f ? sv : -INFINITY;
                    sc[kt][rr] = sv; mx = fmaxf(mx, sv); } } }
        { auto rr = __builtin_amdgcn_permlane32_swap(__float_as_uint(mx), __float_as_uint(mx), false, false); mx = fmaxf(__uint_as_float(rr[0]), __uint_as_float(rr[1])); }
        float l = 0.f;
#pragma unroll
        for (int kt = 0; kt < 5; ++kt)
#pragma unroll
            for (int rr = 0; rr < 16; ++rr) { const float p = __builtin_amdgcn_exp2f(sc[kt][rr] - mx); sc[kt][rr] = p; l += p; }
        { auto rr = __builtin_amdgcn_permlane32_swap(__float_as_uint(l), __float_as_uint(l), false, false); l = __uint_as_float(rr[0]) + __uint_as_float(rr[1]); }
        f32x16 o0 = (f32x16){}, o1 = (f32x16){};
        const LAS unsigned char* vp = Vl + ((lane >> 4) & 1) * 32 + (lane & 3) * 8 + (4 * hi + ((lane & 15) >> 2)) * 64;
#pragma unroll
        for (int kt = 0; kt < 5; ++kt)
#pragma unroll
            for (int ks = 0; ks < 2; ++ks) { const LAS unsigned char* ap = vp + (32 * (wave + kt) + 16 * ks) * 64;
                const s16x4 l0 = vtr(ap), h0 = vtr(ap + 512), l1 = vtr(ap + 24576), h1 = vtr(ap + 24576 + 512);
                pg8::u32x4 pw; pw.x = pg8::cvt_pk_bf16(sc[kt][8 * ks + 0], sc[kt][8 * ks + 1]); pw.y = pg8::cvt_pk_bf16(sc[kt][8 * ks + 2], sc[kt][8 * ks + 3]);
                pw.z = pg8::cvt_pk_bf16(sc[kt][8 * ks + 4], sc[kt][8 * ks + 5]); pw.w = pg8::cvt_pk_bf16(sc[kt][8 * ks + 6], sc[kt][8 * ks + 7]);
                const bf16x8 pf = __builtin_bit_cast(bf16x8, pw);
                o0 = __builtin_amdgcn_mfma_f32_32x32x16_bf16((bf16x8){l0[0], l0[1], l0[2], l0[3], h0[0], h0[1], h0[2], h0[3]}, pf, o0, 0, 0, 0);
                o1 = __builtin_amdgcn_mfma_f32_32x32x16_bf16((bf16x8){l1[0], l1[1], l1[2], l1[3], h1[0], h1[1], h1[2], h1[3]}, pf, o1, 0, 0, 0);
                asm volatile("" ::: "memory"); }
        const float inv = 1.0f / l; const size_t row = (size_t)g * T + (size_t)b * 4096 + sq;
        LAS unsigned char* ow = Ql + (32 * wave) * 16;
#pragma unroll
        for (int aa = 0; aa < 4; ++aa) {
            v2u w0; w0.x = pk2(o0[4 * aa] * inv, o0[4 * aa + 1] * inv); w0.y = pk2(o0[4 * aa + 2] * inv, o0[4 * aa + 3] * inv);
            *(LAS v2u*)(ow + aa * 4096 + (r32 ^ aa) * 16 + 8 * hi) = w0;
            v2u w1; w1.x = pk2(o1[4 * aa] * inv, o1[4 * aa + 1] * inv); w1.y = pk2(o1[4 * aa + 2] * inv, o1[4 * aa + 3] * inv);
            *(LAS v2u*)(ow + (4 + aa) * 4096 + (r32 ^ (4 + aa)) * 16 + 8 * hi) = w1; }
        {   const int piece = lane & 7; bf16* ob = OG + ((size_t)g * T + (size_t)b * 4096) * AW + h * 64 + piece * 8;
#pragma unroll
            for (int i = 0; i < 4; ++i) { const int rw = (lane >> 3) + 8 * i;
                const v4u ov = *(const LAS v4u*)(ow + piece * 4096 + (rw ^ piece) * 16);
                *(v4u*)(ob + (size_t)(r + ((p0 + 32 * wave + rw) << dsh)) * AW) = ov; } }
        if (hi == 0) LSE[row * 8 + h] = mx + __builtin_log2f(l);
    }
#undef ATTN_DECODE
#undef ATTN_REQUEST
}
__device__ __forceinline__ void attn_merge_phase(const Args& a) {
    int tid = threadIdx.x; asm volatile("" : "+v"(tid)); const int lane = tid & 63, wave = __builtin_amdgcn_readfirstlane(tid >> 6);
    const bf16* OG = (const bf16*)(a.ws + WS_OG); const float* LSE = (const float*)(a.ws + WS_LSE); bf16* O = (bf16*)(a.ws + WS_O);
    const int gw = blockIdx.x * 8 + wave, NGW = gridDim.x * 8;
    for (int row = gw; row < T; row += NGW) {
        float ls[3]; v4u og[3];
#pragma unroll
        for (int g = 0; g < 3; ++g) { ls[g] = LSE[((size_t)g * T + row) * 8 + (lane >> 3)]; og[g] = *(const v4u*)(OG + ((size_t)g * T + row) * AW + lane * 8); }
        const float M = fmaxf(fmaxf(ls[0], ls[1]), ls[2]);
        float w[3]; float den = 0.f;
#pragma unroll
        for (int g = 0; g < 3; ++g) { w[g] = __builtin_amdgcn_exp2f(ls[g] - M); den += w[g]; }
        const float iden = 1.0f / den;
        float acc[8];
#pragma unroll
        for (int i = 0; i < 8; ++i) acc[i] = 0.f;
#pragma unroll
        for (int g = 0; g < 3; ++g) { const float wg = w[g] * iden; const unsigned ww[4] = {og[g].x, og[g].y, og[g].z, og[g].w};
#pragma unroll
            for (int i = 0; i < 4; ++i) { acc[2 * i] += wg * bf_lo(ww[i]); acc[2 * i + 1] += wg * bf_hi(ww[i]); } }
        v4u o; o.x = pk2(acc[0], acc[1]); o.y = pk2(acc[2], acc[3]); o.z = pk2(acc[4], acc[5]); o.w = pk2(acc[6], acc[7]);
        *(v4u*)(O + (size_t)row * AW + lane * 8) = o;
    }
}

__device__ __forceinline__ void router_phase(const Args& a, int layer, LAS unsigned char* lds) {
    int tid = threadIdx.x; asm volatile("" : "+v"(tid)); const int lane = tid & 63, wave = __builtin_amdgcn_readfirstlane(tid >> 6);
    LAS float* wr = (LAS float*)lds;
    constexpr int WRS = 1028;
    const float* Wr = a.moe_w_router + (size_t)layer * D * NE; const float* br = a.moe_b_router + layer * NE; const float* gain = a.ffn_norm + layer * D;
    __syncthreads();
    {   f32x4 wq[8];
#pragma unroll
        for (int k = 0; k < 8; ++k) wq[k] = *(const f32x4*)(Wr + (size_t)(tid + 512 * k) * 4);
#pragma unroll
        for (int k = 0; k < 8; ++k) { const int i4 = tid + 512 * k, d = i4 >> 2, e0 = 4 * (i4 & 3);
            wr[(e0 + 0) * WRS + d] = wq[k].x; wr[(e0 + 1) * WRS + d] = wq[k].y; wr[(e0 + 2) * WRS + d] = wq[k].z; wr[(e0 + 3) * WRS + d] = wq[k].w; } }
    __syncthreads();
    bf16* H = (bf16*)(a.ws + WS_H); float* AFF = (float*)(a.ws + WS_AFF); const float* XB = (const float*)(a.ws + WS_XB);
    const int gw = blockIdx.x * 8 + wave, NGW = gridDim.x * 8;
    const f32x4* gr = (const f32x4*)gain + lane;
    constexpr int RT = 4;
    f32x4 nx[RT][4];
    if (gw < T / RT) {
#pragma unroll
        for (int t = 0; t < RT; ++t) { const f32x4* xr = (const f32x4*)(XB + (size_t)(RT * gw + t) * D) + lane;
#pragma unroll
            for (int j = 0; j < 4; ++j) nx[t][j] = xr[64 * j]; } }
    for (int rp = gw; rp < T / RT; rp += NGW) {
        const int row = RT * rp;
        f32x4 v[RT][4]; float ss[RT];
#pragma unroll
        for (int t = 0; t < RT; ++t) { ss[t] = 0.f;
#pragma unroll
            for (int j = 0; j < 4; ++j) { v[t][j] = nx[t][j]; ss[t] += (v[t][j].x * v[t][j].x + v[t][j].y * v[t][j].y) + (v[t][j].z * v[t][j].z + v[t][j].w * v[t][j].w); } }
        if (rp + NGW < T / RT) {
#pragma unroll
            for (int t = 0; t < RT; ++t) { const f32x4* xr = (const f32x4*)(XB + (size_t)(RT * (rp + NGW) + t) * D) + lane;
#pragma unroll
                for (int j = 0; j < 4; ++j) nx[t][j] = xr[64 * j]; } }
#pragma unroll
        for (int t = 0; t < RT; ++t) { const float rinv = 1.0f / sqrtf(wave_sum(ss[t]) * (1.f / D) + EPS);
            unsigned long long* o8 = (unsigned long long*)(H + (size_t)(row + t) * D) + lane;
#pragma unroll
            for (int j = 0; j < 4; ++j) { v[t][j] = v[t][j] * rinv * gr[64 * j];
                o8[64 * j] = (unsigned long long)pk2(v[t][j].x, v[t][j].y) | ((unsigned long long)pk2(v[t][j].z, v[t][j].w) << 32); } }
        float mine[RT];
#pragma unroll
        for (int t = 0; t < RT; ++t) mine[t] = 0.f;
#pragma unroll 2
        for (int e = 0; e < 16; ++e) { float ac[RT];
#pragma unroll
            for (int t = 0; t < RT; ++t) ac[t] = 0.f;
#pragma unroll
            for (int j = 0; j < 4; ++j) { const f32x4 w = *(const LAS f32x4*)(wr + e * WRS + 256 * j + 4 * lane);
#pragma unroll
                for (int t = 0; t < RT; ++t) ac[t] += (v[t][j].x * w.x + v[t][j].y * w.y) + (v[t][j].z * w.z + v[t][j].w * w.w); }
            const float be = br[e];
#pragma unroll
            for (int t = 0; t < RT; ++t) { const float lg = wave_sum(ac[t]) + be; mine[t] = (lane == e) ? lg : mine[t]; } }
        float pr[RT];
#pragma unroll
        for (int t = 0; t < RT; ++t) { const float m = row_max(mine[t]); const float ex = __expf(mine[t] - m); pr[t] = ex / row_sum(ex); }
        if (lane < 16) { float* ap = AFF + ((size_t)(row >> 12) * 16 + lane) * 4096 + (row & 4095); *(f32x4*)ap = (f32x4){pr[0], pr[1], pr[2], pr[3]}; }
    }
}

__device__ __forceinline__ void topk_phase(const Args& a, LAS unsigned char* lds) {
    int tid = threadIdx.x; asm volatile("" : "+v"(tid)); const int lane = tid & 63, wave = __builtin_amdgcn_readfirstlane(tid >> 6); (void)lane; (void)wave;
    LAS unsigned* hist = (LAS unsigned*)lds;
    LAS unsigned* sh = hist + 256;
    LAS unsigned* wtot = hist + 272;
    const float* AFF = (const float*)(a.ws + WS_AFF); int* SMAP = (int*)(a.ws + WS_SMAP); int* TOK = (int*)(a.ws + WS_TOK); float* GATE = (float*)(a.ws + WS_GATE);
    for (int prob = blockIdx.x; prob < NB * NE; prob += gridDim.x) {
        const int b = prob >> 4, e = prob & 15;
        const v4u* src = (const v4u*)(AFF + (size_t)prob * 4096) + 2 * tid;
        const v4u k0 = src[0], k1 = src[1];
        unsigned key[8] = {k0.x, k0.y, k0.z, k0.w, k1.x, k1.y, k1.z, k1.w};
        unsigned prefix = 0u, kk = CAP;
#pragma unroll
        for (int pass = 0; pass < 4; ++pass) {
            const int shift = 24 - 8 * pass; const unsigned mhi = pass == 0 ? 0u : (0xFFFFFFFFu << (shift + 8));
            __syncthreads();
            if (tid < 256) hist[tid] = 0u;
            __syncthreads();
#pragma unroll
            for (int i = 0; i < 8; ++i) if ((key[i] & mhi) == prefix) __hip_atomic_fetch_add(&hist[(key[i] >> shift) & 255u], 1u, __ATOMIC_RELAXED, __HIP_MEMORY_SCOPE_WORKGROUP);
            __syncthreads();
            if (wave == 0) {
                const unsigned c0 = hist[4 * lane], c1 = hist[4 * lane + 1], c2 = hist[4 * lane + 2], c3 = hist[4 * lane + 3];
                const unsigned tot = c0 + c1 + c2 + c3;
                unsigned suf = tot;
#pragma unroll
                for (int o = 1; o < 64; o <<= 1) { const unsigned t = __shfl_down(suf, o); if (lane + o < 64) suf += t; }
                unsigned gt = suf - tot;
                if (gt < kk && kk <= gt + c3) { sh[0] = 4 * lane + 3; sh[1] = kk - gt; } gt += c3;
                if (gt < kk && kk <= gt + c2) { sh[0] = 4 * lane + 2; sh[1] = kk - gt; } gt += c2;
                if (gt < kk && kk <= gt + c1) { sh[0] = 4 * lane + 1; sh[1] = kk - gt; } gt += c1;
                if (gt < kk && kk <= gt + c0) { sh[0] = 4 * lane + 0; sh[1] = kk - gt; }
            }
            __syncthreads();
            prefix |= sh[0] << shift; kk = sh[1];
        }
        unsigned cg = 0u, ce = 0u;
#pragma unroll
        for (int i = 0; i < 8; ++i) { cg += key[i] > prefix ? 1u : 0u; ce += key[i] == prefix ? 1u : 0u; }
        const unsigned mine = cg | (ce << 16);
        unsigned inc = mine;
#pragma unroll
        for (int o = 1; o < 64; o <<= 1) { const unsigned t = __shfl_up(inc, o); if (lane >= o) inc += t; }
        __syncthreads();
        if (lane == 63) wtot[wave] = inc;
        __syncthreads();
        unsigned base = 0u;
#pragma unroll
        for (int w = 0; w < 8; ++w) base += (w < wave) ? wtot[w] : 0u;
        const unsigned exc = base + inc - mine;
        unsigned gb = exc & 0xffffu, eb = exc >> 16;
        const int srow0 = (e * 8 + b) * CAP;
#pragma unroll
        for (int i = 0; i < 8; ++i) { const int s = 8 * tid + i; int slot = -1;
            if (key[i] > prefix) { slot = (int)(gb + (eb < kk ? eb : kk)); gb++; }
            else if (key[i] == prefix) { if (eb < kk) slot = (int)(gb + eb); eb++; }
            int sr = -1;
            if (slot >= 0) { sr = srow0 + slot; TOK[sr] = b * 4096 + s; GATE[sr] = __builtin_bit_cast(float, key[i]); }
            SMAP[(size_t)prob * 4096 + s] = sr; }
    }
}

__device__ __forceinline__ void gather_phase(const Args& a) {
    int tid = threadIdx.x; asm volatile("" : "+v"(tid)); const int lane = tid & 63, wave = __builtin_amdgcn_readfirstlane(tid >> 6);
    const bf16* H = (const bf16*)(a.ws + WS_H); bf16* XIN = (bf16*)(a.ws + WS_XIN); const int* TOK = (const int*)(a.ws + WS_TOK);
    const int gw = blockIdx.x * 8 + wave, NGW = gridDim.x * 8;
    for (int blk = gw; blk < NSLOT / 64; blk += NGW) {
        const int r0 = blk * 64; const int tokv = TOK[r0 + lane];
#pragma unroll 1
        for (int i0 = 0; i0 < 64; i0 += 8) {
            v4u x[8][2];
#pragma unroll
            for (int i = 0; i < 8; ++i) { const int tok = __builtin_amdgcn_readlane(tokv, i0 + i); const v4u* sp = (const v4u*)(H + (size_t)tok * D) + lane; x[i][0] = sp[0]; x[i][1] = sp[64]; }
#pragma unroll
            for (int i = 0; i < 8; ++i) { v4u* dp = (v4u*)(XIN + (size_t)(r0 + i0 + i) * D) + lane; dp[0] = x[i][0]; dp[64] = x[i][1]; }
        }
    }
}

__device__ __forceinline__ void combine_phase(const Args& a, int layer) {
    int tid = threadIdx.x; asm volatile("" : "+v"(tid)); const int lane = tid & 63, wave = __builtin_amdgcn_readfirstlane(tid >> 6);
    const bf16* Y = (const bf16*)(a.ws + WS_Y); const int* SMAP = (const int*)(a.ws + WS_SMAP); bf16* H = (bf16*)(a.ws + WS_H);
    const int gw = blockIdx.x * 8 + wave, NGW = gridDim.x * 8;
    for (int row = gw; row < T; row += NGW) {
        const int b = row >> 12, s = row & 4095;
        const int srv = SMAP[((size_t)b * 16 + (lane & 15)) * 4096 + s];
        const f32x4* xi = (const f32x4*)((const float*)(a.ws + WS_XB) + (size_t)row * D) + lane; f32x4* xr = (f32x4*)(a.out + (size_t)row * D) + lane;
        f32x4 v[4];
#pragma unroll
        for (int j = 0; j < 4; ++j) v[j] = xi[64 * j];
        unsigned mask = (unsigned)(__builtin_amdgcn_ballot_w64(srv >= 0) & 0xffffull);
        while (mask) {
            int sr[4]; bool on[4];
#pragma unroll
            for (int k = 0; k < 4; ++k) { on[k] = mask != 0u; const int e = on[k] ? __builtin_ctz(mask) : 0; sr[k] = __builtin_amdgcn_readlane(srv, e); if (on[k]) mask &= mask - 1u; }
            v2u y[4][4];
#pragma unroll
            for (int k = 0; k < 4; ++k) { if (on[k]) { const v2u* yr = (const v2u*)(Y + (size_t)sr[k] * D) + lane;
#pragma unroll
                for (int j = 0; j < 4; ++j) y[k][j] = yr[64 * j]; } else {
#pragma unroll
                for (int j = 0; j < 4; ++j) y[k][j] = (v2u){0u, 0u}; } }
#pragma unroll
            for (int k = 0; k < 4; ++k)
#pragma unroll
                for (int j = 0; j < 4; ++j) { v[j].x += bf_lo(y[k][j].x); v[j].y += bf_hi(y[k][j].x); v[j].z += bf_lo(y[k][j].y); v[j].w += bf_hi(y[k][j].y); }
        }
#pragma unroll
        for (int j = 0; j < 4; ++j) xr[64 * j] = v[j];
        if (layer < 3) {
            const f32x4* gr = (const f32x4*)(a.mix_norm + (layer + 1) * D) + lane; float ss = 0.f;
#pragma unroll
            for (int j = 0; j < 4; ++j) ss += (v[j].x * v[j].x + v[j].y * v[j].y) + (v[j].z * v[j].z + v[j].w * v[j].w);
            const float rinv = 1.0f / sqrtf(wave_sum(ss) * (1.f / D) + EPS);
            unsigned long long* o8 = (unsigned long long*)(H + (size_t)row * D) + lane;
#pragma unroll
            for (int j = 0; j < 4; ++j) { const f32x4 y = v[j] * rinv * gr[64 * j]; o8[64 * j] = (unsigned long long)pk2(y.x, y.y) | ((unsigned long long)pk2(y.z, y.w) << 32); }
        }
    }
}

constexpr int N_PHASES = 1 + 4 * 9;
__global__ void __launch_bounds__(512, 2) mega_fwd(Args a) {
    extern __shared__ __attribute__((aligned(16))) unsigned char lds_raw[];
    LAS unsigned char* lds = (LAS unsigned char*)lds_raw;
    const int tid = threadIdx.x, lane = tid & 63, wave = __builtin_amdgcn_readfirstlane(tid >> 6);
    const int G = gridDim.x, bid = blockIdx.x;
    unsigned char* ws = a.ws;
    volatile LAS unsigned* MISC = (volatile LAS unsigned*)(lds + LDSCTL_OFF);
    if (tid < 64) MISC[tid] = 0u;
    __syncthreads();
#if !MK_MULTI
    XcdBarrier bar = xcd_barrier_post((unsigned*)(ws + WS_CTL) + CW_BAR, MISC + 8);
#define GRID_BAR() xcd_barrier(bar)
#else
#define GRID_BAR() do {} while (0)
#endif
    const int lo = a.ph_lo, hi = a.ph_hi;
#ifndef PH_EN
#define PH_EN 0x1fff
#endif
#define EN(b) ((PH_EN >> (b)) & 1)
#ifndef PH_REP
#define PH_REP 0
#endif
#define NREP(b) (1 + ((PH_REP >> (b)) & 1))
#define IN(k) (lo <= (k) && (k) < hi)
#define SEAM(k) do { if (IN((k) + 1)) GRID_BAR(); } while (0)
    bf16* H = (bf16*)(ws + WS_H);

#define PHASE(bit, k, seam, ...) do { if (EN(bit) && IN(k)) { for (int rep_ = 0; rep_ < NREP(bit); ++rep_) { if (rep_) GRID_BAR(); __VA_ARGS__ } if (seam) SEAM(k); } } while (0)
    constexpr int NG = 228;
    const bool split = (G == 256);
    PHASE(12, 0, true, prologue_phase(a, lds, split ? 1 : 4););

    for (int layer = 0; layer < 4; ++layer) {
        const int pb = 1 + 9 * layer, j = layer >> 1;
        const float* xbase = layer == 0 ? a.x : a.out;
        if ((layer & 1) == 0) {
            PHASE(0, pb + 0, true,
                { pg8::Gemm g{H, (const bf16*)(ws + WS_WIN) + (size_t)j * 6144 * 1024, T, GW, D}; pg8::StaticOrder S; S.init(T, GW, G, bid);
                  pg8::EpiGeluBf16 E{(bf16*)(ws + WS_U), GW, a.gm_b_in + j * 6144};
                  pg8::gemm_phase<pg8::EpiGeluBf16, pg8::StaticOrder, true, true>(lds, g, S, E); }
                { pg8::Gemm g{(const bf16*)(ws + WS_WIN) + (size_t)j * 6144 * 1024 + (size_t)GW * 1024, H, GW, T, D}; pg8::StaticOrder S; S.init(GW, T, G, bid);
                  pg8::EpiVT E{(bf16*)(ws + WS_VT), T, a.gm_b_in + j * 6144 + GW, (float*)(ws + WS_SSQ)};
                  pg8::gemm_phase<pg8::EpiVT, pg8::StaticOrder, true, true>(lds, g, S, E); });
            PHASE(1, pb + 1, true, gating_phase(a, j, lds););
            PHASE(2, pb + 2, true,
                pg8::Gemm g{(const bf16*)(ws + WS_UV), (const bf16*)(ws + WS_WOUT) + (size_t)j * 1024 * 3072, T, D, GW}; pg8::StaticOrder S; S.init(T, D, G, bid);
                pg8::EpiResid E{xbase, (float*)(ws + WS_XB), D, a.gm_b_out + j * D};
                pg8::gemm_phase<pg8::EpiResid, pg8::StaticOrder, true, true>(lds, g, S, E););
        } else {
            PHASE(3, pb + 0, true,
                pg8::Gemm g{H, (const bf16*)(ws + WS_WQKV) + (size_t)j * QKVW * 1024, T, QKVW, D}; pg8::StaticOrder S; S.init(T, QKVW, G, bid);
                pg8::EpiQKV E{(bf16*)(ws + WS_QKV), a.at_q_norm + j * 192, a.at_k_norm + j * 192};
                pg8::gemm_phase<pg8::EpiQKV, pg8::StaticOrder, true, true>(lds, g, S, E););
            PHASE(4, pb + 1, true, for (int q_ = 0; q_ < NREP(13); ++q_) { if (q_) GRID_BAR(); attn_phase(a, lds); } GRID_BAR(); for (int q_ = 0; q_ < NREP(14); ++q_) { if (q_) GRID_BAR(); attn_merge_phase(a); });
            PHASE(5, pb + 2, true,
                pg8::Gemm g{(const bf16*)(ws + WS_O), (const bf16*)(ws + WS_WO) + (size_t)j * 1024 * 512, T, D, AW}; pg8::StaticOrder S; S.init(T, D, G, bid);
                pg8::EpiResid E{xbase, (float*)(ws + WS_XB), D, nullptr};
                pg8::gemm_phase<pg8::EpiResid, pg8::StaticOrder, true, true>(lds, g, S, E););
        }
        PHASE(6, pb + 3, true, router_phase(a, layer, lds););
        PHASE(7, pb + 4, true, topk_phase(a, lds););
        PHASE(9, pb + 6, true,
            const bool hetero = split && layer < 3;
            if (hetero && bid >= NG) { moe_convert_layer(a, layer + 1, lds, (bid - NG) * 8 + wave, (G - NG) * 8); }
            else {
            pg8::Gemm g{H, (const bf16*)(ws + WS_W13) + (size_t)layer * 16 * 4096 * 1024, NSLOT, 16 * 4096, D}; pg8::MoeOrder1 S{hetero ? NG : G, bid};
            pg8::EpiSwiGLU E{(bf16*)(ws + WS_HID)};
            pg8::gemm_phase_gather<pg8::EpiSwiGLU, pg8::MoeOrder1>(lds, g, (const int*)(ws + WS_TOK), S, E); });
        PHASE(10, pb + 7, true,
            pg8::Gemm g{(const bf16*)(ws + WS_HID), (const bf16*)(ws + WS_W2) + (size_t)layer * 16 * 1024 * 2048, NSLOT, 16 * 1024, DE}; pg8::MoeOrder2 S{G, bid};
            pg8::EpiGate E{(bf16*)(ws + WS_Y), (const float*)(ws + WS_GATE)};
            pg8::gemm_phase<pg8::EpiGate, pg8::MoeOrder2, true, true>(lds, g, S, E););
        PHASE(11, pb + 8, layer < 3, combine_phase(a, layer););
    }
#undef PHASE
#undef IN
#undef SEAM
}

extern "C" void kernel_launch(void* const* d_in, const int* in_sizes, int n_in, void* d_out, int out_size, void* d_ws, size_t ws_size, hipStream_t stream) {
    static int grid = 0;
    if (grid == 0) {
        if (n_in != 19 || out_size != T * D || ws_size < WS_END) { fprintf(stderr, "kernel_launch: unexpected shapes (n_in %d, out %d, ws %zu < %zu)\n", n_in, out_size, ws_size, (size_t)WS_END); grid = -1; return; }
        int dev = 0, cus = 0, per_cu = 0;
        if (hipGetDevice(&dev) != hipSuccess || hipDeviceGetAttribute(&cus, hipDeviceAttributeMultiprocessorCount, dev) != hipSuccess) { grid = -1; return; }
        if (hipFuncSetAttribute((const void*)mega_fwd, hipFuncAttributeMaxDynamicSharedMemorySize, LDS_BYTES) != hipSuccess) { fprintf(stderr, "kernel_launch: hipFuncSetAttribute failed\n"); grid = -1; return; }
        if (hipOccupancyMaxActiveBlocksPerMultiprocessor(&per_cu, (const void*)mega_fwd, 512, LDS_BYTES) != hipSuccess || per_cu < 1) { fprintf(stderr, "kernel_launch: occupancy query says %d\n", per_cu); }
        (void)hipGetLastError();
        grid = cus;
    }
    if (grid < 0) return;
    (void)hipMemsetAsync((char*)d_ws + WS_CTL, 0, CTL_ZERO_BYTES, stream);
    Args a{};
    const float** ap = (const float**)&a;
    for (int i = 0; i < 19; ++i) ap[i] = (const float*)d_in[i];
    a.out = (float*)d_out; a.ws = (unsigned char*)d_ws;
#if MK_MULTI
    for (int p = 0; p < N_PHASES; ++p) { a.ph_lo = p; a.ph_hi = p + 1; hipLaunchKernelGGL(mega_fwd, dim3(grid), dim3(512), LDS_BYTES, stream, a); }
#else
    a.ph_lo = 0; a.ph_hi = N_PHASES;
    hipLaunchKernelGGL(mega_fwd, dim3(grid), dim3(512), LDS_BYTES, stream, a);
#endif
}
```

```cpp
#include <hip/hip_runtime.h>
#include <cstdio>
#include <cstdint>

#ifndef MK_MULTI
#define MK_MULTI 0
#endif

namespace pg8 {
#define PG8_LAS __attribute__((address_space(3)))
typedef unsigned short bf16_t;
typedef short bf16x8 __attribute__((ext_vector_type(8)));
typedef float f32x4 __attribute__((ext_vector_type(4)));
typedef float f32x2 __attribute__((ext_vector_type(2)));
typedef unsigned u32x4 __attribute__((ext_vector_type(4)));
typedef unsigned u32x2 __attribute__((ext_vector_type(2)));
constexpr int BM = 256, BK = 64, HALF = 128, HTB = HALF * BK * 2, STAGE_BYTES = 8 * HTB, NXCD = 8, WGM = 8;

__host__ __device__ __forceinline__ int lds_byte(int r, int c) { const int st = (r >> 4) * 2 + (c >> 5), rr = r & 15, cc = c & 31, ob = rr * 64 + cc * 2; return st * 1024 + (ob ^ (((ob >> 9) & 1) << 5)); }
__host__ __device__ __forceinline__ void stage_rc(int b, int& R, int& C) { const int st = b / 1024, sb = b % 1024, swz = sb ^ (((sb >> 9) & 1) << 5); R = (st >> 1) * 16 + swz / 64; C = (st & 1) * 32 + (swz % 64) / 2; }
__host__ __device__ __forceinline__ int perm32(int rho) { const int n = rho >> 4, i = rho & 15; return 8 * (i >> 2) + 4 * n + (i & 3); }

struct Unit { int pm, pn; };
struct Gemm { const bf16_t* A; const bf16_t* Bt; int M, N, K; };

struct StaticOrder {
    int nM, nN, nwg, G, c;
    __host__ __device__ void init(int M, int N, int G_, int c_) { nM = M / BM; nN = N / BM; nwg = nM * nN; G = G_; c = c_; }
    __host__ __device__ bool next(int i, Unit& u) const {
        const long L = (long)i * G + c; if (L >= nwg) return false;
        int wgid = (int)L; { const int q = nwg / NXCD, r = nwg % NXCD, xcd = wgid % NXCD, off = wgid / NXCD; wgid = (xcd < r ? xcd * (q + 1) : r * (q + 1) + (xcd - r) * q) + off; }
        const int nig = WGM * nN, gid = wgid / nig, fm = gid * WGM, gsz = (nM - fm) < WGM ? (nM - fm) : WGM;
        u.pm = fm + ((wgid % nig) % gsz); u.pn = (wgid % nig) / gsz; return true;
    }
    __device__ __forceinline__ void a_ready(const Unit&) const {}
    __device__ __forceinline__ void done(const Unit&) const {}
};
struct MoeOrder1 {
    int G, c;
    __device__ bool next(int i, Unit& u) const {
        const int L = i * G + c; if (L >= 4096) return false;
        const int e = L >> 8, w = L & 255, x = w & 7, off = w >> 3;
        u.pm = e * 16 + 4 * (x >> 1) + (off & 3); u.pn = e * 16 + 8 * (x & 1) + (off >> 2); return true;
    }
    __device__ __forceinline__ void a_ready(const Unit&) const {}
    __device__ __forceinline__ void done(const Unit&) const {}
};
struct MoeOrder2 {
    int G, c;
    __device__ bool next(int i, Unit& u) const {
        const int L = i * G + c; if (L >= 1024) return false;
        const int r = L >> 8, w0 = L & 255, wg = (w0 & 7) * 32 + (w0 >> 3), e = r * 4 + (wg >> 6), w = wg & 63;
        u.pm = e * 16 + (w >> 2); u.pn = e * 4 + (w & 3); return true;
    }
    __device__ __forceinline__ void a_ready(const Unit&) const {}
    __device__ __forceinline__ void done(const Unit&) const {}
};

typedef __bf16 bf16x2_v __attribute__((ext_vector_type(2)));
__device__ __forceinline__ unsigned cvt_pk_bf16(float lo, float hi) { const f32x2 v = {lo, hi}; return __builtin_bit_cast(unsigned, __builtin_convertvector(v, bf16x2_v)); }
__device__ __forceinline__ float gelu_tanh(float x) {
    const float t = x * (1.0f + 0.044715f * x * x);
    const float e = __builtin_amdgcn_exp2f(t * (-2.0f * 0.7978845608f * 1.4426950409f));
    return x * __builtin_amdgcn_rcpf(1.0f + e);
}
__device__ __forceinline__ float silu_f(float a) { return a * __builtin_amdgcn_rcpf(1.0f + __builtin_amdgcn_exp2f(a * -1.4426950409f)); }

template <int CTRL> __device__ __forceinline__ float dpp_f(float v) { return __builtin_bit_cast(float, __builtin_amdgcn_update_dpp(0, __builtin_bit_cast(int, v), CTRL, 0xF, 0xF, true)); }
__device__ __forceinline__ float row16_sum(float v) { v += dpp_f<0xB1>(v); v += dpp_f<0x4E>(v); v += dpp_f<0x141>(v); v += dpp_f<0x140>(v); return v; }
__device__ __forceinline__ float xrow_sum(float v) {
    { auto rr = __builtin_amdgcn_permlane16_swap(__float_as_uint(v), __float_as_uint(v), false, false); v = __uint_as_float(rr[0]) + __uint_as_float(rr[1]); }
    { auto rr = __builtin_amdgcn_permlane32_swap(__float_as_uint(v), __float_as_uint(v), false, false); v = __uint_as_float(rr[0]) + __uint_as_float(rr[1]); }
    return v; }
template <class V4> __device__ __forceinline__ void xchg_rows(const V4& p0, const V4& p1, V4& s1, V4& s2) {
    const u32x4 a = __builtin_bit_cast(u32x4, p0), b = __builtin_bit_cast(u32x4, p1); u32x4 x, y;
#pragma unroll
    for (int k = 0; k < 4; ++k) { x[k] = (unsigned)__builtin_amdgcn_update_dpp((int)a[k], (int)b[k], 0x128, 0xF, 0xC, false);
                                  y[k] = (unsigned)__builtin_amdgcn_update_dpp((int)b[k], (int)a[k], 0x128, 0xF, 0x3, false); }
    s1 = __builtin_bit_cast(V4, x); s2 = __builtin_bit_cast(V4, y);
}
struct EpiGeluBf16 {
    static constexpr bool PERM = true, AFTER_DRAIN = false;
    bf16_t* O; int ldc; const float* bias;
    __device__ __forceinline__ void operator()(const f32x4 (&acc)[2][2][4][2], const Unit& u, int wr, int wc, int fr, int fq) const {
        const int rowb = u.pm * BM + wr * 64, colw = u.pn * BM + wc * 64;
        f32x4 bv[2][2];
#pragma unroll
        for (int bj = 0; bj < 2; ++bj)
#pragma unroll
            for (int n = 0; n < 2; ++n) bv[bj][n] = *(const f32x4*)(bias + colw + 32 * bj + 8 * fq + 4 * n);
        bf16_t* ob = O + (size_t)(rowb + (fr & 7)) * ldc + colw + (fr >> 3) * 32 + 8 * fq;
#pragma unroll
        for (int ai = 0; ai < 2; ++ai)
#pragma unroll
            for (int m = 0; m < 4; ++m) { u32x4 w[2];
#pragma unroll
                for (int bj = 0; bj < 2; ++bj) { const f32x4 v0 = acc[ai][bj][m][0] + bv[bj][0], v1 = acc[ai][bj][m][1] + bv[bj][1];
                    w[bj].x = cvt_pk_bf16(gelu_tanh(v0[0]), gelu_tanh(v0[1])); w[bj].y = cvt_pk_bf16(gelu_tanh(v0[2]), gelu_tanh(v0[3]));
                    w[bj].z = cvt_pk_bf16(gelu_tanh(v1[0]), gelu_tanh(v1[1])); w[bj].w = cvt_pk_bf16(gelu_tanh(v1[2]), gelu_tanh(v1[3])); }
                u32x4 s1, s2; xchg_rows(w[0], w[1], s1, s2);
                bf16_t* rp = ob + (size_t)(ai * HALF + m * 16) * ldc;
                *(u32x4*)rp = s1; *(u32x4*)(rp + (size_t)8 * ldc) = s2; }
    }
};
struct EpiVT {
    static constexpr bool PERM = true, AFTER_DRAIN = false;
    bf16_t* VT; int ldc; const float* bias; float* ssq;
    __device__ __forceinline__ void operator()(const f32x4 (&acc)[2][2][4][2], const Unit& u, int wr, int wc, int fr, int fq) const {
        const int rowb = u.pm * BM + wr * 64, colw = u.pn * BM + wc * 64;
        f32x4 cs[2][2];
#pragma unroll
        for (int bj = 0; bj < 2; ++bj)
#pragma unroll
            for (int n = 0; n < 2; ++n) cs[bj][n] = (f32x4){0.f, 0.f, 0.f, 0.f};
        bf16_t* ob = VT + ((size_t)(2 * u.pn + (wc >> 1)) * 3072 + rowb + (fr & 7)) * 128 + (wc & 1) * 64 + (fr >> 3) * 32 + 8 * fq;
#pragma unroll
        for (int ai = 0; ai < 2; ++ai)
#pragma unroll
            for (int m = 0; m < 4; ++m) { const int e = rowb + fr + ai * HALF + m * 16; const float b = bias[e]; u32x4 w[2];
#pragma unroll
                for (int bj = 0; bj < 2; ++bj) { f32x4 v0 = acc[ai][bj][m][0] + b, v1 = acc[ai][bj][m][1] + b;
#pragma unroll
                    for (int j = 0; j < 4; ++j) { v0[j] = gelu_tanh(v0[j]); v1[j] = gelu_tanh(v1[j]); }
                    cs[bj][0] += v0 * v0; cs[bj][1] += v1 * v1;
                    w[bj].x = cvt_pk_bf16(v0[0], v0[1]); w[bj].y = cvt_pk_bf16(v0[2], v0[3]); w[bj].z = cvt_pk_bf16(v1[0], v1[1]); w[bj].w = cvt_pk_bf16(v1[2], v1[3]); }
                u32x4 s1, s2; xchg_rows(w[0], w[1], s1, s2);
                bf16_t* rp = ob + (size_t)(ai * HALF + m * 16) * 128;
                *(u32x4*)rp = s1; *(u32x4*)(rp + 8 * 128) = s2; }
#pragma unroll
        for (int bj = 0; bj < 2; ++bj)
#pragma unroll
            for (int n = 0; n < 2; ++n)
#pragma unroll
                for (int j = 0; j < 4; ++j) cs[bj][n][j] = row16_sum(cs[bj][n][j]);
        if (fr == 0) {
            float* sp = ssq + (size_t)(2 * u.pm + wr) * ldc + colw + 8 * fq;
#pragma unroll
            for (int bj = 0; bj < 2; ++bj)
#pragma unroll
                for (int n = 0; n < 2; ++n) *(f32x4*)(sp + 32 * bj + 4 * n) = cs[bj][n];
        }
    }
};
struct EpiResid {
    static constexpr bool PERM = false, AFTER_DRAIN = false;
    const float* base; float* out; int ldc; const float* bias;
    __device__ __forceinline__ void operator()(const f32x4 (&acc)[2][2][4][2], const Unit& u, int wr, int wc, int fr, int fq) const {
        const int rowb = u.pm * BM + wr * 64, colw = u.pn * BM + wc * 64;
        const int cS = colw + (fr >> 3) * 16 + 4 * fq;
        f32x4 bv[2];
#pragma unroll
        for (int bj = 0; bj < 2; ++bj) bv[bj] = bias ? *(const f32x4*)(bias + cS + 32 * bj) : (f32x4){0.f, 0.f, 0.f, 0.f};
#pragma unroll
        for (int ai = 0; ai < 2; ++ai)
#pragma unroll
            for (int m = 0; m < 4; ++m) { const size_t off = (size_t)(rowb + ai * HALF + m * 16 + (fr & 7)) * ldc + cS;
#pragma unroll
                for (int bj = 0; bj < 2; ++bj) { f32x4 s1, s2; xchg_rows(acc[ai][bj][m][0], acc[ai][bj][m][1], s1, s2);
                    const f32x4 b1 = *(const f32x4*)(base + off + 32 * bj), b2 = *(const f32x4*)(base + off + (size_t)8 * ldc + 32 * bj);
                    *(f32x4*)(out + off + 32 * bj) = b1 + s1 + bv[bj]; *(f32x4*)(out + off + (size_t)8 * ldc + 32 * bj) = b2 + s2 + bv[bj]; }
                asm volatile("" ::: "memory"); }
    }
};
struct EpiQKV {
    static constexpr bool PERM = true, AFTER_DRAIN = false;
    bf16_t* QKV; const float* qg; const float* kg;
    __device__ __forceinline__ void operator()(const f32x4 (&acc)[2][2][4][2], const Unit& u, int wr, int wc, int fr, int fq) const {
        const int hd = u.pn * 4 + wc, which = hd / 24, g = (hd % 24) >> 3, h = hd & 7;
        f32x4 gv[2][2];
#pragma unroll
        for (int bj = 0; bj < 2; ++bj)
#pragma unroll
            for (int n = 0; n < 2; ++n) {
                if (which == 0) gv[bj][n] = *(const f32x4*)(qg + g * 64 + 32 * bj + 8 * fq + 4 * n) * (0.125f * 1.4426950408889634f);
                else if (which == 1) gv[bj][n] = *(const f32x4*)(kg + g * 64 + 32 * bj + 8 * fq + 4 * n);
                else gv[bj][n] = (f32x4){1.f, 1.f, 1.f, 1.f}; }
        bf16_t* hb = QKV + (size_t)(which * 3 + g) * (8 * 8 * 4096 * 64) + (size_t)h * (4096 * 64) + (fr >> 3) * 32 + 8 * fq;
#pragma unroll
        for (int ai = 0; ai < 2; ++ai)
#pragma unroll
            for (int m = 0; m < 4; ++m) {
                float ss = 0.f;
#pragma unroll
                for (int bj = 0; bj < 2; ++bj)
#pragma unroll
                    for (int n = 0; n < 2; ++n) { const f32x4 x = acc[ai][bj][m][n]; ss += (x[0] * x[0] + x[1] * x[1]) + (x[2] * x[2] + x[3] * x[3]); }
                ss = xrow_sum(ss);
                const float rinv = which < 2 ? __builtin_amdgcn_rsqf(ss * (1.0f / 64.0f) + 1e-6f) : 1.0f;
                u32x4 w[2];
#pragma unroll
                for (int bj = 0; bj < 2; ++bj) { const f32x4 v0 = acc[ai][bj][m][0] * rinv * gv[bj][0], v1 = acc[ai][bj][m][1] * rinv * gv[bj][1];
                    w[bj].x = cvt_pk_bf16(v0[0], v0[1]); w[bj].y = cvt_pk_bf16(v0[2], v0[3]); w[bj].z = cvt_pk_bf16(v1[0], v1[1]); w[bj].w = cvt_pk_bf16(v1[2], v1[3]); }
                u32x4 s1, s2; xchg_rows(w[0], w[1], s1, s2);
                const int row = u.pm * BM + ai * HALF + wr * 64 + m * 16 + (fr & 7), b = row >> 12, sq = row & 4095;
                bf16_t* dst = hb + (size_t)b * (8 * 4096 * 64) + (size_t)sq * 64;
                *(u32x4*)dst = s1; *(u32x4*)(dst + 8 * 64) = s2; }
    }
};
struct EpiSwiGLU {
    static constexpr bool PERM = true, AFTER_DRAIN = false;
    bf16_t* HID;
    __device__ __forceinline__ void operator()(const f32x4 (&acc)[2][2][4][2], const Unit& u, int wr, int wc, int fr, int fq) const {
        const int row0 = u.pm * BM + wr * 64 + fr, col0 = (u.pn & 15) * HALF + wc * 32 + 8 * fq;
#pragma unroll
        for (int ai = 0; ai < 2; ++ai)
#pragma unroll
            for (int m = 0; m < 4; ++m) { bf16_t* rowp = HID + (size_t)(row0 + ai * HALF + m * 16) * 2048 + col0;
                const f32x4 a0 = acc[ai][0][m][0], a1 = acc[ai][0][m][1], b0 = acc[ai][1][m][0], b1 = acc[ai][1][m][1];
                u32x4 w; w.x = cvt_pk_bf16(silu_f(a0[0]) * b0[0], silu_f(a0[1]) * b0[1]); w.y = cvt_pk_bf16(silu_f(a0[2]) * b0[2], silu_f(a0[3]) * b0[3]);
                w.z = cvt_pk_bf16(silu_f(a1[0]) * b1[0], silu_f(a1[1]) * b1[1]); w.w = cvt_pk_bf16(silu_f(a1[2]) * b1[2], silu_f(a1[3]) * b1[3]);
                *(u32x4*)rowp = w; }
    }
};
struct EpiGate {
    static constexpr bool PERM = true, AFTER_DRAIN = false;
    bf16_t* Y; const float* gate;
    __device__ __forceinline__ void operator()(const f32x4 (&acc)[2][2][4][2], const Unit& u, int wr, int wc, int fr, int fq) const {
        const int rowb = u.pm * BM + wr * 64, colw = (u.pn & 3) * BM + wc * 64;
        bf16_t* ob = Y + (size_t)(rowb + (fr & 7)) * 1024 + colw + (fr >> 3) * 32 + 8 * fq;
#pragma unroll
        for (int ai = 0; ai < 2; ++ai)
#pragma unroll
            for (int m = 0; m < 4; ++m) { const float gt = gate[rowb + fr + ai * HALF + m * 16]; u32x4 w[2];
#pragma unroll
                for (int bj = 0; bj < 2; ++bj) { const f32x4 v0 = acc[ai][bj][m][0] * gt, v1 = acc[ai][bj][m][1] * gt;
                    w[bj].x = cvt_pk_bf16(v0[0], v0[1]); w[bj].y = cvt_pk_bf16(v0[2], v0[3]); w[bj].z = cvt_pk_bf16(v1[0], v1[1]); w[bj].w = cvt_pk_bf16(v1[2], v1[3]); }
                u32x4 s1, s2; xchg_rows(w[0], w[1], s1, s2);
                bf16_t* rp = ob + (size_t)(ai * HALF + m * 16) * 1024;
                *(u32x4*)rp = s1; *(u32x4*)(rp + 8 * 1024) = s2; }
    }
};

template <class Epi, class Sched, bool ALIGN_EPI = false, bool SP2 = false>
__device__ __forceinline__ void gemm_phase(PG8_LAS unsigned char* lds, const Gemm g, const Sched& S, const Epi& E) {
    int tid_ = threadIdx.x; asm volatile("" : "+v"(tid_));
    const int tid = tid_, wid = __builtin_amdgcn_readfirstlane(tid >> 6), lane = tid & 63, wr = wid >> 2, wc = wid & 3, fr = lane & 15, fq = lane >> 4;
    const int K = g.K, nt = K / BK;
    unsigned voffA[2], voffB0[2], voffB1[2];
#pragma unroll
    for (int i = 0; i < 2; ++i) { int R, C; stage_rc(tid * 16 + i * 8192, R, C); const int Rb = 64 * (R >> 5) + (Epi::PERM ? perm32(R & 31) : (R & 31));
        voffA[i] = (unsigned)(R * K + C) * 2u; voffB0[i] = (unsigned)(Rb * K + C) * 2u; voffB1[i] = (unsigned)((Rb + 32) * K + C) * 2u; }
    const size_t kstep = (size_t)(BK * 2);
    const size_t hstep = (size_t)HALF * K * 2;
    const size_t tstep = 2 * hstep;
    const unsigned ldsw = (unsigned)wid * 1024u;
    const int aoff = lds_byte(wr * 64 + fr, fq * 8), boff = lds_byte(wc * 32 + fr, fq * 8);
#define PG8_SA(b, h) (((b) * 2 + (h)) * HTB)
#define PG8_SB(b, h) ((4 + (b) * 2 + (h)) * HTB)
#define PG8_STAGE(bufoff, gbase, voff) do { _Pragma("unroll") for (int _i = 0; _i < 2; ++_i) \
        __builtin_amdgcn_global_load_lds((const unsigned*)((const char*)(gbase) + (voff)[_i]), (PG8_LAS unsigned*)(lds + (bufoff) + ldsw + _i * 8192), 16, 0, 0); } while (0)
#define PG8_LDA(dst, b, h) do { _Pragma("unroll") for (int m = 0; m < 4; ++m) _Pragma("unroll") for (int k = 0; k < 2; ++k) dst[m][k] = *(const PG8_LAS bf16x8*)(lds + PG8_SA(b, h) + aoff + m * 2048 + k * 1024); } while (0)
#define PG8_LDB(dst, b, h) do { _Pragma("unroll") for (int n = 0; n < 2; ++n) _Pragma("unroll") for (int k = 0; k < 2; ++k) dst[n][k] = *(const PG8_LAS bf16x8*)(lds + PG8_SB(b, h) + boff + n * 2048 + k * 1024); } while (0)
#define PG8_MMA(ai, bj, At, Bt) do { __builtin_amdgcn_s_setprio(1); _Pragma("unroll") for (int m = 0; m < 4; ++m) _Pragma("unroll") for (int n = 0; n < 2; ++n) _Pragma("unroll") for (int k = 0; k < 2; ++k) \
        acc[ai][bj][m][n] = __builtin_amdgcn_mfma_f32_16x16x32_bf16(Bt[n][k], At[m][k], acc[ai][bj][m][n], 0, 0, 0); __builtin_amdgcn_s_setprio(0); } while (0)
#define PG8_WAIT_V(n) asm volatile("s_waitcnt vmcnt(" #n ")" ::: "memory")
#define PG8_WAIT_L(n) asm volatile("s_waitcnt lgkmcnt(" #n ")" ::: "memory")
#define PG8_BAR __builtin_amdgcn_s_barrier()
#define PG8_SCHED __builtin_amdgcn_sched_barrier(0)
    Unit cur, nxt; int ui = 0;
    if (!S.next(0, cur)) return;
    f32x4 acc[2][2][4][2];
#pragma unroll
    for (int a = 0; a < 2; ++a)
#pragma unroll
        for (int b = 0; b < 2; ++b)
#pragma unroll
            for (int m = 0; m < 4; ++m)
#pragma unroll
                for (int n = 0; n < 2; ++n) acc[a][b][m][n] = (f32x4){0.f, 0.f, 0.f, 0.f};
    bf16x8 At[4][2], B0[2][2], B1[2][2];
    const char* cA = (const char*)g.A + (size_t)cur.pm * tstep; const char* cB = (const char*)g.Bt + (size_t)cur.pn * tstep;
    S.a_ready(cur);
    if constexpr (SP2) {
        PG8_STAGE(PG8_SB(0, 0), cB, voffB0); PG8_STAGE(PG8_SB(0, 1), cB, voffB1); PG8_STAGE(PG8_SA(0, 0), cA, voffA); PG8_STAGE(PG8_SA(0, 1), cA + hstep, voffA);
        if (wr == 1) PG8_BAR;
        PG8_WAIT_V(2); PG8_BAR;
        PG8_STAGE(PG8_SB(1, 0), cB + kstep, voffB0); PG8_STAGE(PG8_SA(1, 0), cA + kstep, voffA); PG8_STAGE(PG8_SB(1, 1), cB + kstep, voffB1);
        PG8_WAIT_V(6); PG8_BAR;
    } else {
        PG8_STAGE(PG8_SB(0, 0), cB, voffB0); PG8_STAGE(PG8_SA(0, 0), cA, voffA); PG8_STAGE(PG8_SB(0, 1), cB, voffB1); PG8_STAGE(PG8_SA(0, 1), cA + hstep, voffA);
        if (wr == 1) PG8_BAR;
        PG8_WAIT_V(4); PG8_BAR;
        PG8_STAGE(PG8_SB(1, 0), cB + kstep, voffB0); PG8_STAGE(PG8_SA(1, 0), cA + kstep, voffA); PG8_STAGE(PG8_SB(1, 1), cB + kstep, voffB1);
        PG8_WAIT_V(6); PG8_BAR;
    }
    for (;;) {
        const bool has_next = S.next(ui + 1, nxt);
        const char* nA = has_next ? (const char*)g.A + (size_t)nxt.pm * tstep : cA; const char* nB = has_next ? (const char*)g.Bt + (size_t)nxt.pn * tstep : cB;
        for (int t = 0; t < nt; t += 2) {
            const bool last = (t == nt - 2);
            const char* a1 = cA + (size_t)(t + 1) * kstep;
            const char* a2 = last ? nA : cA + (size_t)(t + 2) * kstep; const char* b2 = last ? nB : cB + (size_t)(t + 2) * kstep;
            const char* a3 = a2 + kstep; const char* b3 = b2 + kstep;
            if (last && has_next) S.a_ready(nxt);
            if constexpr (SP2) {
            PG8_LDB(B0, 0, 0); PG8_LDB(B1, 0, 1); PG8_SCHED; PG8_LDA(At, 0, 0); PG8_STAGE(PG8_SA(1, 1), a1 + hstep, voffA);
            PG8_WAIT_V(8); PG8_WAIT_L(0); PG8_BAR; PG8_MMA(0, 0, At, B0); PG8_MMA(0, 1, At, B1); PG8_BAR; PG8_SCHED;
            PG8_LDA(At, 0, 1); PG8_STAGE(PG8_SB(0, 0), b2, voffB0); PG8_STAGE(PG8_SB(0, 1), b2, voffB1); PG8_STAGE(PG8_SA(0, 0), a2, voffA);
            PG8_WAIT_V(8); PG8_WAIT_L(0); PG8_BAR; PG8_MMA(1, 0, At, B0); PG8_MMA(1, 1, At, B1); PG8_BAR; PG8_SCHED;
            PG8_LDB(B0, 1, 0); PG8_LDB(B1, 1, 1); PG8_SCHED; PG8_LDA(At, 1, 0); PG8_STAGE(PG8_SA(0, 1), a2 + hstep, voffA);
            PG8_WAIT_V(8); PG8_WAIT_L(0); PG8_BAR; PG8_MMA(0, 0, At, B0); PG8_MMA(0, 1, At, B1); PG8_BAR; PG8_SCHED;
            PG8_LDA(At, 1, 1); PG8_STAGE(PG8_SB(1, 0), b3, voffB0); PG8_STAGE(PG8_SB(1, 1), b3, voffB1); PG8_STAGE(PG8_SA(1, 0), a3, voffA);
            PG8_WAIT_V(8); PG8_WAIT_L(0); PG8_BAR; PG8_MMA(1, 0, At, B0); PG8_MMA(1, 1, At, B1); PG8_BAR; PG8_SCHED;
            } else {
            PG8_LDB(B0, 0, 0); PG8_SCHED; PG8_LDA(At, 0, 0); PG8_STAGE(PG8_SA(1, 1), a1 + hstep, voffA);
            PG8_WAIT_L(8); PG8_BAR; PG8_WAIT_L(0); PG8_MMA(0, 0, At, B0); PG8_BAR; PG8_SCHED;
            PG8_LDB(B1, 0, 1); PG8_STAGE(PG8_SB(0, 0), b2, voffB0);
            PG8_BAR; PG8_WAIT_L(0); PG8_MMA(0, 1, At, B1); PG8_BAR;
            PG8_LDA(At, 0, 1); PG8_STAGE(PG8_SA(0, 0), a2, voffA);
            PG8_BAR; PG8_WAIT_L(0); PG8_MMA(1, 0, At, B0); PG8_BAR; PG8_SCHED;
            PG8_STAGE(PG8_SB(0, 1), b2, voffB1);
            PG8_WAIT_V(6); PG8_BAR; PG8_MMA(1, 1, At, B1); PG8_BAR;
            PG8_LDB(B0, 1, 0); PG8_SCHED; PG8_LDA(At, 1, 0); PG8_STAGE(PG8_SA(0, 1), a2 + hstep, voffA);
            PG8_WAIT_L(8); PG8_BAR; PG8_WAIT_L(0); PG8_MMA(0, 0, At, B0); PG8_BAR; PG8_SCHED;
            PG8_LDB(B1, 1, 1); PG8_STAGE(PG8_SB(1, 0), b3, voffB0);
            PG8_BAR; PG8_WAIT_L(0); PG8_MMA(0, 1, At, B1); PG8_BAR;
            PG8_LDA(At, 1, 1); PG8_STAGE(PG8_SA(1, 0), a3, voffA);
            PG8_BAR; PG8_WAIT_L(0); PG8_MMA(1, 0, At, B0); PG8_BAR; PG8_SCHED;
            PG8_STAGE(PG8_SB(1, 1), b3, voffB1);
            PG8_WAIT_V(6); PG8_BAR; PG8_MMA(1, 1, At, B1); PG8_BAR;
            }
        }
        if constexpr (ALIGN_EPI) { if (wr == 0) PG8_BAR; }
        if constexpr (!Epi::AFTER_DRAIN) { E(acc, cur, wr, wc, fr, fq); S.done(cur); }
        if (!has_next) break;
#pragma unroll
        for (int a = 0; a < 2; ++a)
#pragma unroll
            for (int b = 0; b < 2; ++b)
#pragma unroll
                for (int m = 0; m < 4; ++m)
#pragma unroll
                    for (int n = 0; n < 2; ++n) acc[a][b][m][n] = (f32x4){0.f, 0.f, 0.f, 0.f};
        cur = nxt; cA = nA; cB = nB; ++ui;
        if constexpr (ALIGN_EPI) { if (wr == 1) PG8_BAR; }
    }
    PG8_WAIT_V(0);
    if constexpr (!ALIGN_EPI) { if (wr == 0) PG8_BAR; }
    PG8_BAR;
#undef PG8_SA
#undef PG8_SB
#undef PG8_STAGE
#undef PG8_LDA
#undef PG8_LDB
#undef PG8_MMA
#undef PG8_WAIT_V
#undef PG8_WAIT_L
#undef PG8_BAR
#undef PG8_SCHED
}
template <class Epi, class Sched>
__device__ __forceinline__ void gemm_phase_gather(PG8_LAS unsigned char* lds, const Gemm g, const int* rowmap, const Sched& S, const Epi& E) {
    constexpr bool ALIGN_EPI = true, SP2 = true;
    int tid_ = threadIdx.x; asm volatile("" : "+v"(tid_));
    const int tid = tid_, wid = __builtin_amdgcn_readfirstlane(tid >> 6), lane = tid & 63, wr = wid >> 2, wc = wid & 3, fr = lane & 15, fq = lane >> 4;
    const int K = g.K, nt = K / BK;
    unsigned voffB0[2], voffB1[2]; int rA[2]; unsigned cA2[2];
#pragma unroll
    for (int i = 0; i < 2; ++i) { int R, C; stage_rc(tid * 16 + i * 8192, R, C); const int Rb = 64 * (R >> 5) + (Epi::PERM ? perm32(R & 31) : (R & 31));
        rA[i] = R; cA2[i] = (unsigned)C * 2u; voffB0[i] = (unsigned)(Rb * K + C) * 2u; voffB1[i] = (unsigned)((Rb + 32) * K + C) * 2u; }
    const unsigned rowb = (unsigned)K * 2u;
    const size_t kstep = (size_t)(BK * 2);
    const size_t hstep = (size_t)HALF * K * 2;
    const size_t tstep = 2 * hstep;
    const unsigned ldsw = (unsigned)wid * 1024u;
    const int aoff = lds_byte(wr * 64 + fr, fq * 8), boff = lds_byte(wc * 32 + fr, fq * 8);
#define PG8_SA(b, h) (((b) * 2 + (h)) * HTB)
#define PG8_SB(b, h) ((4 + (b) * 2 + (h)) * HTB)
#define PG8_STAGE(bufoff, gbase, voff) do { _Pragma("unroll") for (int _i = 0; _i < 2; ++_i) \
        __builtin_amdgcn_global_load_lds((const unsigned*)((const char*)(gbase) + (voff)[_i]), (PG8_LAS unsigned*)(lds + (bufoff) + ldsw + _i * 8192), 16, 0, 0); } while (0)
#define PG8_LDA(dst, b, h) do { _Pragma("unroll") for (int m = 0; m < 4; ++m) _Pragma("unroll") for (int k = 0; k < 2; ++k) dst[m][k] = *(const PG8_LAS bf16x8*)(lds + PG8_SA(b, h) + aoff + m * 2048 + k * 1024); } while (0)
#define PG8_LDB(dst, b, h) do { _Pragma("unroll") for (int n = 0; n < 2; ++n) _Pragma("unroll") for (int k = 0; k < 2; ++k) dst[n][k] = *(const PG8_LAS bf16x8*)(lds + PG8_SB(b, h) + boff + n * 2048 + k * 1024); } while (0)
#define PG8_MMA(ai, bj, At, Bt) do { __builtin_amdgcn_s_setprio(1); _Pragma("unroll") for (int m = 0; m < 4; ++m) _Pragma("unroll") for (int n = 0; n < 2; ++n) _Pragma("unroll") for (int k = 0; k < 2; ++k) \
        acc[ai][bj][m][n] = __builtin_amdgcn_mfma_f32_16x16x32_bf16(Bt[n][k], At[m][k], acc[ai][bj][m][n], 0, 0, 0); __builtin_amdgcn_s_setprio(0); } while (0)
#define PG8_WAIT_V(n) asm volatile("s_waitcnt vmcnt(" #n ")" ::: "memory")
#define PG8_WAIT_L(n) asm volatile("s_waitcnt lgkmcnt(" #n ")" ::: "memory")
#define PG8_BAR __builtin_amdgcn_s_barrier()
#define PG8_SCHED __builtin_amdgcn_sched_barrier(0)
    Unit cur, nxt; int ui = 0;
    if (!S.next(0, cur)) return;
    f32x4 acc[2][2][4][2];
#pragma unroll
    for (int a = 0; a < 2; ++a)
#pragma unroll
        for (int b = 0; b < 2; ++b)
#pragma unroll
            for (int m = 0; m < 4; ++m)
#pragma unroll
                for (int n = 0; n < 2; ++n) acc[a][b][m][n] = (f32x4){0.f, 0.f, 0.f, 0.f};
    bf16x8 At[4][2], B0[2][2], B1[2][2];
    const char* const gA = (const char*)g.A; const char* cB = (const char*)g.Bt + (size_t)cur.pn * tstep;
    unsigned va[2][2], vn[2][2]; unsigned nraw[2][2];
#pragma unroll
    for (int h = 0; h < 2; ++h)
#pragma unroll
        for (int i = 0; i < 2; ++i) { va[h][i] = (unsigned)rowmap[cur.pm * BM + h * HALF + rA[i]] * rowb + cA2[i]; vn[h][i] = va[h][i]; nraw[h][i] = 0u; }
    S.a_ready(cur);
    if constexpr (SP2) {
        PG8_STAGE(PG8_SB(0, 0), cB, voffB0); PG8_STAGE(PG8_SB(0, 1), cB, voffB1); PG8_STAGE(PG8_SA(0, 0), gA, va[0]); PG8_STAGE(PG8_SA(0, 1), gA, va[1]);
        if (wr == 1) PG8_BAR;
        PG8_WAIT_V(2); PG8_BAR;
        PG8_STAGE(PG8_SB(1, 0), cB + kstep, voffB0); PG8_STAGE(PG8_SA(1, 0), gA + kstep, va[0]); PG8_STAGE(PG8_SB(1, 1), cB + kstep, voffB1);
        PG8_WAIT_V(6); PG8_BAR;
    }
    for (;;) {
        const bool has_next = S.next(ui + 1, nxt);
        const char* nB = has_next ? (const char*)g.Bt + (size_t)nxt.pn * tstep : cB;
        if (has_next) {
#pragma unroll
            for (int h = 0; h < 2; ++h)
#pragma unroll
                for (int i = 0; i < 2; ++i) { const int* rp = rowmap + nxt.pm * BM + h * HALF + rA[i]; asm volatile("global_load_dword %0, %1, off" : "=v"(nraw[h][i]) : "v"(rp) : "memory"); } }
        for (int t = 0; t < nt; t += 2) {
            const bool last = (t == nt - 2);
            if (last && has_next) {
#pragma unroll
                for (int h = 0; h < 2; ++h)
#pragma unroll
                    for (int i = 0; i < 2; ++i) { unsigned x = nraw[h][i]; asm volatile("" : "+v"(x)); vn[h][i] = x * rowb + cA2[i]; } }
            const char* a1 = gA + (size_t)(t + 1) * kstep;
            const char* a2 = last ? gA : gA + (size_t)(t + 2) * kstep; const char* b2 = last ? nB : cB + (size_t)(t + 2) * kstep;
            const char* a3 = a2 + kstep; const char* b3 = b2 + kstep;
            unsigned v2[2][2];
#pragma unroll
            for (int h = 0; h < 2; ++h)
#pragma unroll
                for (int i = 0; i < 2; ++i) v2[h][i] = last ? vn[h][i] : va[h][i];
            if (last && has_next) S.a_ready(nxt);
            if constexpr (SP2) {
            PG8_LDB(B0, 0, 0); PG8_LDB(B1, 0, 1); PG8_SCHED; PG8_LDA(At, 0, 0); PG8_STAGE(PG8_SA(1, 1), a1, va[1]);
            PG8_WAIT_V(8); PG8_WAIT_L(0); PG8_BAR; PG8_MMA(0, 0, At, B0); PG8_MMA(0, 1, At, B1); PG8_BAR; PG8_SCHED;
            PG8_LDA(At, 0, 1); PG8_STAGE(PG8_SB(0, 0), b2, voffB0); PG8_STAGE(PG8_SB(0, 1), b2, voffB1); PG8_STAGE(PG8_SA(0, 0), a2, v2[0]);
            PG8_WAIT_V(8); PG8_WAIT_L(0); PG8_BAR; PG8_MMA(1, 0, At, B0); PG8_MMA(1, 1, At, B1); PG8_BAR; PG8_SCHED;
            PG8_LDB(B0, 1, 0); PG8_LDB(B1, 1, 1); PG8_SCHED; PG8_LDA(At, 1, 0); PG8_STAGE(PG8_SA(0, 1), a2, v2[1]);
            PG8_WAIT_V(8); PG8_WAIT_L(0); PG8_BAR; PG8_MMA(0, 0, At, B0); PG8_MMA(0, 1, At, B1); PG8_BAR; PG8_SCHED;
            PG8_LDA(At, 1, 1); PG8_STAGE(PG8_SB(1, 0), b3, voffB0); PG8_STAGE(PG8_SB(1, 1), b3, voffB1); PG8_STAGE(PG8_SA(1, 0), a3, v2[0]);
            PG8_WAIT_V(8); PG8_WAIT_L(0); PG8_BAR; PG8_MMA(1, 0, At, B0); PG8_MMA(1, 1, At, B1); PG8_BAR; PG8_SCHED;
            }
        }
        if constexpr (ALIGN_EPI) { if (wr == 0) PG8_BAR; }
        if constexpr (!Epi::AFTER_DRAIN) { E(acc, cur, wr, wc, fr, fq); S.done(cur); }
        if (!has_next) break;
#pragma unroll
        for (int a = 0; a < 2; ++a)
#pragma unroll
            for (int b = 0; b < 2; ++b)
#pragma unroll
                for (int m = 0; m < 4; ++m)
#pragma unroll
                    for (int n = 0; n < 2; ++n) acc[a][b][m][n] = (f32x4){0.f, 0.f, 0.f, 0.f};
        cur = nxt; cB = nB; ++ui;
#pragma unroll
        for (int h = 0; h < 2; ++h)
#pragma unroll
            for (int i = 0; i < 2; ++i) va[h][i] = vn[h][i];
        if constexpr (ALIGN_EPI) { if (wr == 1) PG8_BAR; }
    }
    PG8_WAIT_V(0);
    if constexpr (!ALIGN_EPI) { if (wr == 0) PG8_BAR; }
    PG8_BAR;
#undef PG8_SA
#undef PG8_SB
#undef PG8_STAGE
#undef PG8_LDA
#undef PG8_LDB
#undef PG8_MMA
#undef PG8_WAIT_V
#undef PG8_WAIT_L
#undef PG8_BAR
#undef PG8_SCHED
}
}

constexpr int NB = 8, SEQ = 4096, D = 1024, T = NB * SEQ;
constexpr int GW = 3072;
constexpr int NE = 16, CAP = 512, DE = 2048, NSLOT = NB * NE * CAP;
constexpr int QKVW = 4608, AW = 512;
constexpr float EPS = 1e-6f;

constexpr size_t MiB = 1u << 20;
constexpr size_t WS_CTL = 0, CTL_ZERO_BYTES = 1 * MiB;
constexpr size_t WS_WIN = 1 * MiB;
constexpr size_t WS_WOUT = 25 * MiB;
constexpr size_t WS_WQKV = 37 * MiB;
constexpr size_t WS_WO = 55 * MiB;
constexpr size_t WS_W13 = 57 * MiB;
constexpr size_t WS_W2 = 569 * MiB;
constexpr size_t WS_H = 825 * MiB;
constexpr size_t WS_AFF = 889 * MiB;
constexpr size_t WS_SMAP = 891 * MiB;
constexpr size_t WS_TOK = 893 * MiB;
constexpr size_t WS_GATE = 893 * MiB + 512 * 1024;
constexpr size_t WS_XB = 894 * MiB;
constexpr size_t WS_ACT = 1022 * MiB;
constexpr size_t WS_U = WS_ACT, WS_VT = WS_ACT + 192 * MiB, WS_SSQ = WS_ACT + 384 * MiB, WS_UV = WS_ACT + 388 * MiB;
constexpr size_t WS_QKV = WS_ACT, WS_OG = WS_ACT + 288 * MiB, WS_LSE = WS_ACT + 384 * MiB, WS_O = WS_ACT + 388 * MiB;
constexpr size_t WS_XIN = WS_ACT, WS_HID = WS_ACT + 128 * MiB, WS_Y = WS_ACT + 384 * MiB;
constexpr size_t WS_END = WS_ACT + 580 * MiB;
constexpr int CW_BAR = 4096;

constexpr int RING_BYTES = 131072, LDS_BYTES = 147456, LDSCTL_OFF = LDS_BYTES - 256;

#define LAS __attribute__((address_space(3)))
typedef unsigned short bf16;
typedef unsigned v4u __attribute__((ext_vector_type(4)));
typedef unsigned v2u __attribute__((ext_vector_type(2)));
typedef float f32x4 __attribute__((ext_vector_type(4)));
typedef short bf16x8 __attribute__((ext_vector_type(8)));
#define LDS_WAIT() asm volatile("s_waitcnt lgkmcnt(0)" ::: "memory")
__device__ __forceinline__ unsigned f2bf(float f) { unsigned u = __builtin_bit_cast(unsigned, f); return (u + 0x7fffu + ((u >> 16) & 1u)) >> 16; }
typedef float f32x2_t __attribute__((ext_vector_type(2))); typedef __bf16 bf16x2_t __attribute__((ext_vector_type(2)));
__device__ __forceinline__ unsigned pk2(float lo, float hi) { const f32x2_t v = {lo, hi}; return __builtin_bit_cast(unsigned, __builtin_convertvector(v, bf16x2_t)); }
__device__ __forceinline__ float bf_lo(unsigned w) { return __builtin_bit_cast(float, w << 16); }
__device__ __forceinline__ float bf_hi(unsigned w) { return __builtin_bit_cast(float, w & 0xffff0000u); }

#define XB_TMO      128
#define XB_XCNT(j)  (256  + 64 * (j))
#define XB_XSUB(j)  (1280 + 64 * (j))
#define XB_XGEN(j)  (2304 + 64 * (j))
#define XB_TOP      3328
#define XB_TOPGEN   3392
#define XCD_BAR_WORDS 3456
#define XB_SPIN_CAP (1u << 22)
__device__ __forceinline__ unsigned xb_ld(unsigned* p)              { return __hip_atomic_load(p, __ATOMIC_RELAXED, __HIP_MEMORY_SCOPE_AGENT); }
__device__ __forceinline__ unsigned xb_add(unsigned* p, unsigned v) { return __hip_atomic_fetch_add(p, v, __ATOMIC_RELAXED, __HIP_MEMORY_SCOPE_AGENT); }
__device__ __forceinline__ unsigned xb_xcc_id() { return (unsigned)__builtin_amdgcn_s_getreg((3 << 11) | 20) & 0xFu; }
#define XB_SPIN(cond, bar) do { unsigned _sp = 0; while (cond) { __builtin_amdgcn_s_sleep(1); \
    if ((++_sp & 255u) == 0u) { if (xb_ld(&(bar)[XB_TMO])) break; if (_sp > XB_SPIN_CAP) { atomicAdd(&(bar)[XB_TMO], 1u); break; } } } } while (0)
struct XcdBarrier { unsigned* bar; unsigned x; volatile LAS unsigned* st; };
__device__ __forceinline__ XcdBarrier xcd_barrier_post(unsigned* bar, volatile LAS unsigned* st) {
    XcdBarrier b; b.bar = bar; b.x = xb_xcc_id(); b.st = st;
    if (threadIdx.x == 0) (void)xb_add(&bar[XB_XCNT(b.x)], 1u);
    return b;
}
__device__ __forceinline__ void xcd_barrier_complete(unsigned* bar, unsigned x, unsigned& nloc, unsigned& nx) {
    const unsigned G = gridDim.x * gridDim.y * gridDim.z;
    unsigned sum, cnt, mine, sp = 0u;
    for (;;) {
        sum = 0u; cnt = 0u; mine = 0u;
#pragma unroll
        for (unsigned j = 0; j < 16; ++j) { const unsigned c = xb_ld(&bar[XB_XCNT(j)]); sum += c; cnt += (c > 0u) ? 1u : 0u; mine = (j == x) ? c : mine; }
        if (sum == G) break;
        __builtin_amdgcn_s_sleep(1);
        if ((++sp & 255u) == 0u) { if (xb_ld(&bar[XB_TMO])) break; if (sp > XB_SPIN_CAP) { atomicAdd(&bar[XB_TMO], 1u); break; } }
    }
    nloc = mine > 0u ? mine : 1u; nx = cnt > 0u ? cnt : 1u;
}
__device__ __forceinline__ void xcd_barrier(const XcdBarrier& b) {
    asm volatile("s_waitcnt vmcnt(0)" ::: "memory");
    __syncthreads();
    if (threadIdx.x == 0) {
        unsigned* bar = b.bar;
        __builtin_amdgcn_s_waitcnt(0);
        unsigned nloc = b.st[0], nx = b.st[1];
        if (nloc == 0u) { xcd_barrier_complete(bar, b.x, nloc, nx); b.st[0] = nloc; b.st[1] = nx; }
        const unsigned old = xb_add(&bar[XB_XSUB(b.x)], 1u);
        const unsigned gen = old / nloc;
        if (old + 1u == (gen + 1u) * nloc) {
            __builtin_amdgcn_fence(__ATOMIC_RELEASE, "agent");
            asm volatile("s_waitcnt vmcnt(0)" ::: "memory");
            const unsigned og = xb_add(&bar[XB_TOP], 1u);
            const unsigned tg = og / nx;
            if (og + 1u == (tg + 1u) * nx) xb_add(&bar[XB_TOPGEN], 1u);
            else XB_SPIN(xb_ld(&bar[XB_TOPGEN]) == tg, bar);
            __builtin_amdgcn_fence(__ATOMIC_ACQUIRE, "agent");
            xb_add(&bar[XB_XGEN(b.x)], 1u);
            asm volatile("s_waitcnt vmcnt(0)" ::: "memory");
        } else {
            XB_SPIN(xb_ld(&bar[XB_XGEN(b.x)]) == gen, bar);
            __builtin_amdgcn_fence(__ATOMIC_ACQUIRE, "agent");
            asm volatile("s_waitcnt vmcnt(0)" ::: "memory");
        }
    }
    __syncthreads();
}

struct Args {
    const float* x; const float* mix_norm; const float* ffn_norm;
    const float* gm_w_in; const float* gm_b_in; const float* gm_v_norm; const float* gm_w_s; const float* gm_b_s; const float* gm_w_out; const float* gm_b_out;
    const float* at_w_qkv; const float* at_q_norm; const float* at_k_norm; const float* at_w_o;
    const float* moe_w_router; const float* moe_b_router; const float* moe_w1; const float* moe_w3; const float* moe_w2;
    float* out; unsigned char* ws; int ph_lo, ph_hi;
};

template <int CTRL> __device__ __forceinline__ float dppf(float v) { return __builtin_bit_cast(float, __builtin_amdgcn_update_dpp(0, __builtin_bit_cast(int, v), CTRL, 0xF, 0xF, true)); }
__device__ __forceinline__ float row_sum(float v) { v += dppf<0xB1>(v); v += dppf<0x4E>(v); v += dppf<0x141>(v); v += dppf<0x140>(v); return v; }
__device__ __forceinline__ float row_max(float v) { v = fmaxf(v, dppf<0xB1>(v)); v = fmaxf(v, dppf<0x4E>(v)); v = fmaxf(v, dppf<0x141>(v)); v = fmaxf(v, dppf<0x140>(v)); return v; }
__device__ __forceinline__ float wave_sum(float v) {
    v = row_sum(v);
    { auto rr = __builtin_amdgcn_permlane16_swap(__float_as_uint(v), __float_as_uint(v), false, false); v = __uint_as_float(rr[0]) + __uint_as_float(rr[1]); }
    { auto rr = __builtin_amdgcn_permlane32_swap(__float_as_uint(v), __float_as_uint(v), false, false); v = __uint_as_float(rr[0]) + __uint_as_float(rr[1]); }
    return v;
}

template <int MAP> __device__ __forceinline__ int wt_drow(int n) {
    if (MAP == 2) return 256 * (n >> 7) + 64 * ((n >> 5) & 3) + (n & 31);
    if (MAP == 3) return 256 * (n >> 7) + 64 * ((n >> 5) & 3) + 32 + (n & 31);
    return n;
}
template <int MAP> __device__ __forceinline__ void transpose_item(const float* __restrict__ W, int K, int N, bf16* WT, int k0, int n0, LAS float* scr, int lane) {
    f32x4 x[16];
#pragma unroll
    for (int i = 0; i < 16; ++i) x[i] = __builtin_nontemporal_load((const f32x4*)(W + (size_t)(k0 + 4 * i + (lane >> 4)) * N + n0 + 4 * (lane & 15)));
#pragma unroll
    for (int i = 0; i < 16; ++i) { LAS float* d = scr + (4 * i + (lane >> 4)) * 65 + 4 * (lane & 15); d[0] = x[i].x; d[1] = x[i].y; d[2] = x[i].z; d[3] = x[i].w; }
    LDS_WAIT(); asm volatile("" ::: "memory");
    const int c = lane & 7;
#pragma unroll
    for (int j = 0; j < 8; ++j) { const int n = (lane >> 3) + 8 * j; const LAS float* sp = scr + (8 * c) * 65 + n;
        v4u o; o.x = pk2(sp[0 * 65], sp[1 * 65]); o.y = pk2(sp[2 * 65], sp[3 * 65]); o.z = pk2(sp[4 * 65], sp[5 * 65]); o.w = pk2(sp[6 * 65], sp[7 * 65]);
        __builtin_nontemporal_store(o, (v4u*)(WT + (size_t)wt_drow<MAP>(n0 + n) * K + k0 + 8 * c)); }
    LDS_WAIT(); asm volatile("" ::: "memory");
}

__device__ __forceinline__ void rms_row_to_bf16(const float* xrow, const float* gain, bf16* orow, int lane) {
    const f32x4* xr = (const f32x4*)xrow + lane; const f32x4* gr = (const f32x4*)gain + lane;
    f32x4 v[4]; float s = 0.f;
#pragma unroll
    for (int j = 0; j < 4; ++j) { v[j] = xr[64 * j]; s += (v[j].x * v[j].x + v[j].y * v[j].y) + (v[j].z * v[j].z + v[j].w * v[j].w); }
    const float rinv = 1.0f / sqrtf(wave_sum(s) * (1.f / D) + EPS);
    unsigned long long* o8 = (unsigned long long*)orow + lane;
#pragma unroll
    for (int j = 0; j < 4; ++j) { const f32x4 g = gr[64 * j]; const f32x4 y = v[j] * rinv * g;
        o8[64 * j] = (unsigned long long)pk2(y.x, y.y) | ((unsigned long long)pk2(y.z, y.w) << 32); }
}

__device__ __forceinline__ void moe_convert_item(const Args& a, int layer, int it, LAS float* scr, int lane) {
    unsigned char* ws = a.ws;
    const int q = it >> 9, r = it & 511, le = layer * 16 + q / 3, which = q % 3;
    if (which == 0) transpose_item<2>(a.moe_w1 + (size_t)le * 1024 * 2048, 1024, 2048, (bf16*)(ws + WS_W13) + (size_t)le * 4096 * 1024, (r >> 5) * 64, (r & 31) * 64, scr, lane);
    else if (which == 1) transpose_item<3>(a.moe_w3 + (size_t)le * 1024 * 2048, 1024, 2048, (bf16*)(ws + WS_W13) + (size_t)le * 4096 * 1024, (r >> 5) * 64, (r & 31) * 64, scr, lane);
    else transpose_item<0>(a.moe_w2 + (size_t)le * 2048 * 1024, 2048, 1024, (bf16*)(ws + WS_W2) + (size_t)le * 1024 * 2048, (r >> 4) * 64, (r & 15) * 64, scr, lane);
}
constexpr int MOE_ITEMS_PER_LAYER = 16 * 3 * 512;
__device__ __forceinline__ void moe_convert_layer(const Args& a, int layer, LAS unsigned char* lds, int w, int nw) {
    int tid = threadIdx.x; asm volatile("" : "+v"(tid)); const int lane = tid & 63, wave = __builtin_amdgcn_readfirstlane(tid >> 6);
    LAS float* scr = (LAS float*)(lds + wave * 16640);
    for (int it = w; it < MOE_ITEMS_PER_LAYER; it += nw) moe_convert_item(a, layer, it, scr, lane);
}
__device__ __forceinline__ void prologue_phase(const Args& a, LAS unsigned char* lds, int nmoe) {
    int tid = threadIdx.x; asm volatile("" : "+v"(tid)); const int lane = tid & 63, wave = __builtin_amdgcn_readfirstlane(tid >> 6); (void)lane; (void)wave;
    LAS float* scr = (LAS float*)(lds + wave * 16640);
    const int gw = blockIdx.x * 8 + wave, NGW = gridDim.x * 8;
    unsigned char* ws = a.ws;
    const int IT_MOE = nmoe * MOE_ITEMS_PER_LAYER, NITEMS = IT_MOE + 3072 + 1536 + 2304 + 256;
    for (int it = gw; it < NITEMS; it += NGW) {
        if (it < IT_MOE) { moe_convert_item(a, it / MOE_ITEMS_PER_LAYER, it % MOE_ITEMS_PER_LAYER, scr, lane);
        } else {
            int r = it - IT_MOE;
            if (r < 3072) { const int j = r / 1536, rr = r % 1536; transpose_item<0>(a.gm_w_in + (size_t)j * 1024 * 6144, 1024, 6144, (bf16*)(ws + WS_WIN) + (size_t)j * 6144 * 1024, (rr / 96) * 64, (rr % 96) * 64, scr, lane); }
            else if (r < 3072 + 1536) { r -= 3072; const int j = r / 768, rr = r % 768; transpose_item<0>(a.gm_w_out + (size_t)j * 3072 * 1024, 3072, 1024, (bf16*)(ws + WS_WOUT) + (size_t)j * 1024 * 3072, (rr >> 4) * 64, (rr & 15) * 64, scr, lane); }
            else if (r < 3072 + 1536 + 2304) { r -= 3072 + 1536; const int j = r / 1152, rr = r % 1152; transpose_item<0>(a.at_w_qkv + (size_t)j * 1024 * 4608, 1024, 4608, (bf16*)(ws + WS_WQKV) + (size_t)j * 4608 * 1024, (rr / 72) * 64, (rr % 72) * 64, scr, lane); }
            else { r -= 3072 + 1536 + 2304; const int j = r >> 7, rr = r & 127; transpose_item<0>(a.at_w_o + (size_t)j * 512 * 1024, 512, 1024, (bf16*)(ws + WS_WO) + (size_t)j * 1024 * 512, (rr >> 4) * 64, (rr & 15) * 64, scr, lane); }
        }
    }
    bf16* H = (bf16*)(ws + WS_H);
    for (int m = gw; m < T; m += NGW) rms_row_to_bf16(a.x + (size_t)m * D, a.mix_norm, H + (size_t)m * D, lane);
}

__device__ __forceinline__ void gating_phase(const Args& a, int j, LAS unsigned char* lds) {
    int tid = threadIdx.x; asm volatile("" : "+v"(tid)); const int lane = tid & 63, wave = __builtin_amdgcn_readfirstlane(tid >> 6);
    LAS unsigned short* Wl = (LAS unsigned short*)lds;
    LAS float* rinv = (LAS float*)(lds + 36864);
    LAS float* part = (LAS float*)(lds + 37888);
    LAS unsigned char* stage = lds + 40960;
    const float* Ws = a.gm_w_s + (size_t)j * 8 * 128 * 128; const float* bs = a.gm_b_s + j * 8 * 128; const float* vg = a.gm_v_norm + j * GW;
    const bf16* U = (const bf16*)(a.ws + WS_U); bf16* UV = (bf16*)(a.ws + WS_UV); const bf16* VT = (const bf16*)(a.ws + WS_VT); const float* SSQ = (const float*)(a.ws + WS_SSQ);
    const int fr = lane & 15, fq = lane >> 4;
    int cur_g = -1;
    bf16x8 vf[3][4]; float ssum = 0.f;
#define GATE_REQUEST(unit_) do { const int g_ = (unit_) & 7, tok0_ = ((unit_) >> 3) * 128; \
        _Pragma("unroll") for (int n = 0; n < 3; ++n) _Pragma("unroll") for (int ks = 0; ks < 4; ++ks) \
            vf[n][ks] = *(const bf16x8*)(VT + ((size_t)(tok0_ >> 7) * 3072 + g_ * 384 + 48 * wave + 16 * n + fr) * 128 + 32 * ks + 8 * fq); \
        ssum = 0.f; _Pragma("unroll") for (int q = 0; q < 6; ++q) ssum += SSQ[(size_t)(6 * (tid >> 7) + q) * T + tok0_ + (tid & 127)]; } while (0)
    if (blockIdx.x < 2048) GATE_REQUEST(blockIdx.x);
    for (int unit = blockIdx.x; unit < 2048; unit += gridDim.x) {
        const int g = unit & 7, tok0 = (unit >> 3) * 128;
        __syncthreads();
        if (g != cur_g) {
            int tw = tid; asm volatile("" : "+v"(tw));
#pragma unroll
            for (int i = 0; i < 8; ++i) { const int idx = (tw + 512 * i) * 4, t = idx >> 7, s0 = idx & 127; const f32x4 w = *(const f32x4*)(Ws + g * 16384 + idx);
                v2u o; o.x = pk2(w.x, w.y); o.y = pk2(w.z, w.w); *(LAS v2u*)(Wl + t * 136 + s0) = o; }
            cur_g = g; }
        part[tid] = ssum;
        __syncthreads();
        if (tid < 128) rinv[tid] = 1.0f / sqrtf(((part[tid] + part[128 + tid]) + (part[256 + tid] + part[384 + tid])) * (1.0f / GW) + EPS);
        __syncthreads();
#pragma unroll
        for (int ks = 0; ks < 4; ++ks) { const f32x4 r0 = *(const LAS f32x4*)(rinv + 32 * ks + 8 * fq), r1 = *(const LAS f32x4*)(rinv + 32 * ks + 8 * fq + 4);
#pragma unroll
            for (int n = 0; n < 3; ++n) { const v4u x = __builtin_bit_cast(v4u, vf[n][ks]); v4u y;
                y.x = pk2(bf_lo(x.x) * r0.x, bf_hi(x.x) * r0.y); y.y = pk2(bf_lo(x.y) * r0.z, bf_hi(x.y) * r0.w);
                y.z = pk2(bf_lo(x.z) * r1.x, bf_hi(x.z) * r1.y); y.w = pk2(bf_lo(x.w) * r1.z, bf_hi(x.w) * r1.w);
                vf[n][ks] = __builtin_bit_cast(bf16x8, y); } }
#pragma unroll 1
        for (int mh = 0; mh < 2; ++mh) {
            v4u ug[6];
            int te = tid; asm volatile("" : "+v"(te));
#pragma unroll
            for (int k = 0; k < 6; ++k) { const int c = te + 512 * k, row = c / 48, c8 = c % 48; ug[k] = *(const v4u*)(U + (size_t)(tok0 + 64 * mh + row) * GW + g * 384 + c8 * 8); }
            f32x4 acc[4][3];
#pragma unroll
            for (int m = 0; m < 4; ++m)
#pragma unroll
                for (int n = 0; n < 3; ++n) acc[m][n] = (f32x4){0.f, 0.f, 0.f, 0.f};
#pragma unroll
            for (int ks = 0; ks < 4; ++ks)
#pragma unroll
                for (int m = 0; m < 4; ++m) { const bf16x8 wf = *(const LAS bf16x8*)(Wl + (64 * mh + 16 * m + fr) * 136 + 32 * ks + 8 * fq);
#pragma unroll
                    for (int n = 0; n < 3; ++n) acc[m][n] = __builtin_amdgcn_mfma_f32_16x16x32_bf16(vf[n][ks], wf, acc[m][n], 0, 0, 0); }
            if (mh == 1 && unit + (int)gridDim.x < 2048) { asm volatile("" ::: "memory"); GATE_REQUEST(unit + (int)gridDim.x); }
#pragma unroll
            for (int n = 0; n < 3; ++n) { const int el = 48 * wave + 16 * n + 4 * fq; const f32x4 gn = *(const f32x4*)(vg + g * 384 + el);
#pragma unroll
                for (int m = 0; m < 4; ++m) { const int tl = 16 * m + fr; const float bt = bs[g * 128 + 64 * mh + tl];
                    *(LAS f32x4*)(stage + tl * 1552 + el * 4) = acc[m][n] * gn + bt; } }
            __syncthreads();
#pragma unroll
            for (int k = 0; k < 6; ++k) { const int c = te + 512 * k, row = c / 48, c8 = c % 48;
                const f32x4 g0 = *(const LAS f32x4*)(stage + row * 1552 + c8 * 32), g1 = *(const LAS f32x4*)(stage + row * 1552 + c8 * 32 + 16);
                v4u w; w.x = pk2(g0.x * bf_lo(ug[k].x), g0.y * bf_hi(ug[k].x)); w.y = pk2(g0.z * bf_lo(ug[k].y), g0.w * bf_hi(ug[k].y));
                w.z = pk2(g1.x * bf_lo(ug[k].z), g1.y * bf_hi(ug[k].z)); w.w = pk2(g1.z * bf_lo(ug[k].w), g1.w * bf_hi(ug[k].w));
                *(v4u*)(UV + (size_t)(tok0 + 64 * mh + row) * GW + g * 384 + c8 * 8) = w; }
            if (mh == 0) __syncthreads();
        }
    }
#undef GATE_REQUEST
}

typedef float f32x16 __attribute__((ext_vector_type(16)));
typedef short s16x4 __attribute__((ext_vector_type(4)));
typedef short v4i16_t __attribute__((ext_vector_type(4)));
__device__ __forceinline__ s16x4 vtr(const LAS unsigned char* p) { return __builtin_bit_cast(s16x4, __builtin_amdgcn_ds_read_tr16_b64_v4i16((LAS v4i16_t*)p)); }
__device__ __forceinline__ void attn_phase(const Args& a, LAS unsigned char* lds) {
    int tid = threadIdx.x; asm volatile("" : "+v"(tid)); const int lane = tid & 63, wave = __builtin_amdgcn_readfirstlane(tid >> 6), r32 = lane & 31, hi = lane >> 5;
    const bf16* QKV = (const bf16*)(a.ws + WS_QKV); bf16* OG = (bf16*)(a.ws + WS_OG); float* LSE = (float*)(a.ws + WS_LSE);
    LAS unsigned char* Kl = lds; LAS unsigned char* Vl = lds + 49152;
    LAS unsigned char* Ql = lds + 98304;
    constexpr size_t HEADSZ = (size_t)4096 * 64, WHICHSZ = (size_t)3 * 64 * 4096 * 64;
    v4u kr[6], vr[6], qv[4];
#define ATTN_DECODE(u_) const int g = (u_) >> 10, v = (u_) & 1023, bh = v >> 4, w16 = v & 15, dsh = 2 * g, dil = 1 << dsh, r = w16 & (dil - 1), blk = w16 >> dsh, L = 4096 >> dsh, p0 = blk * 256; \
        const bf16* qb = QKV + ((size_t)g * 64 + bh) * HEADSZ; const bf16* kb = qb + WHICHSZ; const bf16* vb = qb + 2 * WHICHSZ; (void)dil; (void)kb; (void)vb;
#define ATTN_REQUEST(u_) do { ATTN_DECODE(u_) \
        _Pragma("unroll") for (int i = 0; i < 6; ++i) { const int wv = wave + 8 * i; \
            const int key = 8 * wv + (lane & 7), p = min(max(p0 - 64 + key, 0), L - 1);        \
            kr[i] = *(const v4u*)(kb + (size_t)(r + (p << dsh)) * 64 + (lane >> 3) * 8); \
            const int key2 = 8 * wv + (lane >> 3), p2 = min(max(p0 - 64 + key2, 0), L - 1); \
            vr[i] = *(const v4u*)(vb + (size_t)(r + (p2 << dsh)) * 64 + (lane & 7) * 8); } \
        _Pragma("unroll") for (int i = 0; i < 4; ++i) { const int qq = 8 * (wave + 8 * i) + (lane & 7); \
            qv[i] = *(const v4u*)(qb + (size_t)(r + ((p0 + qq) << dsh)) * 64 + (lane >> 3) * 8); } } while (0)
    const int G8 = (int)gridDim.x, u0 = (G8 % 8 == 0) ? ((int)blockIdx.x % 8) * (G8 / 8) + (int)blockIdx.x / 8 : (int)blockIdx.x;
    if (u0 < 3072) ATTN_REQUEST(u0);
    for (int u = u0; u < 3072; u += gridDim.x) {
        ATTN_DECODE(u)
        const int b = bh >> 3, h = bh & 7;
        __syncthreads();
#pragma unroll
        for (int i = 0; i < 6; ++i) { const int wv = wave + 8 * i; const v4u z4 = (v4u){0u, 0u, 0u, 0u};
            const bool ok = (unsigned)(p0 - 64 + 8 * wv + (lane & 7)) < (unsigned)L, ok2 = (unsigned)(p0 - 64 + 8 * wv + (lane >> 3)) < (unsigned)L;
            *(LAS v4u*)(Kl + (lane >> 3) * 6144 + (8 * wv + (lane & 7)) * 16) = ok ? kr[i] : z4;
            *(LAS v4u*)(Vl + ((lane & 7) >> 2) * 24576 + (8 * wv + (lane >> 3)) * 64 + (lane & 3) * 16) = ok2 ? vr[i] : z4; }
#pragma unroll
        for (int i = 0; i < 4; ++i) *(LAS v4u*)(Ql + (lane >> 3) * 4096 + (8 * (wave + 8 * i) + (lane & 7)) * 16) = qv[i];
        __syncthreads();
        if (u + (int)gridDim.x < 3072) ATTN_REQUEST(u + (int)gridDim.x);
        const int sq = r + ((p0 + 32 * wave + r32) << dsh);
        bf16x8 qr[4];
#pragma unroll
        for (int d0 = 0; d0 < 4; ++d0) qr[d0] = *(const LAS bf16x8*)(Ql + (2 * d0 + hi) * 4096 + (32 * wave + r32) * 16);
        f32x16 sc[5];
#pragma unroll
        for (int k2 = 0; k2 < 5; k2 += 2) {
            const LAS unsigned char* kp = Kl + hi * 6144 + (32 * (wave + k2) + r32) * 16;
            bf16x8 ka[4], kb2[4];
#pragma unroll
            for (int d0 = 0; d0 < 4; ++d0) { ka[d0] = *(const LAS bf16x8*)(kp + d0 * 12288); if (k2 + 1 < 5) kb2[d0] = *(const LAS bf16x8*)(kp + 512 + d0 * 12288); }
#pragma unroll
            for (int d0 = 0; d0 < 4; ++d0) {
                if (d0 == 0) { sc[k2] = __builtin_amdgcn_mfma_f32_32x32x16_bf16(ka[0], qr[0], (f32x16){}, 0, 0, 0); if (k2 + 1 < 5) sc[k2 + 1] = __builtin_amdgcn_mfma_f32_32x32x16_bf16(kb2[0], qr[0], (f32x16){}, 0, 0, 0); }
                else { sc[k2] = __builtin_amdgcn_mfma_f32_32x32x16_bf16(ka[d0], qr[d0], sc[k2], 0, 0, 0); if (k2 + 1 < 5) sc[k2 + 1] = __builtin_amdgcn_mfma_f32_32x32x16_bf16(kb2[d0], qr[d0], sc[k2 + 1], 0, 0, 0); } }
            asm volatile("" ::: "memory"); }
        const float cb = __builtin_ldexpf(1.4426950408889634f, dsh - (h + 1));
        const float t0f = (float)(4 * hi - r32);
        const bool first = (p0 == 0), lastb = (p0 + 256 == L);
        float mx = -INFINITY;
#pragma unroll
        for (int kt = 0; kt < 5; ++kt) {
            float base = t0f; asm volatile("" : "+v"(base));
            const bool dead = (first && wave + kt < 2) || (lastb && wave + kt >= 10);
            if (dead) {
#pragma unroll
                for (int rr = 0; rr < 16; ++rr) sc[kt][rr] = -INFINITY;
            } else {
#pragma unroll
                for (int rr = 0; rr < 16; ++rr) { const float rel = base + (float)(32 * kt - 64 + (rr & 3) + 8 * (rr >> 2));
                    float sv = sc[kt][rr] - cb * __builtin_fabsf(rel);
                    if (kt == 0) sv = rel >= -64.f ? sv : -INFINITY;
                    if (kt == 4) sv = rel <= 64.f ? sv : -INFINITY;
                    sc[kt][rr] = sv; mx = fmaxf(mx, sv); } } }
        { auto rr = __builtin_amdgcn_permlane32_swap(__float_as_uint(mx), __float_as_uint(mx), false, false); mx = fmaxf(__uint_as_float(rr[0]), __uint_as_float(rr[1])); }
        float l = 0.f;
#pragma unroll
        for (int kt = 0; kt < 5; ++kt)
#pragma unroll
            for (int rr = 0; rr < 16; ++rr) { const float p = __builtin_amdgcn_exp2f(sc[kt][rr] - mx); sc[kt][rr] = p; l += p; }
        { auto rr = __builtin_amdgcn_permlane32_swap(__float_as_uint(l), __float_as_uint(l), false, false); l = __uint_as_float(rr[0]) + __uint_as_float(rr[1]); }
        f32x16 o0 = (f32x16){}, o1 = (f32x16){};
        const LAS unsigned char* vp = Vl + ((lane >> 4) & 1) * 32 + (lane & 3) * 8 + (4 * hi + ((lane & 15) >> 2)) * 64;
#pragma unroll
        for (int kt = 0; kt < 5; ++kt)
#pragma unroll
            for (int ks = 0; ks < 2; ++ks) { const LAS unsigned char* ap = vp + (32 * (wave + kt) + 16 * ks) * 64;
                const s16x4 l0 = vtr(ap), h0 = vtr(ap + 512), l1 = vtr(ap + 24576), h1 = vtr(ap + 24576 + 512);
                pg8::u32x4 pw; pw.x = pg8::cvt_pk_bf16(sc[kt][8 * ks + 0], sc[kt][8 * ks + 1]); pw.y = pg8::cvt_pk_bf16(sc[kt][8 * ks + 2], sc[kt][8 * ks + 3]);
                pw.z = pg8::cvt_pk_bf16(sc[kt][8 * ks + 4], sc[kt][8 * ks + 5]); pw.w = pg8::cvt_pk_bf16(sc[kt][8 * ks + 6], sc[kt][8 * ks + 7]);
                const bf16x8 pf = __builtin_bit_cast(bf16x8, pw);
                o0 = __builtin_amdgcn_mfma_f32_32x32x16_bf16((bf16x8){l0[0], l0[1], l0[2], l0[3], h0[0], h0[1], h0[2], h0[3]}, pf, o0, 0, 0, 0);
                o1 = __builtin_amdgcn_mfma_f32_32x32x16_bf16((bf16x8){l1[0], l1[1], l1[2], l1[3], h1[0], h1[1], h1[2], h1[3]}, pf, o1, 0, 0, 0);
                asm volatile("" ::: "memory"); }
        const float inv = 1.0f / l; const size_t row = (size_t)g * T + (size_t)b * 4096 + sq;
        LAS unsigned char* ow = Ql + (32 * wave) * 16;
#pragma unroll
        for (int aa = 0; aa < 4; ++aa) {
            v2u w0; w0.x = pk2(o0[4 * aa] * inv, o0[4 * aa + 1] * inv); w0.y = pk2(o0[4 * aa + 2] * inv, o0[4 * aa + 3] * inv);
            *(LAS v2u*)(ow + aa * 4096 + (r32 ^ aa) * 16 + 8 * hi) = w0;
            v2u w1; w1.x = pk2(o1[4 * aa] * inv, o1[4 * aa + 1] * inv); w1.y = pk2(o1[4 * aa + 2] * inv, o1[4 * aa + 3] * inv);
            *(LAS v2u*)(ow + (4 + aa) * 4096 + (r32 ^ (4 + aa)) * 16 + 8 * hi) = w1; }
        {   const int piece = lane & 7; bf16* ob = OG + ((size_t)g * T + (size_t)b * 4096) * AW + h * 64 + piece * 8;
#pragma unroll
            for (int i = 0; i < 4; ++i) { const int rw = (lane >> 3) + 8 * i;
                const v4u ov = *(const LAS v4u*)(ow + piece * 4096 + (rw ^ piece) * 16);
                *(v4u*)(ob + (size_t)(r + ((p0 + 32 * wave + rw) << dsh)) * AW) = ov; } }
        if (hi == 0) LSE[row * 8 + h] = mx + __builtin_log2f(l);
    }
#undef ATTN_DECODE
#undef ATTN_REQUEST
}
__device__ __forceinline__ void attn_merge_phase(const Args& a) {
    int tid = threadIdx.x; asm volatile("" : "+v"(tid)); const int lane = tid & 63, wave = __builtin_amdgcn_readfirstlane(tid >> 6);
    const bf16* OG = (const bf16*)(a.ws + WS_OG); const float* LSE = (const float*)(a.ws + WS_LSE); bf16* O = (bf16*)(a.ws + WS_O);
    const int gw = blockIdx.x * 8 + wave, NGW = gridDim.x * 8;
    for (int row = gw; row < T; row += NGW) {
        float ls[3]; v4u og[3];
#pragma unroll
        for (int g = 0; g < 3; ++g) { ls[g] = LSE[((size_t)g * T + row) * 8 + (lane >> 3)]; og[g] = *(const v4u*)(OG + ((size_t)g * T + row) * AW + lane * 8); }
        const float M = fmaxf(fmaxf(ls[0], ls[1]), ls[2]);
        float w[3]; float den = 0.f;
#pragma unroll
        for (int g = 0; g < 3; ++g) { w[g] = __builtin_amdgcn_exp2f(ls[g] - M); den += w[g]; }
        const float iden = 1.0f / den;
        float acc[8];
#pragma unroll
        for (int i = 0; i < 8; ++i) acc[i] = 0.f;
#pragma unroll
        for (int g = 0; g < 3; ++g) { const float wg = w[g] * iden; const unsigned ww[4] = {og[g].x, og[g].y, og[g].z, og[g].w};
#pragma unroll
            for (int i = 0; i < 4; ++i) { acc[2 * i] += wg * bf_lo(ww[i]); acc[2 * i + 1] += wg * bf_hi(ww[i]); } }
        v4u o; o.x = pk2(acc[0], acc[1]); o.y = pk2(acc[2], acc[3]); o.z = pk2(acc[4], acc[5]); o.w = pk2(acc[6], acc[7]);
        *(v4u*)(O + (size_t)row * AW + lane * 8) = o;
    }
}

__device__ __forceinline__ void router_phase(const Args& a, int layer, LAS unsigned char* lds) {
    int tid = threadIdx.x; asm volatile("" : "+v"(tid)); const int lane = tid & 63, wave = __builtin_amdgcn_readfirstlane(tid >> 6);
    LAS float* wr = (LAS float*)lds;
    constexpr int WRS = 1028;
    const float* Wr = a.moe_w_router + (size_t)layer * D * NE; const float* br = a.moe_b_router + layer * NE; const float* gain = a.ffn_norm + layer * D;
    __syncthreads();
    {   f32x4 wq[8];
#pragma unroll
        for (int k = 0; k < 8; ++k) wq[k] = *(const f32x4*)(Wr + (size_t)(tid + 512 * k) * 4);
#pragma unroll
        for (int k = 0; k < 8; ++k) { const int i4 = tid + 512 * k, d = i4 >> 2, e0 = 4 * (i4 & 3);
            wr[(e0 + 0) * WRS + d] = wq[k].x; wr[(e0 + 1) * WRS + d] = wq[k].y; wr[(e0 + 2) * WRS + d] = wq[k].z; wr[(e0 + 3) * WRS + d] = wq[k].w; } }
    __syncthreads();
    bf16* H = (bf16*)(a.ws + WS_H); float* AFF = (float*)(a.ws + WS_AFF); const float* XB = (const float*)(a.ws + WS_XB);
    const int gw = blockIdx.x * 8 + wave, NGW = gridDim.x * 8;
    const f32x4* gr = (const f32x4*)gain + lane;
    constexpr int RT = 4;
    f32x4 nx[RT][4];
    if (gw < T / RT) {
#pragma unroll
        for (int t = 0; t < RT; ++t) { const f32x4* xr = (const f32x4*)(XB + (size_t)(RT * gw + t) * D) + lane;
#pragma unroll
            for (int j = 0; j < 4; ++j) nx[t][j] = xr[64 * j]; } }
    for (int rp = gw; rp < T / RT; rp += NGW) {
        const int row = RT * rp;
        f32x4 v[RT][4]; float ss[RT];
#pragma unroll
        for (int t = 0; t < RT; ++t) { ss[t] = 0.f;
#pragma unroll
            for (int j = 0; j < 4; ++j) { v[t][j] = nx[t][j]; ss[t] += (v[t][j].x * v[t][j].x + v[t][j].y * v[t][j].y) + (v[t][j].z * v[t][j].z + v[t][j].w * v[t][j].w); } }
        if (rp + NGW < T / RT) {
#pragma unroll
            for (int t = 0; t < RT; ++t) { const f32x4* xr = (const f32x4*)(XB + (size_t)(RT * (rp + NGW) + t) * D) + lane;
#pragma unroll
                for (int j = 0; j < 4; ++j) nx[t][j] = xr[64 * j]; } }
#pragma unroll
        for (int t = 0; t < RT; ++t) { const float rinv = 1.0f / sqrtf(wave_sum(ss[t]) * (1.f / D) + EPS);
            unsigned long long* o8 = (unsigned long long*)(H + (size_t)(row + t) * D) + lane;
#pragma unroll
            for (int j = 0; j < 4; ++j) { v[t][j] = v[t][j] * rinv * gr[64 * j];
                o8[64 * j] = (unsigned long long)pk2(v[t][j].x, v[t][j].y) | ((unsigned long long)pk2(v[t][j].z, v[t][j].w) << 32); } }
        float mine[RT];
#pragma unroll
        for (int t = 0; t < RT; ++t) mine[t] = 0.f;
#pragma unroll 2
        for (int e = 0; e < 16; ++e) { float ac[RT];
#pragma unroll
            for (int t = 0; t < RT; ++t) ac[t] = 0.f;
#pragma unroll
            for (int j = 0; j < 4; ++j) { const f32x4 w = *(const LAS f32x4*)(wr + e * WRS + 256 * j + 4 * lane);
#pragma unroll
                for (int t = 0; t < RT; ++t) ac[t] += (v[t][j].x * w.x + v[t][j].y * w.y) + (v[t][j].z * w.z + v[t][j].w * w.w); }
            const float be = br[e];
#pragma unroll
            for (int t = 0; t < RT; ++t) { const float lg = wave_sum(ac[t]) + be; mine[t] = (lane == e) ? lg : mine[t]; } }
        float pr[RT];
#pragma unroll
        for (int t = 0; t < RT; ++t) { const float m = row_max(mine[t]); const float ex = __expf(mine[t] - m); pr[t] = ex / row_sum(ex); }
        if (lane < 16) { float* ap = AFF + ((size_t)(row >> 12) * 16 + lane) * 4096 + (row & 4095); *(f32x4*)ap = (f32x4){pr[0], pr[1], pr[2], pr[3]}; }
    }
}

__device__ __forceinline__ void topk_phase(const Args& a, LAS unsigned char* lds) {
    int tid = threadIdx.x; asm volatile("" : "+v"(tid)); const int lane = tid & 63, wave = __builtin_amdgcn_readfirstlane(tid >> 6); (void)lane; (void)wave;
    LAS unsigned* hist = (LAS unsigned*)lds;
    LAS unsigned* sh = hist + 256;
    LAS unsigned* wtot = hist + 272;
    const float* AFF = (const float*)(a.ws + WS_AFF); int* SMAP = (int*)(a.ws + WS_SMAP); int* TOK = (int*)(a.ws + WS_TOK); float* GATE = (float*)(a.ws + WS_GATE);
    for (int prob = blockIdx.x; prob < NB * NE; prob += gridDim.x) {
        const int b = prob >> 4, e = prob & 15;
        const v4u* src = (const v4u*)(AFF + (size_t)prob * 4096) + 2 * tid;
        const v4u k0 = src[0], k1 = src[1];
        unsigned key[8] = {k0.x, k0.y, k0.z, k0.w, k1.x, k1.y, k1.z, k1.w};
        unsigned prefix = 0u, kk = CAP;
#pragma unroll
        for (int pass = 0; pass < 4; ++pass) {
            const int shift = 24 - 8 * pass; const unsigned mhi = pass == 0 ? 0u : (0xFFFFFFFFu << (shift + 8));
            __syncthreads();
            if (tid < 256) hist[tid] = 0u;
            __syncthreads();
#pragma unroll
            for (int i = 0; i < 8; ++i) if ((key[i] & mhi) == prefix) __hip_atomic_fetch_add(&hist[(key[i] >> shift) & 255u], 1u, __ATOMIC_RELAXED, __HIP_MEMORY_SCOPE_WORKGROUP);
            __syncthreads();
            if (wave == 0) {
                const unsigned c0 = hist[4 * lane], c1 = hist[4 * lane + 1], c2 = hist[4 * lane + 2], c3 = hist[4 * lane + 3];
                const unsigned tot = c0 + c1 + c2 + c3;
                unsigned suf = tot;
#pragma unroll
                for (int o = 1; o < 64; o <<= 1) { const unsigned t = __shfl_down(suf, o); if (lane + o < 64) suf += t; }
                unsigned gt = suf - tot;
                if (gt < kk && kk <= gt + c3) { sh[0] = 4 * lane + 3; sh[1] = kk - gt; } gt += c3;
                if (gt < kk && kk <= gt + c2) { sh[0] = 4 * lane + 2; sh[1] = kk - gt; } gt += c2;
                if (gt < kk && kk <= gt + c1) { sh[0] = 4 * lane + 1; sh[1] = kk - gt; } gt += c1;
                if (gt < kk && kk <= gt + c0) { sh[0] = 4 * lane + 0; sh[1] = kk - gt; }
            }
            __syncthreads();
            prefix |= sh[0] << shift; kk = sh[1];
        }
        unsigned cg = 0u, ce = 0u;
#pragma unroll
        for (int i = 0; i < 8; ++i) { cg += key[i] > prefix ? 1u : 0u; ce += key[i] == prefix ? 1u : 0u; }
        const unsigned mine = cg | (ce << 16);
        unsigned inc = mine;
#pragma unroll
        for (int o = 1; o < 64; o <<= 1) { const unsigned t = __shfl_up(inc, o); if (lane >= o) inc += t; }
        __syncthreads();
        if (lane == 63) wtot[wave] = inc;
        __syncthreads();
        unsigned base = 0u;
#pragma unroll
        for (int w = 0; w < 8; ++w) base += (w < wave) ? wtot[w] : 0u;
        const unsigned exc = base + inc - mine;
        unsigned gb = exc & 0xffffu, eb = exc >> 16;
        const int srow0 = (e * 8 + b) * CAP;
#pragma unroll
        for (int i = 0; i < 8; ++i) { const int s = 8 * tid + i; int slot = -1;
            if (key[i] > prefix) { slot = (int)(gb + (eb < kk ? eb : kk)); gb++; }
            else if (key[i] == prefix) { if (eb < kk) slot = (int)(gb + eb); eb++; }
            int sr = -1;
            if (slot >= 0) { sr = srow0 + slot; TOK[sr] = b * 4096 + s; GATE[sr] = __builtin_bit_cast(float, key[i]); }
            SMAP[(size_t)prob * 4096 + s] = sr; }
    }
}

__device__ __forceinline__ void gather_phase(const Args& a) {
    int tid = threadIdx.x; asm volatile("" : "+v"(tid)); const int lane = tid & 63, wave = __builtin_amdgcn_readfirstlane(tid >> 6);
    const bf16* H = (const bf16*)(a.ws + WS_H); bf16* XIN = (bf16*)(a.ws + WS_XIN); const int* TOK = (const int*)(a.ws + WS_TOK);
    const int gw = blockIdx.x * 8 + wave, NGW = gridDim.x * 8;
    for (int blk = gw; blk < NSLOT / 64; blk += NGW) {
        const int r0 = blk * 64; const int tokv = TOK[r0 + lane];
#pragma unroll 1
        for (int i0 = 0; i0 < 64; i0 += 8) {
            v4u x[8][2];
#pragma unroll
            for (int i = 0; i < 8; ++i) { const int tok = __builtin_amdgcn_readlane(tokv, i0 + i); const v4u* sp = (const v4u*)(H + (size_t)tok * D) + lane; x[i][0] = sp[0]; x[i][1] = sp[64]; }
#pragma unroll
            for (int i = 0; i < 8; ++i) { v4u* dp = (v4u*)(XIN + (size_t)(r0 + i0 + i) * D) + lane; dp[0] = x[i][0]; dp[64] = x[i][1]; }
        }
    }
}

__device__ __forceinline__ void combine_phase(const Args& a, int layer) {
    int tid = threadIdx.x; asm volatile("" : "+v"(tid)); const int lane = tid & 63, wave = __builtin_amdgcn_readfirstlane(tid >> 6);
    const bf16* Y = (const bf16*)(a.ws + WS_Y); const int* SMAP = (const int*)(a.ws + WS_SMAP); bf16* H = (bf16*)(a.ws + WS_H);
    const int gw = blockIdx.x * 8 + wave, NGW = gridDim.x * 8;
    for (int row = gw; row < T; row += NGW) {
        const int b = row >> 12, s = row & 4095;
        const int srv = SMAP[((size_t)b * 16 + (lane & 15)) * 4096 + s];
        const f32x4* xi = (const f32x4*)((const float*)(a.ws + WS_XB) + (size_t)row * D) + lane; f32x4* xr = (f32x4*)(a.out + (size_t)row * D) + lane;
        f32x4 v[4];
#pragma unroll
        for (int j = 0; j < 4; ++j) v[j] = xi[64 * j];
        unsigned mask = (unsigned)(__builtin_amdgcn_ballot_w64(srv >= 0) & 0xffffull);
        while (mask) {
            int sr[4]; bool on[4];
#pragma unroll
            for (int k = 0; k < 4; ++k) { on[k] = mask != 0u; const int e = on[k] ? __builtin_ctz(mask) : 0; sr[k] = __builtin_amdgcn_readlane(srv, e); if (on[k]) mask &= mask - 1u; }
            v2u y[4][4];
#pragma unroll
            for (int k = 0; k < 4; ++k) { if (on[k]) { const v2u* yr = (const v2u*)(Y + (size_t)sr[k] * D) + lane;
#pragma unroll
                for (int j = 0; j < 4; ++j) y[k][j] = yr[64 * j]; } else {
#pragma unroll
                for (int j = 0; j < 4; ++j) y[k][j] = (v2u){0u, 0u}; } }
#pragma unroll
            for (int k = 0; k < 4; ++k)
#pragma unroll
                for (int j = 0; j < 4; ++j) { v[j].x += bf_lo(y[k][j].x); v[j].y += bf_hi(y[k][j].x); v[j].z += bf_lo(y[k][j].y); v[j].w += bf_hi(y[k][j].y); }
        }
#pragma unroll
        for (int j = 0; j < 4; ++j) xr[64 * j] = v[j];
        if (layer < 3) {
            const f32x4* gr = (const f32x4*)(a.mix_norm + (layer + 1) * D) + lane; float ss = 0.f;
#pragma unroll
            for (int j = 0; j < 4; ++j) ss += (v[j].x * v[j].x + v[j].y * v[j].y) + (v[j].z * v[j].z + v[j].w * v[j].w);
            const float rinv = 1.0f / sqrtf(wave_sum(ss) * (1.f / D) + EPS);
            unsigned long long* o8 = (unsigned long long*)(H + (size_t)row * D) + lane;
#pragma unroll
            for (int j = 0; j < 4; ++j) { const f32x4 y = v[j] * rinv * gr[64 * j]; o8[64 * j] = (unsigned long long)pk2(y.x, y.y) | ((unsigned long long)pk2(y.z, y.w) << 32); }
        }
    }
}

constexpr int N_PHASES = 1 + 4 * 9;
__global__ void __launch_bounds__(512, 2) mega_fwd(Args a) {
    extern __shared__ __attribute__((aligned(16))) unsigned char lds_raw[];
    LAS unsigned char* lds = (LAS unsigned char*)lds_raw;
    const int tid = threadIdx.x, lane = tid & 63, wave = __builtin_amdgcn_readfirstlane(tid >> 6);
    const int G = gridDim.x, bid = blockIdx.x;
    unsigned char* ws = a.ws;
    volatile LAS unsigned* MISC = (volatile LAS unsigned*)(lds + LDSCTL_OFF);
    if (tid < 64) MISC[tid] = 0u;
    __syncthreads();
#if !MK_MULTI
    XcdBarrier bar = xcd_barrier_post((unsigned*)(ws + WS_CTL) + CW_BAR, MISC + 8);
#define GRID_BAR() xcd_barrier(bar)
#else
#define GRID_BAR() do {} while (0)
#endif
    const int lo = a.ph_lo, hi = a.ph_hi;
#ifndef PH_EN
#define PH_EN 0x1fff
#endif
#define EN(b) ((PH_EN >> (b)) & 1)
#ifndef PH_REP
#define PH_REP 0
#endif
#define NREP(b) (1 + ((PH_REP >> (b)) & 1))
#define IN(k) (lo <= (k) && (k) < hi)
#define SEAM(k) do { if (IN((k) + 1)) GRID_BAR(); } while (0)
    bf16* H = (bf16*)(ws + WS_H);

#define PHASE(bit, k, seam, ...) do { if (EN(bit) && IN(k)) { for (int rep_ = 0; rep_ < NREP(bit); ++rep_) { if (rep_) GRID_BAR(); __VA_ARGS__ } if (seam) SEAM(k); } } while (0)
    constexpr int NG = 228;
    const bool split = (G == 256);
    PHASE(12, 0, true, prologue_phase(a, lds, split ? 1 : 4););

    for (int layer = 0; layer < 4; ++layer) {
        const int pb = 1 + 9 * layer, j = layer >> 1;
        const float* xbase = layer == 0 ? a.x : a.out;
        if ((layer & 1) == 0) {
            PHASE(0, pb + 0, true,
                { pg8::Gemm g{H, (const bf16*)(ws + WS_WIN) + (size_t)j * 6144 * 1024, T, GW, D}; pg8::StaticOrder S; S.init(T, GW, G, bid);
                  pg8::EpiGeluBf16 E{(bf16*)(ws + WS_U), GW, a.gm_b_in + j * 6144};
                  pg8::gemm_phase<pg8::EpiGeluBf16, pg8::StaticOrder, true, true>(lds, g, S, E); }
                { pg8::Gemm g{(const bf16*)(ws + WS_WIN) + (size_t)j * 6144 * 1024 + (size_t)GW * 1024, H, GW, T, D}; pg8::StaticOrder S; S.init(GW, T, G, bid);
                  pg8::EpiVT E{(bf16*)(ws + WS_VT), T, a.gm_b_in + j * 6144 + GW, (float*)(ws + WS_SSQ)};
                  pg8::gemm_phase<pg8::EpiVT, pg8::StaticOrder, true, true>(lds, g, S, E); });
            PHASE(1, pb + 1, true, gating_phase(a, j, lds););
            PHASE(2, pb + 2, true,
                pg8::Gemm g{(const bf16*)(ws + WS_UV), (const bf16*)(ws + WS_WOUT) + (size_t)j * 1024 * 3072, T, D, GW}; pg8::StaticOrder S; S.init(T, D, G, bid);
                pg8::EpiResid E{xbase, (float*)(ws + WS_XB), D, a.gm_b_out + j * D};
                pg8::gemm_phase<pg8::EpiResid, pg8::StaticOrder, true, true>(lds, g, S, E););
        } else {
            PHASE(3, pb + 0, true,
                pg8::Gemm g{H, (const bf16*)(ws + WS_WQKV) + (size_t)j * QKVW * 1024, T, QKVW, D}; pg8::StaticOrder S; S.init(T, QKVW, G, bid);
                pg8::EpiQKV E{(bf16*)(ws + WS_QKV), a.at_q_norm + j * 192, a.at_k_norm + j * 192};
                pg8::gemm_phase<pg8::EpiQKV, pg8::StaticOrder, true, true>(lds, g, S, E););
            PHASE(4, pb + 1, true, for (int q_ = 0; q_ < NREP(13); ++q_) { if (q_) GRID_BAR(); attn_phase(a, lds); } GRID_BAR(); for (int q_ = 0; q_ < NREP(14); ++q_) { if (q_) GRID_BAR(); attn_merge_phase(a); });
            PHASE(5, pb + 2, true,
                pg8::Gemm g{(const bf16*)(ws + WS_O), (const bf16*)(ws + WS_WO) + (size_t)j * 1024 * 512, T, D, AW}; pg8::StaticOrder S; S.init(T, D, G, bid);
                pg8::EpiResid E{xbase, (float*)(ws + WS_XB), D, nullptr};
                pg8::gemm_phase<pg8::EpiResid, pg8::StaticOrder, true, true>(lds, g, S, E););
        }
        PHASE(6, pb + 3, true, router_phase(a, layer, lds););
        PHASE(7, pb + 4, true, topk_phase(a, lds););
        PHASE(9, pb + 6, true,
            const bool hetero = split && layer < 3;
            if (hetero && bid >= NG) { moe_convert_layer(a, layer + 1, lds, (bid - NG) * 8 + wave, (G - NG) * 8); }
            else {
            pg8::Gemm g{H, (const bf16*)(ws + WS_W13) + (size_t)layer * 16 * 4096 * 1024, NSLOT, 16 * 4096, D}; pg8::MoeOrder1 S{hetero ? NG : G, bid};
            pg8::EpiSwiGLU E{(bf16*)(ws + WS_HID)};
            pg8::gemm_phase_gather<pg8::EpiSwiGLU, pg8::MoeOrder1>(lds, g, (const int*)(ws + WS_TOK), S, E); });
        PHASE(10, pb + 7, true,
            pg8::Gemm g{(const bf16*)(ws + WS_HID), (const bf16*)(ws + WS_W2) + (size_t)layer * 16 * 1024 * 2048, NSLOT, 16 * 1024, DE}; pg8::MoeOrder2 S{G, bid};
            pg8::EpiGate E{(bf16*)(ws + WS_Y), (const float*)(ws + WS_GATE)};
            pg8::gemm_phase<pg8::EpiGate, pg8::MoeOrder2, true, true>(lds, g, S, E););
        PHASE(11, pb + 8, layer < 3, combine_phase(a, layer););
    }
#undef PHASE
#undef IN
#undef SEAM
}

extern "C" void kernel_launch(void* const* d_in, const int* in_sizes, int n_in, void* d_out, int out_size, void* d_ws, size_t ws_size, hipStream_t stream) {
    static int grid = 0;
    if (grid == 0) {
        if (n_in != 19 || out_size != T * D || ws_size < WS_END) { fprintf(stderr, "kernel_launch: unexpected shapes (n_in %d, out %d, ws %zu < %zu)\n", n_in, out_size, ws_size, (size_t)WS_END); grid = -1; return; }
        int dev = 0, cus = 0, per_cu = 0;
        if (hipGetDevice(&dev) != hipSuccess || hipDeviceGetAttribute(&cus, hipDeviceAttributeMultiprocessorCount, dev) != hipSuccess) { grid = -1; return; }
        if (hipFuncSetAttribute((const void*)mega_fwd, hipFuncAttributeMaxDynamicSharedMemorySize, LDS_BYTES) != hipSuccess) { fprintf(stderr, "kernel_launch: hipFuncSetAttribute failed\n"); grid = -1; return; }
        if (hipOccupancyMaxActiveBlocksPerMultiprocessor(&per_cu, (const void*)mega_fwd, 512, LDS_BYTES) != hipSuccess || per_cu < 1) { fprintf(stderr, "kernel_launch: occupancy query says %d\n", per_cu); }
        (void)hipGetLastError();
        grid = cus;
    }
    if (grid < 0) return;
    (void)hipMemsetAsync((char*)d_ws + WS_CTL, 0, CTL_ZERO_BYTES, stream);
    Args a{};
    const float** ap = (const float**)&a;
    for (int i = 0; i < 19; ++i) ap[i] = (const float*)d_in[i];
    a.out = (float*)d_out; a.ws = (unsigned char*)d_ws;
#if MK_MULTI
    for (int p = 0; p < N_PHASES; ++p) { a.ph_lo = p; a.ph_hi = p + 1; hipLaunchKernelGGL(mega_fwd, dim3(grid), dim3(512), LDS_BYTES, stream, a); }
#else
    a.ph_lo = 0; a.ph_hi = N_PHASES;
    hipLaunchKernelGGL(mega_fwd, dim3(grid), dim3(512), LDS_BYTES, stream, a);
#endif
}
```

```cpp
#include <hip/hip_runtime.h>
#include <cstdio>
#include <cstdint>

#ifndef MK_MULTI
#define MK_MULTI 0
#endif

namespace pg8 {
#define PG8_LAS __attribute__((address_space(3)))
typedef unsigned short bf16_t;
typedef short bf16x8 __attribute__((ext_vector_type(8)));
typedef short bf16x16 __attribute__((ext_vector_type(16)));
typedef int i32x8 __attribute__((ext_vector_type(8)));
__device__ __forceinline__ i32x8 cat16(bf16x8 x, bf16x8 y) { return __builtin_bit_cast(i32x8, __builtin_shufflevector(x, y, 0, 1, 2, 3, 4, 5, 6, 7, 8, 9, 10, 11, 12, 13, 14, 15)); }
typedef float f32x4 __attribute__((ext_vector_type(4)));
typedef float f32x2 __attribute__((ext_vector_type(2)));
typedef unsigned u32x4 __attribute__((ext_vector_type(4)));
typedef unsigned u32x2 __attribute__((ext_vector_type(2)));
constexpr int BM = 256, BK = 64, HALF = 128, HTB = HALF * BK * 2, STAGE_BYTES = 8 * HTB, NXCD = 8, WGM = 8;

__host__ __device__ __forceinline__ int lds_byte(int r, int c) { const int st = (r >> 4) * 2 + (c >> 5), rr = r & 15, cc = c & 31, ob = rr * 64 + cc * 2; return st * 1024 + (ob ^ (((ob >> 9) & 1) << 5)); }
__host__ __device__ __forceinline__ void stage_rc(int b_, int& R, int& C) { const unsigned b = (unsigned)b_, st = b >> 10, sb = b & 1023u, swz = sb ^ (((sb >> 9) & 1u) << 5); R = (int)((st >> 1) * 16u + (swz >> 6)); C = (int)((st & 1u) * 32u + ((swz & 63u) >> 1)); }
__host__ __device__ __forceinline__ int perm32(int rho) { const int n = rho >> 4, i = rho & 15; return 8 * (i >> 2) + 4 * n + (i & 3); }

struct Unit { int pm, pn; };
struct Gemm { const bf16_t* A; const bf16_t* Bt; int M, N, K; };

struct StaticOrder {
    int nM, nN, nwg, G, c;
    __host__ __device__ void init(int M, int N, int G_, int c_) { nM = M / BM; nN = N / BM; nwg = nM * nN; G = G_; c = c_; }
    __host__ __device__ bool next(int i, Unit& u) const {
        const long L = (long)i * G + c; if (L >= nwg) return false;
        int wgid = (int)L; { const int q = nwg / NXCD, r = nwg % NXCD, xcd = wgid % NXCD, off = wgid / NXCD; wgid = (xcd < r ? xcd * (q + 1) : r * (q + 1) + (xcd - r) * q) + off; }
        const int nig = WGM * nN, gid = wgid / nig, fm = gid * WGM, gsz = (nM - fm) < WGM ? (nM - fm) : WGM;
        u.pm = fm + ((wgid % nig) % gsz); u.pn = (wgid % nig) / gsz; return true;
    }
    __device__ __forceinline__ void a_ready(const Unit&) const {}
    __device__ __forceinline__ void done(const Unit&) const {}
};
struct MoeOrder1 {
    int G, c;
    __device__ bool next(int i, Unit& u) const {
        const int L = i * G + c; if (L >= 4096) return false;
        const int e = L >> 8, w = L & 255, x = w & 7, off = w >> 3;
        u.pm = e * 16 + 4 * (x >> 1) + (off & 3); u.pn = e * 16 + 8 * (x & 1) + (off >> 2); return true;
    }
    __device__ __forceinline__ void a_ready(const Unit&) const {}
    __device__ __forceinline__ void done(const Unit&) const {}
};
struct MoeOrder2 {
    int G, c;
    __device__ bool next(int i, Unit& u) const {
        const int L = i * G + c; if (L >= 1024) return false;
        const int r = L >> 8, w0 = L & 255, wg = (w0 & 7) * 32 + (w0 >> 3), e = r * 4 + (wg >> 6), w = wg & 63;
        u.pm = e * 16 + (w >> 2); u.pn = e * 4 + (w & 3); return true;
    }
    __device__ __forceinline__ void a_ready(const Unit&) const {}
    __device__ __forceinline__ void done(const Unit&) const {}
};

typedef __bf16 bf16x2_v __attribute__((ext_vector_type(2)));
__device__ __forceinline__ unsigned cvt_pk_fp8x4(float a, float b, float c, float d) {
    a = __builtin_copysignf(fminf(__builtin_fabsf(a), 448.f), a); b = __builtin_copysignf(fminf(__builtin_fabsf(b), 448.f), b); c = __builtin_copysignf(fminf(__builtin_fabsf(c), 448.f), c); d = __builtin_copysignf(fminf(__builtin_fabsf(d), 448.f), d);
    int r = __builtin_amdgcn_cvt_pk_fp8_f32(a, b, 0, false); r = __builtin_amdgcn_cvt_pk_fp8_f32(c, d, r, true); return (unsigned)r; }
__device__ __forceinline__ unsigned cvt_pk_bf16(float lo, float hi) { const f32x2 v = {lo, hi}; return __builtin_bit_cast(unsigned, __builtin_convertvector(v, bf16x2_v)); }
__device__ __forceinline__ float gelu_tanh(float x) {
    const float t = x * (1.0f + 0.044715f * x * x);
    const float e = __builtin_amdgcn_exp2f(t * (-2.0f * 0.7978845608f * 1.4426950409f));
    return x * __builtin_amdgcn_rcpf(1.0f + e);
}
__device__ __forceinline__ float silu_f(float a) { return a * __builtin_amdgcn_rcpf(1.0f + __builtin_amdgcn_exp2f(a * -1.4426950409f)); }

template <int CTRL> __device__ __forceinline__ float dpp_f(float v) { return __builtin_bit_cast(float, __builtin_amdgcn_update_dpp(0, __builtin_bit_cast(int, v), CTRL, 0xF, 0xF, true)); }
__device__ __forceinline__ float row16_sum(float v) { v += dpp_f<0xB1>(v); v += dpp_f<0x4E>(v); v += dpp_f<0x141>(v); v += dpp_f<0x140>(v); return v; }
__device__ __forceinline__ float xrow_sum(float v) {
    { auto rr = __builtin_amdgcn_permlane16_swap(__float_as_uint(v), __float_as_uint(v), false, false); v = __uint_as_float(rr[0]) + __uint_as_float(rr[1]); }
    { auto rr = __builtin_amdgcn_permlane32_swap(__float_as_uint(v), __float_as_uint(v), false, false); v = __uint_as_float(rr[0]) + __uint_as_float(rr[1]); }
    return v; }
template <class V4> __device__ __forceinline__ void xchg_rows(const V4& p0, const V4& p1, V4& s1, V4& s2) {
    const u32x4 a = __builtin_bit_cast(u32x4, p0), b = __builtin_bit_cast(u32x4, p1); u32x4 x, y;
#pragma unroll
    for (int k = 0; k < 4; ++k) { x[k] = (unsigned)__builtin_amdgcn_update_dpp((int)a[k], (int)b[k], 0x128, 0xF, 0xC, false);
                                  y[k] = (unsigned)__builtin_amdgcn_update_dpp((int)b[k], (int)a[k], 0x128, 0xF, 0x3, false); }
    s1 = __builtin_bit_cast(V4, x); s2 = __builtin_bit_cast(V4, y);
}
__device__ __forceinline__ void xchg_rows2(const u32x2& a, const u32x2& b, u32x2& s1, u32x2& s2) {
#pragma unroll
    for (int k = 0; k < 2; ++k) { s1[k] = (unsigned)__builtin_amdgcn_update_dpp((int)a[k], (int)b[k], 0x128, 0xF, 0xC, false);
                                  s2[k] = (unsigned)__builtin_amdgcn_update_dpp((int)b[k], (int)a[k], 0x128, 0xF, 0x3, false); }
}
struct EpiGeluBf16 {
    static constexpr bool PERM = true, AFTER_DRAIN = false;
    bf16_t* O; int ldc; const float* bias;
    __device__ __forceinline__ void operator()(const f32x4 (&acc)[2][2][4][2], const Unit& u, int wr, int wc, int fr, int fq) const {
        const int rowb = u.pm * BM + wr * 64, colw = u.pn * BM + wc * 64;
        f32x4 bv[2][2];
#pragma unroll
        for (int bj = 0; bj < 2; ++bj)
#pragma unroll
            for (int n = 0; n < 2; ++n) bv[bj][n] = *(const f32x4*)(bias + colw + 32 * bj + 8 * fq + 4 * n);
        bf16_t* ob = O + (size_t)(rowb + (fr & 7)) * ldc + colw + (fr >> 3) * 32 + 8 * fq;
#pragma unroll
        for (int ai = 0; ai < 2; ++ai)
#pragma unroll
            for (int m = 0; m < 4; ++m) { u32x4 w[2];
#pragma unroll
                for (int bj = 0; bj < 2; ++bj) { const f32x4 v0 = acc[ai][bj][m][0] + bv[bj][0], v1 = acc[ai][bj][m][1] + bv[bj][1];
                    w[bj].x = cvt_pk_bf16(gelu_tanh(v0[0]), gelu_tanh(v0[1])); w[bj].y = cvt_pk_bf16(gelu_tanh(v0[2]), gelu_tanh(v0[3]));
                    w[bj].z = cvt_pk_bf16(gelu_tanh(v1[0]), gelu_tanh(v1[1])); w[bj].w = cvt_pk_bf16(gelu_tanh(v1[2]), gelu_tanh(v1[3])); }
                u32x4 s1, s2; xchg_rows(w[0], w[1], s1, s2);
                bf16_t* rp = ob + (size_t)(ai * HALF + m * 16) * ldc;
                *(u32x4*)rp = s1; *(u32x4*)(rp + (size_t)8 * ldc) = s2; }
    }
};
struct EpiVT {
    static constexpr bool PERM = true, AFTER_DRAIN = false;
    bf16_t* VT; int ldc; const float* bias; float* ssq;
    __device__ __forceinline__ void operator()(const f32x4 (&acc)[2][2][4][2], const Unit& u, int wr, int wc, int fr, int fq) const {
        const int rowb = u.pm * BM + wr * 64, colw = u.pn * BM + wc * 64;
        f32x4 cs[2][2];
#pragma unroll
        for (int bj = 0; bj < 2; ++bj)
#pragma unroll
            for (int n = 0; n < 2; ++n) cs[bj][n] = (f32x4){0.f, 0.f, 0.f, 0.f};
        bf16_t* ob = VT + ((size_t)(2 * u.pn + (wc >> 1)) * 3072 + rowb + (fr & 7)) * 128 + (wc & 1) * 64 + (fr >> 3) * 32 + 8 * fq;
#pragma unroll
        for (int ai = 0; ai < 2; ++ai)
#pragma unroll
            for (int m = 0; m < 4; ++m) { const int e = rowb + fr + ai * HALF + m * 16; const float b = bias[e]; u32x4 w[2];
#pragma unroll
                for (int bj = 0; bj < 2; ++bj) { f32x4 v0 = acc[ai][bj][m][0] + b, v1 = acc[ai][bj][m][1] + b;
#pragma unroll
                    for (int j = 0; j < 4; ++j) { v0[j] = gelu_tanh(v0[j]); v1[j] = gelu_tanh(v1[j]); }
                    cs[bj][0] += v0 * v0; cs[bj][1] += v1 * v1;
                    w[bj].x = cvt_pk_bf16(v0[0], v0[1]); w[bj].y = cvt_pk_bf16(v0[2], v0[3]); w[bj].z = cvt_pk_bf16(v1[0], v1[1]); w[bj].w = cvt_pk_bf16(v1[2], v1[3]); }
                u32x4 s1, s2; xchg_rows(w[0], w[1], s1, s2);
                bf16_t* rp = ob + (size_t)(ai * HALF + m * 16) * 128;
                *(u32x4*)rp = s1; *(u32x4*)(rp + 8 * 128) = s2; }
#pragma unroll
        for (int bj = 0; bj < 2; ++bj)
#pragma unroll
            for (int n = 0; n < 2; ++n)
#pragma unroll
                for (int j = 0; j < 4; ++j) cs[bj][n][j] = row16_sum(cs[bj][n][j]);
        if (fr == 0) {
            float* sp = ssq + (size_t)(2 * u.pm + wr) * ldc + colw + 8 * fq;
#pragma unroll
            for (int bj = 0; bj < 2; ++bj)
#pragma unroll
                for (int n = 0; n < 2; ++n) *(f32x4*)(sp + 32 * bj + 4 * n) = cs[bj][n];
        }
    }
};
struct EpiResid {
    static constexpr bool PERM = false, AFTER_DRAIN = false;
    const void* base; bool base_f32; bf16_t* out; int ldc; const float* bias;
    __device__ __forceinline__ void operator()(const f32x4 (&acc)[2][2][4][2], const Unit& u, int wr, int wc, int fr, int fq) const {
        const int rowb = u.pm * BM + wr * 64, colw = u.pn * BM + wc * 64;
        const int cS = colw + (fr >> 3) * 16 + 4 * fq;
        f32x4 bv[2];
#pragma unroll
        for (int bj = 0; bj < 2; ++bj) bv[bj] = bias ? *(const f32x4*)(bias + cS + 32 * bj) : (f32x4){0.f, 0.f, 0.f, 0.f};
#pragma unroll
        for (int ai = 0; ai < 2; ++ai)
#pragma unroll
            for (int m = 0; m < 4; ++m) { const size_t off = (size_t)(rowb + ai * HALF + m * 16 + (fr & 7)) * ldc + cS;
#pragma unroll
                for (int bj = 0; bj < 2; ++bj) { f32x4 s1, s2; xchg_rows(acc[ai][bj][m][0], acc[ai][bj][m][1], s1, s2);
                    f32x4 b1, b2;
                    if (base_f32) { b1 = __builtin_nontemporal_load((const f32x4*)((const float*)base + off + 32 * bj)); b2 = __builtin_nontemporal_load((const f32x4*)((const float*)base + off + (size_t)8 * ldc + 32 * bj)); }
                    else { const u32x2 p1 = __builtin_nontemporal_load((const u32x2*)((const bf16_t*)base + off + 32 * bj)), p2 = __builtin_nontemporal_load((const u32x2*)((const bf16_t*)base + off + (size_t)8 * ldc + 32 * bj));
                        b1 = (f32x4){__builtin_bit_cast(float, p1.x << 16), __builtin_bit_cast(float, p1.x & 0xffff0000u), __builtin_bit_cast(float, p1.y << 16), __builtin_bit_cast(float, p1.y & 0xffff0000u)};
                        b2 = (f32x4){__builtin_bit_cast(float, p2.x << 16), __builtin_bit_cast(float, p2.x & 0xffff0000u), __builtin_bit_cast(float, p2.y << 16), __builtin_bit_cast(float, p2.y & 0xffff0000u)}; }
                    const f32x4 r1 = b1 + s1 + bv[bj], r2 = b2 + s2 + bv[bj];
                    u32x2 o1, o2; o1.x = cvt_pk_bf16(r1[0], r1[1]); o1.y = cvt_pk_bf16(r1[2], r1[3]); o2.x = cvt_pk_bf16(r2[0], r2[1]); o2.y = cvt_pk_bf16(r2[2], r2[3]);
                    *(u32x2*)(out + off + 32 * bj) = o1; *(u32x2*)(out + off + (size_t)8 * ldc + 32 * bj) = o2; }
                asm volatile("" ::: "memory"); }
    }
};
struct EpiQKV {
    static constexpr bool PERM = true, AFTER_DRAIN = false;
    bf16_t* QKV; const float* qg; const float* kg;
    static constexpr float sc = 1.0f / 256.0f;
    __device__ __forceinline__ void operator()(const f32x4 (&acc)[2][2][4][2], const Unit& u, int wr, int wc, int fr, int fq) const {
        const int hd = u.pn * 4 + wc, which = hd / 24, g = (hd % 24) >> 3, h = hd & 7;
        const float* gp = which == 0 ? qg + g * 64 : kg + g * 64; const float gs = which == 0 ? 0.125f * 1.4426950408889634f : 1.0f;
        unsigned char* hb = (unsigned char*)QKV + (size_t)(which * 3 + g) * (8 * 8 * 4096 * 64) + (size_t)h * (4096 * 64) + (fr >> 3) * 32 + 8 * fq;
        const float osc = which == 0 ? 64.0f : 16.0f;
#pragma unroll
        for (int ai = 0; ai < 2; ++ai)
#pragma unroll
            for (int m = 0; m < 4; ++m) {
                float ss = 0.f;
#pragma unroll
                for (int bj = 0; bj < 2; ++bj)
#pragma unroll
                    for (int n = 0; n < 2; ++n) { const f32x4 x = acc[ai][bj][m][n]; ss += (x[0] * x[0] + x[1] * x[1]) + (x[2] * x[2] + x[3] * x[3]); }
                ss = xrow_sum(ss) * (sc * sc);
                const float rinv = (which < 2 ? __builtin_amdgcn_rsqf((ss + 64e-6f) * (1.0f / 64.0f)) : 1.0f) * (sc * osc);
                u32x2 w[2];
#pragma unroll
                for (int bj = 0; bj < 2; ++bj) { f32x4 g0 = {1.f, 1.f, 1.f, 1.f}, g1 = g0;
                    if (which < 2) { g0 = *(const f32x4*)(gp + 32 * bj + 8 * fq) * gs; g1 = *(const f32x4*)(gp + 32 * bj + 8 * fq + 4) * gs; }
                    const f32x4 v0 = acc[ai][bj][m][0] * rinv * g0, v1 = acc[ai][bj][m][1] * rinv * g1;
                    w[bj].x = cvt_pk_fp8x4(v0[0], v0[1], v0[2], v0[3]); w[bj].y = cvt_pk_fp8x4(v1[0], v1[1], v1[2], v1[3]); }
                u32x2 s1, s2; xchg_rows2(w[0], w[1], s1, s2);
                const int row = u.pm * BM + ai * HALF + wr * 64 + m * 16 + (fr & 7), b = row >> 12, sq = row & 4095;
                unsigned char* dst = hb + (size_t)b * (8 * 4096 * 64) + (size_t)sq * 64;
                *(u32x2*)dst = s1; *(u32x2*)(dst + 8 * 64) = s2; asm volatile("" ::: "memory"); }
    }
};
struct EpiSwiGLU {
    static constexpr bool PERM = true, AFTER_DRAIN = false;
    static constexpr float SC = 1.0f / 256.0f;
    static constexpr bool ROW_SCALE = true;
    bf16_t* HID; const float* RS; PG8_LAS const float* rs_lds; mutable int par;
    __device__ __forceinline__ void operator()(const f32x4 (&acc)[2][2][4][2], const Unit& u, int wr, int wc, int fr, int fq) const {
        const int row0 = u.pm * BM + wr * 64 + fr, col0 = (u.pn & 15) * HALF + wc * 32 + 8 * fq;
#pragma unroll
        for (int ai = 0; ai < 2; ++ai)
#pragma unroll
            for (int m = 0; m < 4; ++m) { unsigned char* rowp = (unsigned char*)HID + (size_t)(row0 + ai * HALF + m * 16) * 2048 + col0;
                const float rs = rs_lds[par * 256 + wr * 64 + fr + ai * HALF + m * 16] * SC;
                const f32x4 a0 = acc[ai][0][m][0] * rs, a1 = acc[ai][0][m][1] * rs, b0 = acc[ai][1][m][0] * rs, b1 = acc[ai][1][m][1] * rs;
                u32x2 w; w.x = cvt_pk_fp8x4(silu_f(a0[0]) * b0[0] * 8.f, silu_f(a0[1]) * b0[1] * 8.f, silu_f(a0[2]) * b0[2] * 8.f, silu_f(a0[3]) * b0[3] * 8.f);
                w.y = cvt_pk_fp8x4(silu_f(a1[0]) * b1[0] * 8.f, silu_f(a1[1]) * b1[1] * 8.f, silu_f(a1[2]) * b1[2] * 8.f, silu_f(a1[3]) * b1[3] * 8.f);
                *(u32x2*)rowp = w; }
    }
};
struct EpiGate {
    static constexpr bool PERM = true, AFTER_DRAIN = false;
    bf16_t* Y; const float* gate;
    __device__ __forceinline__ void operator()(const f32x4 (&acc)[2][2][4][2], const Unit& u, int wr, int wc, int fr, int fq) const {
        const int rowb = u.pm * BM + wr * 64, colw = (u.pn & 3) * BM + wc * 64;
        unsigned char* ob = (unsigned char*)Y + (size_t)(rowb + (fr & 7)) * 1024 + colw + (fr >> 3) * 32 + 8 * fq;
        float gts[8];
#pragma unroll
        for (int q = 0; q < 8; ++q) gts[q] = gate[rowb + fr + (q >> 2) * HALF + (q & 3) * 16];
        asm volatile("" ::: "memory");
#pragma unroll
        for (int ai = 0; ai < 2; ++ai)
#pragma unroll
            for (int m = 0; m < 4; ++m) { const float gt = gts[ai * 4 + m] * (32.0f / 512.0f); u32x2 w[2];
#pragma unroll
                for (int bj = 0; bj < 2; ++bj) { const f32x4 v0 = acc[ai][bj][m][0] * gt, v1 = acc[ai][bj][m][1] * gt;
                    w[bj].x = cvt_pk_fp8x4(v0[0], v0[1], v0[2], v0[3]); w[bj].y = cvt_pk_fp8x4(v1[0], v1[1], v1[2], v1[3]); }
                u32x2 s1, s2; xchg_rows2(w[0], w[1], s1, s2);
                unsigned char* rp = ob + (size_t)(ai * HALF + m * 16) * 1024;
                *(u32x2*)rp = s1; *(u32x2*)(rp + 8 * 1024) = s2; }
    }
};

template <class Epi, class Sched, bool ALIGN_EPI = false, bool SP2 = false, bool FP8 = false>
__device__ __forceinline__ void gemm_phase(PG8_LAS unsigned char* lds, const Gemm g, const Sched& S, const Epi& E) {
    int tid_ = threadIdx.x; asm volatile("" : "+v"(tid_));
    const int tid = tid_, wid = __builtin_amdgcn_readfirstlane(tid >> 6), lane = tid & 63, wr = wid >> 2, wc = wid & 3, fr = lane & 15, fq = lane >> 4;
    const int K = g.K, nt = K / BK;
    unsigned voffA, voffB;
    { int R, C; stage_rc(tid * 16, R, C); const int Rb = 64 * (R >> 5) + (Epi::PERM ? perm32(R & 31) : (R & 31)); voffA = (unsigned)(R * K + C) * 2u; voffB = (unsigned)(Rb * K + C) * 2u; }
    const unsigned rowb = (unsigned)K * 2u;
    const size_t kstep = (size_t)(BK * 2);
    const size_t hstep = (size_t)HALF * K * 2;
    const size_t tstep = 2 * hstep;
    const unsigned ldsw = (unsigned)wid * 1024u;
    int aoff = lds_byte(wr * 64 + fr, fq * 8), boff = lds_byte(wc * 32 + fr, fq * 8) + 4 * HTB; asm volatile("" : "+v"(aoff), "+v"(boff));
#define PG8_SA(b, h) (((b) * 2 + (h)) * HTB)
#define PG8_SB(b, h) ((4 + (b) * 2 + (h)) * HTB)
#define PG8_STAGEA(bufoff, gbase) do { _Pragma("unroll") for (int _i = 0; _i < 2; ++_i) { const char* _gb = (const char*)(gbase) + (size_t)(_i * 64) * rowb; unsigned _vo = voffA; asm volatile("" : "+s"(_gb), "+v"(_vo)); \
        __builtin_amdgcn_global_load_lds((const unsigned*)(_gb + _vo), (PG8_LAS unsigned*)(lds + (bufoff) + ldsw + _i * 8192), 16, 0, 0); } } while (0)
#define PG8_STAGEB(bufoff, gbase, h) do { _Pragma("unroll") for (int _i = 0; _i < 2; ++_i) { const char* _gb = (const char*)(gbase) + (size_t)((h) * 32 + _i * 128) * rowb; unsigned _vo = voffB; asm volatile("" : "+s"(_gb), "+v"(_vo)); \
        __builtin_amdgcn_global_load_lds((const unsigned*)(_gb + _vo), (PG8_LAS unsigned*)(lds + (bufoff) + ldsw + _i * 8192), 16, 0, 0); } } while (0)
#define PG8_LDA(dst, b, h) do { if constexpr (FP8) { _Pragma("unroll") for (int m = 0; m < 4; ++m) dst##8[m] = cat16(*(const PG8_LAS bf16x8*)(lds + PG8_SA(b, h) + aoff + m * 2048), *(const PG8_LAS bf16x8*)(lds + PG8_SA(b, h) + aoff + m * 2048 + 1024)); } else { \
        _Pragma("unroll") for (int m = 0; m < 4; ++m) _Pragma("unroll") for (int k = 0; k < 2; ++k) dst[m][k] = *(const PG8_LAS bf16x8*)(lds + PG8_SA(b, h) + aoff + m * 2048 + k * 1024); } } while (0)
#define PG8_LDB(dst, b, h) do { if constexpr (FP8) { _Pragma("unroll") for (int n = 0; n < 2; ++n) dst##8[n] = cat16(*(const PG8_LAS bf16x8*)(lds + (PG8_SB(b, h) - 4 * HTB) + boff + n * 2048), *(const PG8_LAS bf16x8*)(lds + (PG8_SB(b, h) - 4 * HTB) + boff + n * 2048 + 1024)); } else { \
        _Pragma("unroll") for (int n = 0; n < 2; ++n) _Pragma("unroll") for (int k = 0; k < 2; ++k) dst[n][k] = *(const PG8_LAS bf16x8*)(lds + (PG8_SB(b, h) - 4 * HTB) + boff + n * 2048 + k * 1024); } } while (0)
#define PG8_MMA(ai, bj, At, Bt) do { __builtin_amdgcn_s_setprio(1); if constexpr (FP8) { _Pragma("unroll") for (int m = 0; m < 4; ++m) _Pragma("unroll") for (int n = 0; n < 2; ++n) \
        acc[ai][bj][m][n] = __builtin_amdgcn_mfma_scale_f32_16x16x128_f8f6f4(Bt##8[n], At##8[m], acc[ai][bj][m][n], 0, 0, 0, 0, 0, 0); } else { \
        _Pragma("unroll") for (int m = 0; m < 4; ++m) _Pragma("unroll") for (int n = 0; n < 2; ++n) _Pragma("unroll") for (int k = 0; k < 2; ++k) \
        acc[ai][bj][m][n] = __builtin_amdgcn_mfma_f32_16x16x32_bf16(Bt[n][k], At[m][k], acc[ai][bj][m][n], 0, 0, 0); } __builtin_amdgcn_s_setprio(0); } while (0)
#define PG8_WAIT_V(n) asm volatile("s_waitcnt vmcnt(" #n ")" ::: "memory")
#define PG8_WAIT_L(n) asm volatile("s_waitcnt lgkmcnt(" #n ")" ::: "memory")
#define PG8_BAR __builtin_amdgcn_s_barrier()
#define PG8_SCHED __builtin_amdgcn_sched_barrier(0)
    Unit cur, nxt; int ui = 0;
    if (!S.next(0, cur)) return;
    f32x4 acc[2][2][4][2];
#pragma unroll
    for (int a = 0; a < 2; ++a)
#pragma unroll
        for (int b = 0; b < 2; ++b)
#pragma unroll
            for (int m = 0; m < 4; ++m)
#pragma unroll
                for (int n = 0; n < 2; ++n) acc[a][b][m][n] = (f32x4){0.f, 0.f, 0.f, 0.f};
    bf16x8 At[4][2], B0[2][2], B1[2][2]; i32x8 At8[4], B08[2], B18[2];
    const char* cA = (const char*)g.A + (size_t)cur.pm * tstep; const char* cB = (const char*)g.Bt + (size_t)cur.pn * tstep;
    S.a_ready(cur);
    if constexpr (SP2) {
        PG8_STAGEB(PG8_SB(0, 0), cB, 0); PG8_STAGEB(PG8_SB(0, 1), cB, 1); PG8_STAGEA(PG8_SA(0, 0), cA); PG8_STAGEA(PG8_SA(0, 1), cA + hstep);
        if (wr == 1) PG8_BAR;
        PG8_WAIT_V(2); PG8_BAR;
        PG8_STAGEB(PG8_SB(1, 0), cB + kstep, 0); PG8_STAGEA(PG8_SA(1, 0), cA + kstep); PG8_STAGEB(PG8_SB(1, 1), cB + kstep, 1);
        PG8_WAIT_V(6); PG8_BAR;
    } else {
        PG8_STAGEB(PG8_SB(0, 0), cB, 0); PG8_STAGEA(PG8_SA(0, 0), cA); PG8_STAGEB(PG8_SB(0, 1), cB, 1); PG8_STAGEA(PG8_SA(0, 1), cA + hstep);
        if (wr == 1) PG8_BAR;
        PG8_WAIT_V(4); PG8_BAR;
        PG8_STAGEB(PG8_SB(1, 0), cB + kstep, 0); PG8_STAGEA(PG8_SA(1, 0), cA + kstep); PG8_STAGEB(PG8_SB(1, 1), cB + kstep, 1);
        PG8_WAIT_V(6); PG8_BAR;
    }
    for (;;) {
        const bool has_next = S.next(ui + 1, nxt);
        const char* nA = has_next ? (const char*)g.A + (size_t)nxt.pm * tstep : cA; const char* nB = has_next ? (const char*)g.Bt + (size_t)nxt.pn * tstep : cB;
        for (int t = 0; t < nt; t += 2) {
            const bool last = (t == nt - 2);
            const char* a1 = cA + (size_t)(t + 1) * kstep;
            const char* a2 = last ? nA : cA + (size_t)(t + 2) * kstep; const char* b2 = last ? nB : cB + (size_t)(t + 2) * kstep;
            const char* a3 = a2 + kstep; const char* b3 = b2 + kstep;
            if (last && has_next) S.a_ready(nxt);
            if constexpr (SP2) {
            PG8_LDB(B0, 0, 0); PG8_LDB(B1, 0, 1); PG8_SCHED; PG8_LDA(At, 0, 0); PG8_STAGEA(PG8_SA(1, 1), a1 + hstep);
            PG8_WAIT_V(8); PG8_WAIT_L(0); PG8_BAR; PG8_MMA(0, 0, At, B0); PG8_MMA(0, 1, At, B1); PG8_BAR; PG8_SCHED;
            PG8_LDA(At, 0, 1); PG8_STAGEB(PG8_SB(0, 0), b2, 0); PG8_STAGEB(PG8_SB(0, 1), b2, 1); PG8_STAGEA(PG8_SA(0, 0), a2);
            PG8_WAIT_V(8); PG8_WAIT_L(0); PG8_BAR; PG8_MMA(1, 0, At, B0); PG8_MMA(1, 1, At, B1); PG8_BAR; PG8_SCHED;
            PG8_LDB(B0, 1, 0); PG8_LDB(B1, 1, 1); PG8_SCHED; PG8_LDA(At, 1, 0); PG8_STAGEA(PG8_SA(0, 1), a2 + hstep);
            PG8_WAIT_V(8); PG8_WAIT_L(0); PG8_BAR; PG8_MMA(0, 0, At, B0); PG8_MMA(0, 1, At, B1); PG8_BAR; PG8_SCHED;
            PG8_LDA(At, 1, 1); PG8_STAGEB(PG8_SB(1, 0), b3, 0); PG8_STAGEB(PG8_SB(1, 1), b3, 1); PG8_STAGEA(PG8_SA(1, 0), a3);
            PG8_WAIT_V(8); PG8_WAIT_L(0); PG8_BAR; PG8_MMA(1, 0, At, B0); PG8_MMA(1, 1, At, B1); PG8_BAR; PG8_SCHED;
            } else {
            PG8_LDB(B0, 0, 0); PG8_SCHED; PG8_LDA(At, 0, 0); PG8_STAGEA(PG8_SA(1, 1), a1 + hstep);
            PG8_WAIT_L(8); PG8_BAR; PG8_WAIT_L(0); PG8_MMA(0, 0, At, B0); PG8_BAR; PG8_SCHED;
            PG8_LDB(B1, 0, 1); PG8_STAGEB(PG8_SB(0, 0), b2, 0);
            PG8_BAR; PG8_WAIT_L(0); PG8_MMA(0, 1, At, B1); PG8_BAR;
            PG8_LDA(At, 0, 1); PG8_STAGEA(PG8_SA(0, 0), a2);
            PG8_BAR; PG8_WAIT_L(0); PG8_MMA(1, 0, At, B0); PG8_BAR; PG8_SCHED;
            PG8_STAGEB(PG8_SB(0, 1), b2, 1);
            PG8_WAIT_V(6); PG8_BAR; PG8_MMA(1, 1, At, B1); PG8_BAR;
            PG8_LDB(B0, 1, 0); PG8_SCHED; PG8_LDA(At, 1, 0); PG8_STAGEA(PG8_SA(0, 1), a2 + hstep);
            PG8_WAIT_L(8); PG8_BAR; PG8_WAIT_L(0); PG8_MMA(0, 0, At, B0); PG8_BAR; PG8_SCHED;
            PG8_LDB(B1, 1, 1); PG8_STAGEB(PG8_SB(1, 0), b3, 0);
            PG8_BAR; PG8_WAIT_L(0); PG8_MMA(0, 1, At, B1); PG8_BAR;
            PG8_LDA(At, 1, 1); PG8_STAGEA(PG8_SA(1, 0), a3);
            PG8_BAR; PG8_WAIT_L(0); PG8_MMA(1, 0, At, B0); PG8_BAR; PG8_SCHED;
            PG8_STAGEB(PG8_SB(1, 1), b3, 1);
            PG8_WAIT_V(6); PG8_BAR; PG8_MMA(1, 1, At, B1); PG8_BAR;
            }
        }
        if constexpr (ALIGN_EPI) { if (wr == 0) PG8_BAR; }
        if constexpr (!Epi::AFTER_DRAIN) { asm volatile("" ::: "memory"); __builtin_amdgcn_sched_barrier(0); int t2 = threadIdx.x; asm volatile("" : "+v"(t2)); E(acc, cur, wr, wc, t2 & 15, (t2 >> 4) & 3); S.done(cur); }
        if (!has_next) break;
#pragma unroll
        for (int a = 0; a < 2; ++a)
#pragma unroll
            for (int b = 0; b < 2; ++b)
#pragma unroll
                for (int m = 0; m < 4; ++m)
#pragma unroll
                    for (int n = 0; n < 2; ++n) acc[a][b][m][n] = (f32x4){0.f, 0.f, 0.f, 0.f};
        cur = nxt; cA = nA; cB = nB; ++ui;
        if constexpr (ALIGN_EPI) { if (wr == 1) PG8_BAR; }
    }
    PG8_WAIT_V(0);
    if constexpr (!ALIGN_EPI) { if (wr == 0) PG8_BAR; }
    PG8_BAR;
#undef PG8_SA
#undef PG8_SB
#undef PG8_STAGEA
#undef PG8_STAGEB
#undef PG8_LDA
#undef PG8_LDB
#undef PG8_MMA
#undef PG8_WAIT_V
#undef PG8_WAIT_L
#undef PG8_BAR
#undef PG8_SCHED
}
template <class Epi, class Sched, bool FP8 = false>
__device__ __forceinline__ void gemm_phase_gather(PG8_LAS unsigned char* lds, const Gemm g, const int* rowmap, const Sched& S, const Epi& E) {
    constexpr bool ALIGN_EPI = true, SP2 = true;
    int tid_ = threadIdx.x; asm volatile("" : "+v"(tid_));
    const int tid = tid_, wid = __builtin_amdgcn_readfirstlane(tid >> 6), lane = tid & 63, wr = wid >> 2, wc = wid & 3, fr = lane & 15, fq = lane >> 4;
    const int K = g.K, nt = K / BK;
    unsigned voffB; int rA0; unsigned cA2;
    { int R, C; stage_rc(tid * 16, R, C); const int Rb = 64 * (R >> 5) + (Epi::PERM ? perm32(R & 31) : (R & 31)); rA0 = R; cA2 = (unsigned)C * 2u; voffB = (unsigned)(Rb * K + C) * 2u; }
    const unsigned rowb = (unsigned)K * 2u;
    const size_t kstep = (size_t)(BK * 2);
    const size_t hstep = (size_t)HALF * K * 2;
    const size_t tstep = 2 * hstep;
    const unsigned ldsw = (unsigned)wid * 1024u;
    int aoff = lds_byte(wr * 64 + fr, fq * 8), boff = lds_byte(wc * 32 + fr, fq * 8) + 4 * HTB; asm volatile("" : "+v"(aoff), "+v"(boff));
#define PG8_SA(b, h) (((b) * 2 + (h)) * HTB)
#define PG8_SB(b, h) ((4 + (b) * 2 + (h)) * HTB)
#define PG8_STAGE(bufoff, gbase, voff) do { const char* _gb = (const char*)(gbase); asm volatile("" : "+s"(_gb)); _Pragma("unroll") for (int _i = 0; _i < 2; ++_i) { unsigned _vo = (voff)[_i]; asm volatile("" : "+v"(_vo)); \
        __builtin_amdgcn_global_load_lds((const unsigned*)(_gb + _vo), (PG8_LAS unsigned*)(lds + (bufoff) + ldsw + _i * 8192), 16, 0, 0); } } while (0)
#define PG8_STAGEB(bufoff, gbase, h) do { _Pragma("unroll") for (int _i = 0; _i < 2; ++_i) { const char* _gb = (const char*)(gbase) + (size_t)((h) * 32 + _i * 128) * rowb; unsigned _vo = voffB; asm volatile("" : "+s"(_gb), "+v"(_vo)); \
        __builtin_amdgcn_global_load_lds((const unsigned*)(_gb + _vo), (PG8_LAS unsigned*)(lds + (bufoff) + ldsw + _i * 8192), 16, 0, 0); } } while (0)
#define PG8_LDA(dst, b, h) do { if constexpr (FP8) { _Pragma("unroll") for (int m = 0; m < 4; ++m) dst##8[m] = cat16(*(const PG8_LAS bf16x8*)(lds + PG8_SA(b, h) + aoff + m * 2048), *(const PG8_LAS bf16x8*)(lds + PG8_SA(b, h) + aoff + m * 2048 + 1024)); } else { \
        _Pragma("unroll") for (int m = 0; m < 4; ++m) _Pragma("unroll") for (int k = 0; k < 2; ++k) dst[m][k] = *(const PG8_LAS bf16x8*)(lds + PG8_SA(b, h) + aoff + m * 2048 + k * 1024); } } while (0)
#define PG8_LDB(dst, b, h) do { if constexpr (FP8) { _Pragma("unroll") for (int n = 0; n < 2; ++n) dst##8[n] = cat16(*(const PG8_LAS bf16x8*)(lds + (PG8_SB(b, h) - 4 * HTB) + boff + n * 2048), *(const PG8_LAS bf16x8*)(lds + (PG8_SB(b, h) - 4 * HTB) + boff + n * 2048 + 1024)); } else { \
        _Pragma("unroll") for (int n = 0; n < 2; ++n) _Pragma("unroll") for (int k = 0; k < 2; ++k) dst[n][k] = *(const PG8_LAS bf16x8*)(lds + (PG8_SB(b, h) - 4 * HTB) + boff + n * 2048 + k * 1024); } } while (0)
#define PG8_MMA(ai, bj, At, Bt) do { __builtin_amdgcn_s_setprio(1); if constexpr (FP8) { _Pragma("unroll") for (int m = 0; m < 4; ++m) _Pragma("unroll") for (int n = 0; n < 2; ++n) \
        acc[ai][bj][m][n] = __builtin_amdgcn_mfma_scale_f32_16x16x128_f8f6f4(Bt##8[n], At##8[m], acc[ai][bj][m][n], 0, 0, 0, 0, 0, 0); } else { \
        _Pragma("unroll") for (int m = 0; m < 4; ++m) _Pragma("unroll") for (int n = 0; n < 2; ++n) _Pragma("unroll") for (int k = 0; k < 2; ++k) \
        acc[ai][bj][m][n] = __builtin_amdgcn_mfma_f32_16x16x32_bf16(Bt[n][k], At[m][k], acc[ai][bj][m][n], 0, 0, 0); } __builtin_amdgcn_s_setprio(0); } while (0)
#define PG8_WAIT_V(n) asm volatile("s_waitcnt vmcnt(" #n ")" ::: "memory")
#define PG8_WAIT_L(n) asm volatile("s_waitcnt lgkmcnt(" #n ")" ::: "memory")
#define PG8_BAR __builtin_amdgcn_s_barrier()
#define PG8_SCHED __builtin_amdgcn_sched_barrier(0)
    Unit cur, nxt; int ui = 0;
    if (!S.next(0, cur)) return;
    f32x4 acc[2][2][4][2];
#pragma unroll
    for (int a = 0; a < 2; ++a)
#pragma unroll
        for (int b = 0; b < 2; ++b)
#pragma unroll
            for (int m = 0; m < 4; ++m)
#pragma unroll
                for (int n = 0; n < 2; ++n) acc[a][b][m][n] = (f32x4){0.f, 0.f, 0.f, 0.f};
    bf16x8 At[4][2], B0[2][2], B1[2][2]; i32x8 At8[4], B08[2], B18[2];
    const char* const gA = (const char*)g.A; const char* cB = (const char*)g.Bt + (size_t)cur.pn * tstep;
    unsigned va[2][2];
#pragma unroll
    for (int h = 0; h < 2; ++h)
#pragma unroll
        for (int i = 0; i < 2; ++i) va[h][i] = (unsigned)rowmap[cur.pm * BM + h * HALF + rA0 + 64 * i] * rowb + cA2;
    S.a_ready(cur);
    if constexpr (SP2) {
        PG8_STAGEB(PG8_SB(0, 0), cB, 0); PG8_STAGEB(PG8_SB(0, 1), cB, 1); PG8_STAGE(PG8_SA(0, 0), gA, va[0]); PG8_STAGE(PG8_SA(0, 1), gA, va[1]);
        if (wr == 1) PG8_BAR;
        PG8_WAIT_V(2); PG8_BAR;
        PG8_STAGEB(PG8_SB(1, 0), cB + kstep, 0); PG8_STAGE(PG8_SA(1, 0), gA + kstep, va[0]); PG8_STAGEB(PG8_SB(1, 1), cB + kstep, 1);
        PG8_WAIT_V(6); PG8_BAR;
    }
    for (;;) {
        const bool has_next = S.next(ui + 1, nxt);
        const char* nB = has_next ? (const char*)g.Bt + (size_t)nxt.pn * tstep : cB;
        if (wid >= 4) {
            const char* _gb = (const char*)(E.RS + cur.pm * BM) - 1024; unsigned _vo = (unsigned)threadIdx.x; asm volatile("" : "+s"(_gb), "+v"(_vo)); _vo *= 4u;
            __builtin_amdgcn_global_load_lds((const unsigned*)(_gb + _vo), (PG8_LAS unsigned*)(lds + STAGE_BYTES + 1024 + (ui & 1) * 1024 + (wid - 4) * 256), 4, 0, 0); }
        if (has_next && wid < 4) {
            const char* _gb = (const char*)(rowmap + nxt.pm * BM); unsigned _vo = (unsigned)threadIdx.x; asm volatile("" : "+s"(_gb), "+v"(_vo)); _vo *= 4u;
            __builtin_amdgcn_global_load_lds((const unsigned*)(_gb + _vo), (PG8_LAS unsigned*)(lds + STAGE_BYTES + wid * 256), 4, 0, 0); }
        for (int t = 0; t < nt; t += 2) {
            const bool last = (t == nt - 2);
            const char* a1 = gA + (size_t)(t + 1) * kstep;
            const char* a2 = last ? gA : gA + (size_t)(t + 2) * kstep; const char* b2 = last ? nB : cB + (size_t)(t + 2) * kstep;
            const char* a3 = a2 + kstep; const char* b3 = b2 + kstep;
            if (last && has_next) S.a_ready(nxt);
            if constexpr (SP2) {
            PG8_LDB(B0, 0, 0); PG8_LDB(B1, 0, 1); PG8_SCHED; PG8_LDA(At, 0, 0); PG8_STAGE(PG8_SA(1, 1), a1, va[1]);
            if (last && has_next) {
                int t3 = threadIdx.x; asm volatile("" : "+v"(t3)); int R3, C3; stage_rc(t3 * 16, R3, C3);
#pragma unroll
                for (int h = 0; h < 2; ++h)
#pragma unroll
                    for (int i = 0; i < 2; ++i) va[h][i] = *(const PG8_LAS unsigned*)(lds + STAGE_BYTES + (h * HALF + R3 + 64 * i) * 4) * rowb + (unsigned)C3 * 2u; }
            PG8_WAIT_V(8); PG8_WAIT_L(0); PG8_BAR; PG8_MMA(0, 0, At, B0); PG8_MMA(0, 1, At, B1); PG8_BAR; PG8_SCHED;
            PG8_LDA(At, 0, 1); PG8_STAGEB(PG8_SB(0, 0), b2, 0); PG8_STAGEB(PG8_SB(0, 1), b2, 1); PG8_STAGE(PG8_SA(0, 0), a2, va[0]);
            PG8_WAIT_V(8); PG8_WAIT_L(0); PG8_BAR; PG8_MMA(1, 0, At, B0); PG8_MMA(1, 1, At, B1); PG8_BAR; PG8_SCHED;
            PG8_LDB(B0, 1, 0); PG8_LDB(B1, 1, 1); PG8_SCHED; PG8_LDA(At, 1, 0); PG8_STAGE(PG8_SA(0, 1), a2, va[1]);
            PG8_WAIT_V(8); PG8_WAIT_L(0); PG8_BAR; PG8_MMA(0, 0, At, B0); PG8_MMA(0, 1, At, B1); PG8_BAR; PG8_SCHED;
            PG8_LDA(At, 1, 1); PG8_STAGEB(PG8_SB(1, 0), b3, 0); PG8_STAGEB(PG8_SB(1, 1), b3, 1); PG8_STAGE(PG8_SA(1, 0), a3, va[0]);
            PG8_WAIT_V(8); PG8_WAIT_L(0); PG8_BAR; PG8_MMA(1, 0, At, B0); PG8_MMA(1, 1, At, B1); PG8_BAR; PG8_SCHED;
            }
        }
        if constexpr (ALIGN_EPI) { if (wr == 0) PG8_BAR; }
        E.par = ui & 1;
        if constexpr (!Epi::AFTER_DRAIN) { int t2 = threadIdx.x; asm volatile("" : "+v"(t2)); E(acc, cur, wr, wc, t2 & 15, (t2 >> 4) & 3); S.done(cur); }
        if (!has_next) break;
#pragma unroll
        for (int a = 0; a < 2; ++a)
#pragma unroll
            for (int b = 0; b < 2; ++b)
#pragma unroll
                for (int m = 0; m < 4; ++m)
#pragma unroll
                    for (int n = 0; n < 2; ++n) acc[a][b][m][n] = (f32x4){0.f, 0.f, 0.f, 0.f};
        cur = nxt; cB = nB; ++ui;
        if constexpr (ALIGN_EPI) { if (wr == 1) PG8_BAR; }
    }
    PG8_WAIT_V(0);
    if constexpr (!ALIGN_EPI) { if (wr == 0) PG8_BAR; }
    PG8_BAR;
#undef PG8_SA
#undef PG8_SB
#undef PG8_STAGE
#undef PG8_STAGEB
#undef PG8_LDA
#undef PG8_LDB
#undef PG8_MMA
#undef PG8_WAIT_V
#undef PG8_WAIT_L
#undef PG8_BAR
#undef PG8_SCHED
}
}

constexpr int NB = 8, SEQ = 4096, D = 1024, T = NB * SEQ;
constexpr int GW = 3072;
constexpr int NE = 16, CAP = 512, DE = 2048, NSLOT = NB * NE * CAP;
constexpr int QKVW = 4608, AW = 512;
constexpr float EPS = 1e-6f;

constexpr size_t MiB = 1u << 20;
constexpr size_t WS_CTL = 0, CTL_ZERO_BYTES = 1 * MiB;
constexpr size_t WS_WIN = 1 * MiB;
constexpr size_t WS_WOUT = 25 * MiB;
constexpr size_t WS_WQKV = 37 * MiB;
constexpr size_t WS_WO = 55 * MiB;
constexpr size_t WS_W13 = 57 * MiB;
constexpr size_t WS_W2 = 569 * MiB;
constexpr size_t WS_H = 825 * MiB;
constexpr size_t WS_AFF = 889 * MiB;
constexpr size_t WS_SMAP = 891 * MiB;
constexpr size_t WS_TOK = 893 * MiB;
constexpr size_t WS_GATE = 893 * MiB + 512 * 1024;
constexpr size_t WS_RS = 893 * MiB + 256 * 1024;
constexpr size_t WS_RINV = 893 * MiB + 768 * 1024;
constexpr size_t WS_XB = 894 * MiB;
constexpr size_t WS_XO = WS_XB + 64 * MiB;
constexpr size_t WS_ACT = 1022 * MiB;
constexpr size_t WS_U = WS_ACT, WS_VT = WS_ACT + 192 * MiB, WS_SSQ = WS_ACT + 384 * MiB, WS_UV = WS_ACT + 388 * MiB;
constexpr size_t WS_QKV = WS_ACT, WS_OG = WS_ACT + 288 * MiB, WS_LSE = WS_ACT + 384 * MiB, WS_O = WS_ACT + 388 * MiB;
constexpr size_t WS_XIN = WS_ACT, WS_HID = WS_ACT + 128 * MiB, WS_Y = WS_ACT + 384 * MiB;
constexpr size_t WS_END = WS_ACT + 580 * MiB;
constexpr int CW_BAR = 4096;

constexpr int RING_BYTES = 131072, LDS_BYTES = 147456, LDSCTL_OFF = LDS_BYTES - 256;

#define LAS __attribute__((address_space(3)))
typedef unsigned short bf16;
typedef unsigned v4u __attribute__((ext_vector_type(4)));
typedef unsigned v2u __attribute__((ext_vector_type(2)));
typedef float f32x4 __attribute__((ext_vector_type(4)));
typedef short bf16x8 __attribute__((ext_vector_type(8)));
#define LDS_WAIT() asm volatile("s_waitcnt lgkmcnt(0)" ::: "memory")
__device__ __forceinline__ unsigned f2bf(float f) { unsigned u = __builtin_bit_cast(unsigned, f); return (u + 0x7fffu + ((u >> 16) & 1u)) >> 16; }
typedef float f32x2_t __attribute__((ext_vector_type(2))); typedef __bf16 bf16x2_t __attribute__((ext_vector_type(2)));
__device__ __forceinline__ unsigned pk2(float lo, float hi) { const f32x2_t v = {lo, hi}; return __builtin_bit_cast(unsigned, __builtin_convertvector(v, bf16x2_t)); }
__device__ __forceinline__ unsigned pk8(float a, float b, float c, float d) {
    a = __builtin_copysignf(fminf(__builtin_fabsf(a), 448.f), a); b = __builtin_copysignf(fminf(__builtin_fabsf(b), 448.f), b); c = __builtin_copysignf(fminf(__builtin_fabsf(c), 448.f), c); d = __builtin_copysignf(fminf(__builtin_fabsf(d), 448.f), d);
    int r = __builtin_amdgcn_cvt_pk_fp8_f32(a, b, 0, false); r = __builtin_amdgcn_cvt_pk_fp8_f32(c, d, r, true); return (unsigned)r; }
__device__ __forceinline__ v4u fp8x8_bf16(v2u x, float sc) {
    const f32x2_t a = __builtin_amdgcn_cvt_pk_f32_fp8((int)x.x, false), b = __builtin_amdgcn_cvt_pk_f32_fp8((int)x.x, true), c = __builtin_amdgcn_cvt_pk_f32_fp8((int)x.y, false), d = __builtin_amdgcn_cvt_pk_f32_fp8((int)x.y, true);
    v4u o; o.x = pk2(a.x * sc, a.y * sc); o.y = pk2(b.x * sc, b.y * sc); o.z = pk2(c.x * sc, c.y * sc); o.w = pk2(d.x * sc, d.y * sc); return o; }
__device__ __forceinline__ float bf_lo(unsigned w) { return __builtin_bit_cast(float, w << 16); }
__device__ __forceinline__ float bf_hi(unsigned w) { return __builtin_bit_cast(float, w & 0xffff0000u); }

#define XB_TMO      128
#define XB_XCNT(j)  (256  + 64 * (j))
#define XB_XSUB(j)  (1280 + 64 * (j))
#define XB_XGEN(j)  (2304 + 64 * (j))
#define XB_TOP      3328
#define XB_TOPGEN   3392
#define XCD_BAR_WORDS 3456
#define XB_SPIN_CAP (1u << 22)
__device__ __forceinline__ unsigned xb_ld(unsigned* p)              { return __hip_atomic_load(p, __ATOMIC_RELAXED, __HIP_MEMORY_SCOPE_AGENT); }
__device__ __forceinline__ unsigned xb_add(unsigned* p, unsigned v) { asm volatile("" : "+v"(v)); return __hip_atomic_fetch_add(p, v, __ATOMIC_RELAXED, __HIP_MEMORY_SCOPE_AGENT); }
__device__ __forceinline__ unsigned xb_xcc_id() { return (unsigned)__builtin_amdgcn_s_getreg((3 << 11) | 20) & 0xFu; }
#define XB_SPIN(cond, bar) do { unsigned _sp = 0; while (cond) { __builtin_amdgcn_s_sleep(1); \
    if ((++_sp & 255u) == 0u) { if (xb_ld(&(bar)[XB_TMO])) break; if (_sp > XB_SPIN_CAP) { atomicAdd(&(bar)[XB_TMO], 1u); break; } } } } while (0)
struct XcdBarrier { unsigned* bar; unsigned x; volatile LAS unsigned* st; };
__device__ __forceinline__ XcdBarrier xcd_barrier_post(unsigned* bar, volatile LAS unsigned* st) {
    XcdBarrier b; b.bar = bar; b.x = xb_xcc_id(); b.st = st;
    if (threadIdx.x == 0) (void)xb_add(&bar[XB_XCNT(b.x)], 1u);
    return b;
}
__device__ __forceinline__ void xcd_barrier_complete(unsigned* bar, unsigned x, unsigned& nloc, unsigned& nx) {
    const unsigned G = gridDim.x * gridDim.y * gridDim.z;
    unsigned sum, cnt, mine, sp = 0u;
    for (;;) {
        sum = 0u; cnt = 0u; mine = 0u;
#pragma unroll
        for (unsigned j = 0; j < 16; ++j) { const unsigned c = xb_ld(&bar[XB_XCNT(j)]); sum += c; cnt += (c > 0u) ? 1u : 0u; mine = (j == x) ? c : mine; }
        if (sum == G) break;
        __builtin_amdgcn_s_sleep(1);
        if ((++sp & 255u) == 0u) { if (xb_ld(&bar[XB_TMO])) break; if (sp > XB_SPIN_CAP) { atomicAdd(&bar[XB_TMO], 1u); break; } }
    }
    nloc = mine > 0u ? mine : 1u; nx = cnt > 0u ? cnt : 1u;
}
__device__ __forceinline__ void xcd_barrier(const XcdBarrier& b) {
    asm volatile("s_waitcnt vmcnt(0)" ::: "memory");
    __syncthreads();
    if (threadIdx.x == 0) {
        unsigned* bar = b.bar;
        __builtin_amdgcn_s_waitcnt(0);
        unsigned nloc = b.st[0], nx = b.st[1];
        if (nloc == 0u) { xcd_barrier_complete(bar, b.x, nloc, nx); b.st[0] = nloc; b.st[1] = nx; }
        const unsigned old = xb_add(&bar[XB_XSUB(b.x)], 1u);
        const unsigned gen = old / nloc;
        if (old + 1u == (gen + 1u) * nloc) {
            __builtin_amdgcn_fence(__ATOMIC_RELEASE, "agent");
            asm volatile("s_waitcnt vmcnt(0)" ::: "memory");
            const unsigned og = xb_add(&bar[XB_TOP], 1u);
            const unsigned tg = og / nx;
            if (og + 1u == (tg + 1u) * nx) xb_add(&bar[XB_TOPGEN], 1u);
            else XB_SPIN(xb_ld(&bar[XB_TOPGEN]) == tg, bar);
            __builtin_amdgcn_fence(__ATOMIC_ACQUIRE, "agent");
            xb_add(&bar[XB_XGEN(b.x)], 1u);
            asm volatile("s_waitcnt vmcnt(0)" ::: "memory");
        } else {
            XB_SPIN(xb_ld(&bar[XB_XGEN(b.x)]) == gen, bar);
            __builtin_amdgcn_fence(__ATOMIC_ACQUIRE, "agent");
            asm volatile("s_waitcnt vmcnt(0)" ::: "memory");
        }
    }
    __syncthreads();
}

struct Args {
    const float* x; const float* mix_norm; const float* ffn_norm;
    const float* gm_w_in; const float* gm_b_in; const float* gm_v_norm; const float* gm_w_s; const float* gm_b_s; const float* gm_w_out; const float* gm_b_out;
    const float* at_w_qkv; const float* at_q_norm; const float* at_k_norm; const float* at_w_o;
    const float* moe_w_router; const float* moe_b_router; const float* moe_w1; const float* moe_w3; const float* moe_w2;
    float* out; unsigned char* ws; int ph_lo, ph_hi;
};
typedef const __attribute__((address_space(4))) Args KArgs;

template <int CTRL> __device__ __forceinline__ float dppf(float v) { return __builtin_bit_cast(float, __builtin_amdgcn_update_dpp(0, __builtin_bit_cast(int, v), CTRL, 0xF, 0xF, true)); }
__device__ __forceinline__ float row_sum(float v) { v += dppf<0xB1>(v); v += dppf<0x4E>(v); v += dppf<0x141>(v); v += dppf<0x140>(v); return v; }
__device__ __forceinline__ float row_max(float v) { v = fmaxf(v, dppf<0xB1>(v)); v = fmaxf(v, dppf<0x4E>(v)); v = fmaxf(v, dppf<0x141>(v)); v = fmaxf(v, dppf<0x140>(v)); return v; }
__device__ __forceinline__ float wave_sum(float v) {
    v = row_sum(v);
    { auto rr = __builtin_amdgcn_permlane16_swap(__float_as_uint(v), __float_as_uint(v), false, false); v = __uint_as_float(rr[0]) + __uint_as_float(rr[1]); }
    { auto rr = __builtin_amdgcn_permlane32_swap(__float_as_uint(v), __float_as_uint(v), false, false); v = __uint_as_float(rr[0]) + __uint_as_float(rr[1]); }
    return v;
}

template <int MAP> __device__ __forceinline__ int wt_drow(int n) {
    if (MAP == 2) return 256 * (n >> 7) + 64 * ((n >> 5) & 3) + (n & 31);
    if (MAP == 3) return 256 * (n >> 7) + 64 * ((n >> 5) & 3) + 32 + (n & 31);
    return n;
}
template <int MAP> __device__ __forceinline__ void transpose_item(const float* __restrict__ W, int K, int N, bf16* WT, int k0, int n0, LAS float* scr, int lane) {
    f32x4 x[16];
#pragma unroll
    for (int i = 0; i < 16; ++i) x[i] = __builtin_nontemporal_load((const f32x4*)(W + (size_t)(k0 + 4 * i + (lane >> 4)) * N + n0 + 4 * (lane & 15)));
#pragma unroll
    for (int i = 0; i < 16; ++i) { LAS float* d = scr + (4 * i + (lane >> 4)) * 65 + 4 * (lane & 15); d[0] = x[i].x; d[1] = x[i].y; d[2] = x[i].z; d[3] = x[i].w; }
    LDS_WAIT(); asm volatile("" ::: "memory");
    const int c = lane & 7;
#pragma unroll
    for (int j = 0; j < 8; ++j) { const int n = (lane >> 3) + 8 * j; const LAS float* sp = scr + (8 * c) * 65 + n;
        if constexpr (MAP == 2 || MAP == 3 || MAP == 4) {
            v2u o; o.x = pk8(sp[0 * 65] * 64.f, sp[1 * 65] * 64.f, sp[2 * 65] * 64.f, sp[3 * 65] * 64.f); o.y = pk8(sp[4 * 65] * 64.f, sp[5 * 65] * 64.f, sp[6 * 65] * 64.f, sp[7 * 65] * 64.f);
            __builtin_nontemporal_store(o, (v2u*)((unsigned char*)WT + (size_t)wt_drow<MAP>(n0 + n) * K + k0 + 8 * c));
        } else {
        v4u o; o.x = pk2(sp[0 * 65], sp[1 * 65]); o.y = pk2(sp[2 * 65], sp[3 * 65]); o.z = pk2(sp[4 * 65], sp[5 * 65]); o.w = pk2(sp[6 * 65], sp[7 * 65]);
        __builtin_nontemporal_store(o, (v4u*)(WT + (size_t)wt_drow<MAP>(n0 + n) * K + k0 + 8 * c)); } }
    LDS_WAIT(); asm volatile("" ::: "memory");
}

__device__ __forceinline__ void rms_row_to_bf16(const float* xrow, const float* gain, bf16* orow, int lane) {
    const f32x4* xr = (const f32x4*)xrow + lane; const f32x4* gr = (const f32x4*)gain + lane;
    f32x4 v[4]; float s = 0.f;
#pragma unroll
    for (int j = 0; j < 4; ++j) { v[j] = xr[64 * j]; s += (v[j].x * v[j].x + v[j].y * v[j].y) + (v[j].z * v[j].z + v[j].w * v[j].w); }
    const float rinv = __builtin_amdgcn_rsqf((wave_sum(s) + EPS * D) * (1.f / D));
    unsigned long long* o8 = (unsigned long long*)orow + lane;
#pragma unroll
    for (int j = 0; j < 4; ++j) { const f32x4 g = gr[64 * j]; const f32x4 y = v[j] * rinv * g;
        o8[64 * j] = (unsigned long long)pk2(y.x, y.y) | ((unsigned long long)pk2(y.z, y.w) << 32); }
}

__device__ __forceinline__ void moe_convert_item(KArgs& a, int layer, int it, LAS float* scr, int lane) {
    unsigned char* ws = a.ws;
    const int q = it >> 9, r = it & 511, le = layer * 16 + q / 3, which = q % 3;
    if (which == 0) transpose_item<2>(a.moe_w1 + (size_t)le * 1024 * 2048, 1024, 2048, (bf16*)(ws + WS_W13 + (size_t)(le >> 4) * (128 * MiB) + (size_t)(le & 15) * 4096 * 1024), (r >> 5) * 64, (r & 31) * 64, scr, lane);
    else if (which == 1) transpose_item<3>(a.moe_w3 + (size_t)le * 1024 * 2048, 1024, 2048, (bf16*)(ws + WS_W13 + (size_t)(le >> 4) * (128 * MiB) + (size_t)(le & 15) * 4096 * 1024), (r >> 5) * 64, (r & 31) * 64, scr, lane);
    else transpose_item<4>(a.moe_w2 + (size_t)le * 2048 * 1024, 2048, 1024, (bf16*)(ws + WS_W2 + (size_t)(le >> 4) * (64 * MiB) + (size_t)(le & 15) * 1024 * 2048), (r >> 4) * 64, (r & 15) * 64, scr, lane);
}
constexpr int MOE_ITEMS_PER_LAYER = 16 * 3 * 512;
__device__ __forceinline__ void moe_convert_layer(KArgs& a, int layer, LAS unsigned char* lds, int w, int nw) {
    int tid = threadIdx.x; asm volatile("" : "+v"(tid)); const int lane = tid & 63, wave = __builtin_amdgcn_readfirstlane(tid >> 6);
    LAS float* scr = (LAS float*)(lds + wave * 16640);
    for (int it = w; it < MOE_ITEMS_PER_LAYER; it += nw) moe_convert_item(a, layer, it, scr, lane);
}
__device__ __forceinline__ void prologue_phase(KArgs& a, LAS unsigned char* lds, int nmoe) {
    int tid = threadIdx.x; asm volatile("" : "+v"(tid)); const int lane = tid & 63, wave = __builtin_amdgcn_readfirstlane(tid >> 6); (void)lane; (void)wave;
    LAS float* scr = (LAS float*)(lds + wave * 16640);
    const int gw = blockIdx.x * 8 + wave, NGW = gridDim.x * 8;
    unsigned char* ws = a.ws;
    const int IT_MOE = nmoe * MOE_ITEMS_PER_LAYER, NITEMS = IT_MOE + 3072 + 1536 + 2304 + 256;
    for (int it = gw; it < NITEMS; it += NGW) {
        if (it < IT_MOE) { moe_convert_item(a, it / MOE_ITEMS_PER_LAYER, it % MOE_ITEMS_PER_LAYER, scr, lane);
        } else {
            int r = it - IT_MOE;
            if (r < 3072) { const int j = r / 1536, rr = r % 1536; transpose_item<0>(a.gm_w_in + (size_t)j * 1024 * 6144, 1024, 6144, (bf16*)(ws + WS_WIN) + (size_t)j * 6144 * 1024, (rr / 96) * 64, (rr % 96) * 64, scr, lane); }
            else if (r < 3072 + 1536) { r -= 3072; const int j = r / 768, rr = r % 768; transpose_item<0>(a.gm_w_out + (size_t)j * 3072 * 1024, 3072, 1024, (bf16*)(ws + WS_WOUT) + (size_t)j * 1024 * 3072, (rr >> 4) * 64, (rr & 15) * 64, scr, lane); }
            else if (r < 3072 + 1536 + 2304) { r -= 3072 + 1536; const int j = r / 1152, rr = r % 1152; transpose_item<4>(a.at_w_qkv + (size_t)j * 1024 * 4608, 1024, 4608, (bf16*)(ws + WS_WQKV) + (size_t)j * 4608 * 1024, (rr / 72) * 64, (rr % 72) * 64, scr, lane); }
            else { r -= 3072 + 1536 + 2304; const int j = r >> 7, rr = r & 127; transpose_item<0>(a.at_w_o + (size_t)j * 512 * 1024, 512, 1024, (bf16*)(ws + WS_WO) + (size_t)j * 1024 * 512, (rr >> 4) * 64, (rr & 15) * 64, scr, lane); }
        }
    }
    bf16* H = (bf16*)(ws + WS_H);
    {   f32x4 nx[4];
#pragma unroll
        for (int j = 0; j < 4; ++j) nx[j] = (f32x4){0.f, 0.f, 0.f, 0.f};
        if (gw < T) {
#pragma unroll
            for (int j = 0; j < 4; ++j) nx[j] = __builtin_nontemporal_load((const f32x4*)(a.x + (size_t)gw * D) + lane + 64 * j); }
        for (int m = gw; m < T; m += NGW) {
            f32x4 v[4]; float ssq = 0.f;
#pragma unroll
            for (int j = 0; j < 4; ++j) { v[j] = nx[j]; ssq += (v[j].x * v[j].x + v[j].y * v[j].y) + (v[j].z * v[j].z + v[j].w * v[j].w); }
            if (m + NGW < T) {
#pragma unroll
                for (int j = 0; j < 4; ++j) nx[j] = __builtin_nontemporal_load((const f32x4*)(a.x + (size_t)(m + NGW) * D) + lane + 64 * j); }
            const float rinv = __builtin_amdgcn_rsqf((wave_sum(ssq) + EPS * D) * (1.f / D));
            const f32x4* gr = (const f32x4*)a.mix_norm + lane; unsigned long long* o8 = (unsigned long long*)(H + (size_t)m * D) + lane;
#pragma unroll
            for (int j = 0; j < 4; ++j) { const f32x4 y = v[j] * rinv * gr[64 * j]; o8[64 * j] = (unsigned long long)pk2(y.x, y.y) | ((unsigned long long)pk2(y.z, y.w) << 32); } } }
}

__device__ __forceinline__ void gating_phase(KArgs& a, int j, LAS unsigned char* lds) {
    int tid = threadIdx.x; asm volatile("" : "+v"(tid)); const int lane = tid & 63, wave = __builtin_amdgcn_readfirstlane(tid >> 6);
    LAS unsigned short* Wl = (LAS unsigned short*)lds;
    LAS float* rinv = (LAS float*)(lds + 36864);
    LAS float* part = (LAS float*)(lds + 37888);
    LAS unsigned char* stage = lds + 40960;
    const float* Ws = a.gm_w_s + (size_t)j * 8 * 128 * 128; const float* bs = a.gm_b_s + j * 8 * 128; const float* vg = a.gm_v_norm + j * GW;
    const bf16* U = (const bf16*)(a.ws + WS_U); bf16* UV = (bf16*)(a.ws + WS_UV); const bf16* VT = (const bf16*)(a.ws + WS_VT); const float* SSQ = (const float*)(a.ws + WS_SSQ);
    const int fr = lane & 15, fq = lane >> 4;
    int cur_g = -1;
    bf16x8 vf[3][4]; float ssum = 0.f;
#define GATE_REQUEST(unit_) do { const int g_ = (unit_) & 7, tok0_ = ((unit_) >> 3) * 128; \
        _Pragma("unroll") for (int n = 0; n < 3; ++n) _Pragma("unroll") for (int ks = 0; ks < 4; ++ks) \
            vf[n][ks] = __builtin_nontemporal_load((const bf16x8*)(VT + (size_t)((tok0_ >> 7) * 3072 + g_ * 384 + 48 * wave + 16 * n + fr) * 128 + 32 * ks + 8 * fq)); \
        ssum = 0.f; _Pragma("unroll") for (int q = 0; q < 6; ++q) ssum += SSQ[(size_t)(6 * (tid >> 7) + q) * T + tok0_ + (tid & 127)]; } while (0)
    if (blockIdx.x < 2048) GATE_REQUEST(blockIdx.x);
    for (int unit = blockIdx.x; unit < 2048; unit += gridDim.x) {
        const int g = unit & 7, tok0 = (unit >> 3) * 128;
        __syncthreads();
        if (g != cur_g) {
            int tw = tid; asm volatile("" : "+v"(tw));
#pragma unroll
            for (int i = 0; i < 8; ++i) { const int idx = (tw + 512 * i) * 4, t = idx >> 7, s0 = idx & 127; const f32x4 w = *(const f32x4*)(Ws + g * 16384 + idx);
                v2u o; o.x = pk2(w.x, w.y); o.y = pk2(w.z, w.w); *(LAS v2u*)(Wl + t * 136 + s0) = o; }
            cur_g = g; }
        part[tid] = ssum;
        __syncthreads();
        if (tid < 128) rinv[tid] = __builtin_amdgcn_rsqf((((part[tid] + part[128 + tid]) + (part[256 + tid] + part[384 + tid])) + EPS * GW) * (1.0f / GW));
        __syncthreads();
#pragma unroll
        for (int ks = 0; ks < 4; ++ks) { const f32x4 r0 = *(const LAS f32x4*)(rinv + 32 * ks + 8 * fq), r1 = *(const LAS f32x4*)(rinv + 32 * ks + 8 * fq + 4);
#pragma unroll
            for (int n = 0; n < 3; ++n) { const v4u x = __builtin_bit_cast(v4u, vf[n][ks]); v4u y;
                y.x = pk2(bf_lo(x.x) * r0.x, bf_hi(x.x) * r0.y); y.y = pk2(bf_lo(x.y) * r0.z, bf_hi(x.y) * r0.w);
                y.z = pk2(bf_lo(x.z) * r1.x, bf_hi(x.z) * r1.y); y.w = pk2(bf_lo(x.w) * r1.z, bf_hi(x.w) * r1.w);
                vf[n][ks] = __builtin_bit_cast(bf16x8, y); } }
#pragma unroll 1
        for (int mh = 0; mh < 2; ++mh) {
            v4u ug[6];
            int te = tid; asm volatile("" : "+v"(te));
#pragma unroll
            for (int k = 0; k < 6; ++k) { const int c = te + 512 * k, row = c / 48, c8 = c % 48; ug[k] = __builtin_nontemporal_load((const v4u*)(U + (size_t)(tok0 + 64 * mh + row) * GW + g * 384 + c8 * 8)); }
            f32x4 acc[4][3];
#pragma unroll
            for (int m = 0; m < 4; ++m)
#pragma unroll
                for (int n = 0; n < 3; ++n) acc[m][n] = (f32x4){0.f, 0.f, 0.f, 0.f};
#pragma unroll
            for (int ks = 0; ks < 4; ++ks)
#pragma unroll
                for (int m = 0; m < 4; ++m) { const bf16x8 wf = *(const LAS bf16x8*)(Wl + (64 * mh + 16 * m + fr) * 136 + 32 * ks + 8 * fq);
#pragma unroll
                    for (int n = 0; n < 3; ++n) acc[m][n] = __builtin_amdgcn_mfma_f32_16x16x32_bf16(vf[n][ks], wf, acc[m][n], 0, 0, 0); }
            if (mh == 1 && unit + (int)gridDim.x < 2048) { asm volatile("" ::: "memory"); GATE_REQUEST(unit + (int)gridDim.x); }
#pragma unroll
            for (int n = 0; n < 3; ++n) { const int el = 48 * wave + 16 * n + 4 * fq; const f32x4 gn = *(const f32x4*)(vg + g * 384 + el);
#pragma unroll
                for (int m = 0; m < 4; ++m) { const int tl = 16 * m + fr; const float bt = bs[g * 128 + 64 * mh + tl];
                    *(LAS f32x4*)(stage + tl * 1552 + el * 4) = acc[m][n] * gn + bt; } }
            __syncthreads();
#pragma unroll
            for (int k = 0; k < 6; ++k) { const int c = te + 512 * k, row = c / 48, c8 = c % 48;
                const f32x4 g0 = *(const LAS f32x4*)(stage + row * 1552 + c8 * 32), g1 = *(const LAS f32x4*)(stage + row * 1552 + c8 * 32 + 16);
                v4u w; w.x = pk2(g0.x * bf_lo(ug[k].x), g0.y * bf_hi(ug[k].x)); w.y = pk2(g0.z * bf_lo(ug[k].y), g0.w * bf_hi(ug[k].y));
                w.z = pk2(g1.x * bf_lo(ug[k].z), g1.y * bf_hi(ug[k].z)); w.w = pk2(g1.z * bf_lo(ug[k].w), g1.w * bf_hi(ug[k].w));
                __builtin_nontemporal_store(w, (v4u*)(UV + (size_t)(tok0 + 64 * mh + row) * GW + g * 384 + c8 * 8)); }
            if (mh == 0) __syncthreads();
        }
    }
#undef GATE_REQUEST
}

typedef float f32x16 __attribute__((ext_vector_type(16)));
typedef short s16x4 __attribute__((ext_vector_type(4)));
typedef short v4i16_t __attribute__((ext_vector_type(4)));
__device__ __forceinline__ s16x4 vtr(const LAS unsigned char* p) { return __builtin_bit_cast(s16x4, __builtin_amdgcn_ds_read_tr16_b64_v4i16((LAS v4i16_t*)p)); }
__device__ __forceinline__ void attn_phase(KArgs& a, LAS unsigned char* lds) {
    int tid = threadIdx.x; asm volatile("" : "+v"(tid)); const int lane = tid & 63, wave = __builtin_amdgcn_readfirstlane(tid >> 6), r32 = lane & 31, hi = lane >> 5;
    const unsigned char* QKV = a.ws + WS_QKV; bf16* OG = (bf16*)(a.ws + WS_OG); float* LSE = (float*)(a.ws + WS_LSE);
    LAS unsigned char* Kl = lds; LAS unsigned char* Vl = lds + 49152;
    LAS unsigned char* Ql = lds + 98304;
    constexpr size_t HEADSZ = (size_t)4096 * 64, WHICHSZ = (size_t)3 * 64 * 4096 * 64;
    v2u kr[6], vr[6], qv[4];
#define ATTN_DECODE(u_) const int g = (u_) >> 10, v = (u_) & 1023, bh = v >> 4, w16 = v & 15, dsh = 2 * g, dil = 1 << dsh, r = w16 & (dil - 1), blk = w16 >> dsh, L = 4096 >> dsh, p0 = blk * 256; \
        const unsigned char* qb = QKV + ((size_t)g * 64 + bh) * HEADSZ; const unsigned char* kb = qb + WHICHSZ; const unsigned char* vb = qb + 2 * WHICHSZ; (void)dil; (void)kb; (void)vb;
#define ATTN_REQUEST(u_) do { ATTN_DECODE(u_) \
        _Pragma("unroll") for (int i = 0; i < 6; ++i) { const int wv = wave + 8 * i; \
            const int key = 8 * wv + (lane & 7), p = min(max(p0 - 64 + key, 0), L - 1);        \
            kr[i] = __builtin_nontemporal_load((const v2u*)(kb + (size_t)(r + (p << dsh)) * 64 + (lane >> 3) * 8)); \
            const int key2 = 8 * wv + (lane >> 3), p2 = min(max(p0 - 64 + key2, 0), L - 1); \
            vr[i] = __builtin_nontemporal_load((const v2u*)(vb + (size_t)(r + (p2 << dsh)) * 64 + (lane & 7) * 8)); } \
        _Pragma("unroll") for (int i = 0; i < 4; ++i) { const int qq = 8 * (wave + 8 * i) + (lane & 7); \
            qv[i] = __builtin_nontemporal_load((const v2u*)(qb + (size_t)(r + ((p0 + qq) << dsh)) * 64 + (lane >> 3) * 8)); } } while (0)
    const int G8 = (int)gridDim.x, u0 = (G8 % 8 == 0) ? ((int)blockIdx.x % 8) * (G8 / 8) + (int)blockIdx.x / 8 : (int)blockIdx.x;
    if (u0 < 3072) ATTN_REQUEST(u0);
    for (int u = u0; u < 3072; u += gridDim.x) {
        ATTN_DECODE(u)
        const int b = bh >> 3, h = bh & 7;
        __syncthreads();
#pragma unroll
        for (int i = 0; i < 6; ++i) { const int wv = wave + 8 * i; const v4u z4 = (v4u){0u, 0u, 0u, 0u};
            const bool ok = (unsigned)(p0 - 64 + 8 * wv + (lane & 7)) < (unsigned)L, ok2 = (unsigned)(p0 - 64 + 8 * wv + (lane >> 3)) < (unsigned)L;
            *(LAS v4u*)(Kl + (lane >> 3) * 6144 + (8 * wv + (lane & 7)) * 16) = ok ? fp8x8_bf16(kr[i], 1.0f / 16.0f) : z4;
            *(LAS v4u*)(Vl + ((lane & 7) >> 2) * 24576 + (8 * wv + (lane >> 3)) * 64 + (lane & 3) * 16) = ok2 ? fp8x8_bf16(vr[i], 1.0f / 16.0f) : z4; }
#pragma unroll
        for (int i = 0; i < 4; ++i) *(LAS v4u*)(Ql + (lane >> 3) * 4096 + (8 * (wave + 8 * i) + (lane & 7)) * 16) = fp8x8_bf16(qv[i], 1.0f / 64.0f);
        __syncthreads();
        if (u + (int)gridDim.x < 3072) ATTN_REQUEST(u + (int)gridDim.x);
        const int sq = r + ((p0 + 32 * wave + r32) << dsh);
        bf16x8 qr[4];
#pragma unroll
        for (int d0 = 0; d0 < 4; ++d0) qr[d0] = *(const LAS bf16x8*)(Ql + (2 * d0 + hi) * 4096 + (32 * wave + r32) * 16);
        f32x16 sc[5];
#pragma unroll
        for (int k2 = 0; k2 < 5; k2 += 2) {
            const LAS unsigned char* kp = Kl + hi * 6144 + (32 * (wave + k2) + r32) * 16;
            bf16x8 ka[4], kb2[4];
#pragma unroll
            for (int d0 = 0; d0 < 4; ++d0) { ka[d0] = *(const LAS bf16x8*)(kp + d0 * 12288); if (k2 + 1 < 5) kb2[d0] = *(const LAS bf16x8*)(kp + 512 + d0 * 12288); }
#pragma unroll
            for (int d0 = 0; d0 < 4; ++d0) {
                if (d0 == 0) { sc[k2] = __builtin_amdgcn_mfma_f32_32x32x16_bf16(ka[0], qr[0], (f32x16){}, 0, 0, 0); if (k2 + 1 < 5) sc[k2 + 1] = __builtin_amdgcn_mfma_f32_32x32x16_bf16(kb2[0], qr[0], (f32x16){}, 0, 0, 0); }
                else { sc[k2] = __builtin_amdgcn_mfma_f32_32x32x16_bf16(ka[d0], qr[d0], sc[k2], 0, 0, 0); if (k2 + 1 < 5) sc[k2 + 1] = __builtin_amdgcn_mfma_f32_32x32x16_bf16(kb2[d0], qr[d0], sc[k2 + 1], 0, 0, 0); } }
            asm volatile("" ::: "memory"); }
        const float cb = __builtin_ldexpf(1.4426950408889634f, dsh - (h + 1));
        const float t0f = (float)(4 * hi - r32);
        const bool first = (p0 == 0), lastb = (p0 + 256 == L);
        float mx = -INFINITY;
#pragma unroll
        for (int kt = 0; kt < 5; ++kt) {
            float base = t0f; asm volatile("" : "+v"(base));
            const bool dead = (first && wave + kt < 2) || (lastb && wave + kt >= 10);
            if (dead) {
#pragma unroll
                for (int rr = 0; rr < 16; ++rr) sc[kt][rr] = -INFINITY;
            } else {
#pragma unroll
                for (int rr = 0; rr < 16; ++rr) { const float rel = base + (float)(32 * kt - 64 + (rr & 3) + 8 * (rr >> 2));
                    float sv = sc[kt][rr] - cb * __builtin_fabsf(rel);
                    if (kt == 0) sv = rel >= -64.f ? sv : -INFINITY;
                    if (kt == 4) sv = rel <= 64.f ? sv : -INFINITY;
                    sc[kt][rr] = sv; mx = fmaxf(mx, sv); } } }
        { auto rr = __builtin_amdgcn_permlane32_swap(__float_as_uint(mx), __float_as_uint(mx), false, false); mx = fmaxf(__uint_as_float(rr[0]), __uint_as_float(rr[1])); }
        float l = 0.f;
#pragma unroll
        for (int kt = 0; kt < 5; ++kt)
#pragma unroll
            for (int rr = 0; rr < 16; ++rr) { const float p = __builtin_amdgcn_exp2f(sc[kt][rr] - mx); sc[kt][rr] = p; l += p; }
        { auto rr = __builtin_amdgcn_permlane32_swap(__float_as_uint(l), __float_as_uint(l), false, false); l = __uint_as_float(rr[0]) + __uint_as_float(rr[1]); }
        f32x16 o0 = (f32x16){}, o1 = (f32x16){};
        const LAS unsigned char* vp = Vl + ((lane >> 4) & 1) * 32 + (lane & 3) * 8 + (4 * hi + ((lane & 15) >> 2)) * 64;
#pragma unroll
        for (int kt = 0; kt < 5; ++kt)
#pragma unroll
            for (int ks = 0; ks < 2; ++ks) { const LAS unsigned char* ap = vp + (32 * (wave + kt) + 16 * ks) * 64;
                const s16x4 l0 = vtr(ap), h0 = vtr(ap + 512), l1 = vtr(ap + 24576), h1 = vtr(ap + 24576 + 512);
                pg8::u32x4 pw; pw.x = pg8::cvt_pk_bf16(sc[kt][8 * ks + 0], sc[kt][8 * ks + 1]); pw.y = pg8::cvt_pk_bf16(sc[kt][8 * ks + 2], sc[kt][8 * ks + 3]);
                pw.z = pg8::cvt_pk_bf16(sc[kt][8 * ks + 4], sc[kt][8 * ks + 5]); pw.w = pg8::cvt_pk_bf16(sc[kt][8 * ks + 6], sc[kt][8 * ks + 7]);
                const bf16x8 pf = __builtin_bit_cast(bf16x8, pw);
                o0 = __builtin_amdgcn_mfma_f32_32x32x16_bf16((bf16x8){l0[0], l0[1], l0[2], l0[3], h0[0], h0[1], h0[2], h0[3]}, pf, o0, 0, 0, 0);
                o1 = __builtin_amdgcn_mfma_f32_32x32x16_bf16((bf16x8){l1[0], l1[1], l1[2], l1[3], h1[0], h1[1], h1[2], h1[3]}, pf, o1, 0, 0, 0);
                asm volatile("" ::: "memory"); }
        const float inv = 1.0f / l; const size_t row = (size_t)g * T + (size_t)b * 4096 + sq;
        LAS unsigned char* ow = Ql + (32 * wave) * 16;
#pragma unroll
        for (int aa = 0; aa < 4; ++aa) {
            v2u w0; w0.x = pk2(o0[4 * aa] * inv, o0[4 * aa + 1] * inv); w0.y = pk2(o0[4 * aa + 2] * inv, o0[4 * aa + 3] * inv);
            *(LAS v2u*)(ow + aa * 4096 + (r32 ^ aa) * 16 + 8 * hi) = w0;
            v2u w1; w1.x = pk2(o1[4 * aa] * inv, o1[4 * aa + 1] * inv); w1.y = pk2(o1[4 * aa + 2] * inv, o1[4 * aa + 3] * inv);
            *(LAS v2u*)(ow + (4 + aa) * 4096 + (r32 ^ (4 + aa)) * 16 + 8 * hi) = w1; }
        {   const int piece = lane & 7; bf16* ob = OG + ((size_t)g * T + (size_t)b * 4096) * AW + h * 64 + piece * 8;
#pragma unroll
            for (int i = 0; i < 4; ++i) { const int rw = (lane >> 3) + 8 * i;
                const v4u ov = *(const LAS v4u*)(ow + piece * 4096 + (rw ^ piece) * 16);
                *(v4u*)(ob + (size_t)(r + ((p0 + 32 * wave + rw) << dsh)) * AW) = ov; } }
        if (hi == 0) LSE[row * 8 + h] = mx + __builtin_log2f(l);
    }
#undef ATTN_DECODE
#undef ATTN_REQUEST
}
__device__ __forceinline__ void attn_merge_phase(KArgs& a) {
    int tid = threadIdx.x; asm volatile("" : "+v"(tid)); const int lane = tid & 63, wave = __builtin_amdgcn_readfirstlane(tid >> 6);
    const bf16* OG = (const bf16*)(a.ws + WS_OG); const float* LSE = (const float*)(a.ws + WS_LSE); bf16* O = (bf16*)(a.ws + WS_O);
    const int gw = blockIdx.x * 8 + wave, NGW = gridDim.x * 8;
    float lsn[3]; v4u ogn[3];
#pragma unroll
    for (int g = 0; g < 3; ++g) { lsn[g] = 0.f; ogn[g] = (v4u){0u, 0u, 0u, 0u}; }
    if (gw < T) {
#pragma unroll
        for (int g = 0; g < 3; ++g) { lsn[g] = LSE[((size_t)g * T + gw) * 8 + (lane >> 3)]; ogn[g] = __builtin_nontemporal_load((const v4u*)(OG + ((size_t)g * T + gw) * AW + lane * 8)); } }
    for (int row = gw; row < T; row += NGW) {
        float ls[3]; v4u og[3];
#pragma unroll
        for (int g = 0; g < 3; ++g) { ls[g] = lsn[g]; og[g] = ogn[g]; }
        if (row + NGW < T) {
#pragma unroll
            for (int g = 0; g < 3; ++g) { lsn[g] = LSE[((size_t)g * T + row + NGW) * 8 + (lane >> 3)]; ogn[g] = __builtin_nontemporal_load((const v4u*)(OG + ((size_t)g * T + row + NGW) * AW + lane * 8)); } }
        const float M = fmaxf(fmaxf(ls[0], ls[1]), ls[2]);
        float w[3]; float den = 0.f;
#pragma unroll
        for (int g = 0; g < 3; ++g) { w[g] = __builtin_amdgcn_exp2f(ls[g] - M); den += w[g]; }
        const float iden = 1.0f / den;
        float acc[8];
#pragma unroll
        for (int i = 0; i < 8; ++i) acc[i] = 0.f;
#pragma unroll
        for (int g = 0; g < 3; ++g) { const float wg = w[g] * iden; const unsigned ww[4] = {og[g].x, og[g].y, og[g].z, og[g].w};
#pragma unroll
            for (int i = 0; i < 4; ++i) { acc[2 * i] += wg * bf_lo(ww[i]); acc[2 * i + 1] += wg * bf_hi(ww[i]); } }
        v4u o; o.x = pk2(acc[0], acc[1]); o.y = pk2(acc[2], acc[3]); o.z = pk2(acc[4], acc[5]); o.w = pk2(acc[6], acc[7]);
        *(v4u*)(O + (size_t)row * AW + lane * 8) = o;
    }
}

__device__ __forceinline__ void router_phase(KArgs& a, int layer, LAS unsigned char* lds) {
    int tid = threadIdx.x; asm volatile("" : "+v"(tid)); const int lane = tid & 63, wave = __builtin_amdgcn_readfirstlane(tid >> 6);
    const float* Wr = a.moe_w_router + (size_t)layer * D * NE; const float* br = a.moe_b_router + layer * NE; const float* gain = a.ffn_norm + layer * D;
    LAS unsigned char* wf = lds;
    LAS float* gl = (LAS float*)(lds + 65536);
    LAS float* rl = (LAS float*)(lds + 65536 + 4096) + wave * 16;
    unsigned char* H8 = a.ws + WS_H; float* AFF = (float*)(a.ws + WS_AFF); float* RINV = (float*)(a.ws + WS_RINV); const bf16* XB = (const bf16*)(a.ws + WS_XB);
    const int gw = blockIdx.x * 8 + wave, NGW = gridDim.x * 8, ti = lane & 15, q = lane >> 4;
#define RT_LOAD(buf, c) do { _Pragma("unroll") for (int j = 0; j < 8; ++j) buf[j] = __builtin_nontemporal_load(xr + 4 * (8 * (c) + j)); } while (0)
    v4u xa[8], xb[8];
    if (gw < T / 16) { const v4u* xr = (const v4u*)(XB + (size_t)(16 * gw + ti) * D + 8 * q); RT_LOAD(xa, 0); }
    __syncthreads();
#pragma unroll
    for (int n = 0; n < 4; ++n) { const int idx = tid + 512 * n, st = idx >> 6, l = idx & 63, k0 = 32 * st + 8 * (l >> 4), e = l & 15;
        float w[8];
#pragma unroll
        for (int c = 0; c < 8; ++c) w[c] = Wr[(size_t)(k0 + c) * NE + e];
        v4u hi, lo;
        hi.x = pk2(w[0], w[1]); hi.y = pk2(w[2], w[3]); hi.z = pk2(w[4], w[5]); hi.w = pk2(w[6], w[7]);
        lo.x = pk2(w[0] - bf_lo(hi.x), w[1] - bf_hi(hi.x)); lo.y = pk2(w[2] - bf_lo(hi.y), w[3] - bf_hi(hi.y)); lo.z = pk2(w[4] - bf_lo(hi.z), w[5] - bf_hi(hi.z)); lo.w = pk2(w[6] - bf_lo(hi.w), w[7] - bf_hi(hi.w));
        *(LAS v4u*)(wf + ((st * 2 + 0) * 64 + l) * 16) = hi; *(LAS v4u*)(wf + ((st * 2 + 1) * 64 + l) * 16) = lo; }
    if (tid < 256) *(LAS f32x4*)(gl + 4 * tid) = *(const f32x4*)(gain + 4 * tid);
    __syncthreads();
    for (int grp = gw; grp < T / 16; grp += NGW) {
        const int r0 = 16 * grp;
        const v4u* xr = (const v4u*)(XB + (size_t)(r0 + ti) * D + 8 * q);
        unsigned char* hp = H8 + (size_t)(r0 + ti) * D + 8 * q;
        f32x4 acc = {0.f, 0.f, 0.f, 0.f}; float ss = 0.f;
#define RT_STEPS(buf, c) do { _Pragma("unroll") for (int j = 0; j < 8; ++j) { const int st = 8 * (c) + j; const f32x4 x0 = {bf_lo(buf[j].x), bf_hi(buf[j].x), bf_lo(buf[j].y), bf_hi(buf[j].y)}, x1 = {bf_lo(buf[j].z), bf_hi(buf[j].z), bf_lo(buf[j].w), bf_hi(buf[j].w)}; \
            const f32x4 g0 = *(const LAS f32x4*)(gl + 32 * st + 8 * q), g1 = *(const LAS f32x4*)(gl + 32 * st + 8 * q + 4); \
            ss += (x0.x * x0.x + x0.y * x0.y) + (x0.z * x0.z + x0.w * x0.w) + (x1.x * x1.x + x1.y * x1.y) + (x1.z * x1.z + x1.w * x1.w); \
            const f32x4 y0 = x0 * g0, y1 = x1 * g1; \
            v2u h8; h8.x = pk8(y0.x * 4.f, y0.y * 4.f, y0.z * 4.f, y0.w * 4.f); h8.y = pk8(y1.x * 4.f, y1.y * 4.f, y1.z * 4.f, y1.w * 4.f); *(v2u*)(hp + 32 * st) = h8; \
            v4u hi, lo; hi.x = pk2(y0.x, y0.y); hi.y = pk2(y0.z, y0.w); hi.z = pk2(y1.x, y1.y); hi.w = pk2(y1.z, y1.w); \
            lo.x = pk2(y0.x - bf_lo(hi.x), y0.y - bf_hi(hi.x)); lo.y = pk2(y0.z - bf_lo(hi.y), y0.w - bf_hi(hi.y)); lo.z = pk2(y1.x - bf_lo(hi.z), y1.y - bf_hi(hi.z)); lo.w = pk2(y1.z - bf_lo(hi.w), y1.w - bf_hi(hi.w)); \
            const bf16x8 wh = *(const LAS bf16x8*)(wf + ((st * 2 + 0) * 64 + lane) * 16), wl = *(const LAS bf16x8*)(wf + ((st * 2 + 1) * 64 + lane) * 16); \
            const bf16x8 ah = __builtin_bit_cast(bf16x8, hi), al = __builtin_bit_cast(bf16x8, lo); \
            acc = __builtin_amdgcn_mfma_f32_16x16x32_bf16(ah, wh, acc, 0, 0, 0); acc = __builtin_amdgcn_mfma_f32_16x16x32_bf16(ah, wl, acc, 0, 0, 0); acc = __builtin_amdgcn_mfma_f32_16x16x32_bf16(al, wh, acc, 0, 0, 0); } } while (0)
        if (grp != gw) RT_LOAD(xa, 0);
        RT_LOAD(xb, 1); RT_STEPS(xa, 0);
        RT_LOAD(xa, 2); RT_STEPS(xb, 1);
        RT_LOAD(xb, 3); RT_STEPS(xa, 2);
        RT_STEPS(xb, 3);
#undef RT_LOAD
#undef RT_STEPS
        { auto rr = __builtin_amdgcn_permlane16_swap(__float_as_uint(ss), __float_as_uint(ss), false, false); ss = __uint_as_float(rr[0]) + __uint_as_float(rr[1]); }
        { auto rr = __builtin_amdgcn_permlane32_swap(__float_as_uint(ss), __float_as_uint(ss), false, false); ss = __uint_as_float(rr[0]) + __uint_as_float(rr[1]); }
        const float rinv = __builtin_amdgcn_rsqf((ss + EPS * D) * (1.f / D));
        if (lane < 16) { rl[lane] = rinv; RINV[r0 + lane] = rinv; }
        LDS_WAIT(); asm volatile("" ::: "memory");
        const f32x4 rv = *(const LAS f32x4*)(rl + 4 * q);
        const float be = br[ti];
        float pr[4];
#pragma unroll
        for (int t = 0; t < 4; ++t) { const float lg = acc[t] * rv[t] + be; const float m = row_max(lg); const float ex = __expf(lg - m); pr[t] = ex / row_sum(ex); }
        { const int row = r0 + 4 * q; float* ap = AFF + ((size_t)(row >> 12) * 16 + ti) * 4096 + (row & 4095); *(f32x4*)ap = (f32x4){pr[0], pr[1], pr[2], pr[3]}; }
        LDS_WAIT(); asm volatile("" ::: "memory");
    }
}

__device__ __forceinline__ void topk_phase(KArgs& a, LAS unsigned char* lds) {
    int tid = threadIdx.x; asm volatile("" : "+v"(tid)); const int lane = tid & 63, wave = __builtin_amdgcn_readfirstlane(tid >> 6); (void)lane; (void)wave;
    LAS unsigned* hist = (LAS unsigned*)lds;
    LAS unsigned* sh = hist + 256;
    LAS unsigned* wtot = hist + 272;
    const float* AFF = (const float*)(a.ws + WS_AFF); int* SMAP = (int*)(a.ws + WS_SMAP); int* TOK = (int*)(a.ws + WS_TOK); float* GATE = (float*)(a.ws + WS_GATE); float* RS = (float*)(a.ws + WS_RS); const float* RINV = (const float*)(a.ws + WS_RINV);
    for (int prob = blockIdx.x; prob < NB * NE; prob += gridDim.x) {
        const int b = prob >> 4, e = prob & 15;
        const v4u* src = (const v4u*)(AFF + (size_t)prob * 4096) + 2 * tid;
        const v4u k0 = src[0], k1 = src[1];
        const f32x4* rsrc = (const f32x4*)(RINV + (size_t)b * 4096) + 2 * tid; const f32x4 r0 = rsrc[0], r1 = rsrc[1];
        const float rv[8] = {r0.x, r0.y, r0.z, r0.w, r1.x, r1.y, r1.z, r1.w};
        unsigned key[8] = {k0.x, k0.y, k0.z, k0.w, k1.x, k1.y, k1.z, k1.w};
        unsigned prefix = 0u, kk = CAP;
#pragma unroll
        for (int pass = 0; pass < 4; ++pass) {
            const int shift = 24 - 8 * pass; const unsigned mhi = pass == 0 ? 0u : (0xFFFFFFFFu << (shift + 8));
            __syncthreads();
            if (tid < 256) hist[tid] = 0u;
            __syncthreads();
#pragma unroll
            for (int i = 0; i < 8; ++i) if ((key[i] & mhi) == prefix) { unsigned one = 1u; asm volatile("" : "+v"(one)); __hip_atomic_fetch_add(&hist[(key[i] >> shift) & 255u], one, __ATOMIC_RELAXED, __HIP_MEMORY_SCOPE_WORKGROUP); }
            __syncthreads();
            if (wave == 0) {
                const unsigned c0 = hist[4 * lane], c1 = hist[4 * lane + 1], c2 = hist[4 * lane + 2], c3 = hist[4 * lane + 3];
                const unsigned tot = c0 + c1 + c2 + c3;
                unsigned suf = tot;
#pragma unroll
                for (int o = 1; o < 64; o <<= 1) { const unsigned t = (unsigned)__builtin_amdgcn_ds_bpermute(((lane + o) & 63) << 2, (int)suf); if (lane + o < 64) suf += t; }
                unsigned gt = suf - tot;
                if (gt < kk && kk <= gt + c3) { sh[0] = 4 * lane + 3; sh[1] = kk - gt; } gt += c3;
                if (gt < kk && kk <= gt + c2) { sh[0] = 4 * lane + 2; sh[1] = kk - gt; } gt += c2;
                if (gt < kk && kk <= gt + c1) { sh[0] = 4 * lane + 1; sh[1] = kk - gt; } gt += c1;
                if (gt < kk && kk <= gt + c0) { sh[0] = 4 * lane + 0; sh[1] = kk - gt; }
            }
            __syncthreads();
            prefix |= sh[0] << shift; kk = sh[1];
        }
        unsigned cg = 0u, ce = 0u;
#pragma unroll
        for (int i = 0; i < 8; ++i) { cg += key[i] > prefix ? 1u : 0u; ce += key[i] == prefix ? 1u : 0u; }
        const unsigned mine = cg | (ce << 16);
        unsigned inc = mine;
#pragma unroll
        for (int o = 1; o < 64; o <<= 1) { const unsigned t = (unsigned)__builtin_amdgcn_ds_bpermute(((lane - o) & 63) << 2, (int)inc); if (lane >= o) inc += t; }
        __syncthreads();
        if (lane == 63) wtot[wave] = inc;
        __syncthreads();
        unsigned base = 0u;
#pragma unroll
        for (int w = 0; w < 8; ++w) base += (w < wave) ? wtot[w] : 0u;
        const unsigned exc = base + inc - mine;
        unsigned gb = exc & 0xffffu, eb = exc >> 16;
        const int srow0 = (e * 8 + b) * CAP;
#pragma unroll
        for (int i = 0; i < 8; ++i) { const int s = 8 * tid + i; int slot = -1;
            if (key[i] > prefix) { slot = (int)(gb + (eb < kk ? eb : kk)); gb++; }
            else if (key[i] == prefix) { if (eb < kk) slot = (int)(gb + eb); eb++; }
            int sr = -1;
            if (slot >= 0) { sr = srow0 + slot; TOK[sr] = b * 4096 + s; GATE[sr] = __builtin_bit_cast(float, key[i]); RS[sr] = rv[i]; }
            SMAP[(size_t)prob * 4096 + s] = sr; }
    }
}

__device__ __forceinline__ void combine_phase(KArgs& a, int layer) {
    int tid = threadIdx.x; asm volatile("" : "+v"(tid)); const int lane = tid & 63, wave = __builtin_amdgcn_readfirstlane(tid >> 6);
    const unsigned char* Y = a.ws + WS_Y; const int* SMAP = (const int*)(a.ws + WS_SMAP); bf16* H = (bf16*)(a.ws + WS_H); const bf16* XBp = (const bf16*)(a.ws + WS_XB);
    const int gw = blockIdx.x * 8 + wave, NGW = gridDim.x * 8;
#define CB_A(r_, srv_, x_) do { const int b_ = (r_) >> 12, s_ = (r_) & 4095; srv_ = SMAP[((size_t)b_ * 16 + (lane & 15)) * 4096 + s_]; const v2u* xi_ = (const v2u*)(XBp + (size_t)(r_) * D) + lane; \
        _Pragma("unroll") for (int j = 0; j < 4; ++j) x_[j] = __builtin_nontemporal_load(xi_ + 64 * j); } while (0)
#define CB_B(srv_, mask_, y_) do { mask_ = (unsigned)(__builtin_amdgcn_ballot_w64(srv_ >= 0) & 0xffffull); \
        _Pragma("unroll") for (int k = 0; k < 4; ++k) { const bool on_ = mask_ != 0u; const int e_ = on_ ? __builtin_ctz(mask_) : 0; const int sr_ = __builtin_amdgcn_readlane(srv_, e_); if (on_) mask_ &= mask_ - 1u; \
            if (on_) { const unsigned* yr_ = (const unsigned*)(Y + (size_t)sr_ * D) + lane; _Pragma("unroll") for (int j = 0; j < 4; ++j) y_[k][j] = __builtin_nontemporal_load(yr_ + 64 * j); } \
            else { _Pragma("unroll") for (int j = 0; j < 4; ++j) y_[k][j] = 0u; } } } while (0)
    int srv_c = -1, srv_n = -1, srv_nn = -1; v2u x_c[4], x_n[4], x_nn[4]; unsigned y_c[4][4], y_n[4][4]; unsigned mask_c = 0u, mask_n = 0u;
#pragma unroll
    for (int j = 0; j < 4; ++j) { x_c[j] = (v2u){0u, 0u}; x_n[j] = x_c[j]; x_nn[j] = x_c[j]; }
    if (gw < T) { CB_A(gw, srv_c, x_c); if (gw + NGW < T) CB_A(gw + NGW, srv_n, x_n); CB_B(srv_c, mask_c, y_c); }
    for (int row = gw; row < T; row += NGW) {
        if (row + 2 * NGW < T) CB_A(row + 2 * NGW, srv_nn, x_nn);
        if (row + NGW < T) CB_B(srv_n, mask_n, y_n);
        f32x4 v[4];
#pragma unroll
        for (int j = 0; j < 4; ++j) v[j] = (f32x4){bf_lo(x_c[j].x), bf_hi(x_c[j].x), bf_lo(x_c[j].y), bf_hi(x_c[j].y)};
#pragma unroll
        for (int k = 0; k < 4; ++k)
#pragma unroll
            for (int j = 0; j < 4; ++j) { const f32x2_t lo = __builtin_amdgcn_cvt_pk_f32_fp8((int)y_c[k][j], false), hi = __builtin_amdgcn_cvt_pk_f32_fp8((int)y_c[k][j], true);
                v[j].x += lo.x * (1.0f / 32.0f); v[j].y += lo.y * (1.0f / 32.0f); v[j].z += hi.x * (1.0f / 32.0f); v[j].w += hi.y * (1.0f / 32.0f); }
        while (mask_c) {
            unsigned yt[4][4]; unsigned m2 = mask_c; const int srv_t = srv_c;
#pragma unroll
            for (int k = 0; k < 4; ++k) { const bool on_ = m2 != 0u; const int e_ = on_ ? __builtin_ctz(m2) : 0; const int sr_ = __builtin_amdgcn_readlane(srv_t, e_); if (on_) m2 &= m2 - 1u;
                if (on_) { const unsigned* yr_ = (const unsigned*)(Y + (size_t)sr_ * D) + lane;
#pragma unroll
                    for (int j = 0; j < 4; ++j) yt[k][j] = __builtin_nontemporal_load(yr_ + 64 * j); } else {
#pragma unroll
                    for (int j = 0; j < 4; ++j) yt[k][j] = 0u; } }
            mask_c = m2;
#pragma unroll
            for (int k = 0; k < 4; ++k)
#pragma unroll
                for (int j = 0; j < 4; ++j) { const f32x2_t lo = __builtin_amdgcn_cvt_pk_f32_fp8((int)yt[k][j], false), hi = __builtin_amdgcn_cvt_pk_f32_fp8((int)yt[k][j], true);
                    v[j].x += lo.x * (1.0f / 32.0f); v[j].y += lo.y * (1.0f / 32.0f); v[j].z += hi.x * (1.0f / 32.0f); v[j].w += hi.y * (1.0f / 32.0f); }
        }
        srv_c = srv_n; srv_n = srv_nn; mask_c = mask_n;
#pragma unroll
        for (int j = 0; j < 4; ++j) { x_c[j] = x_n[j]; x_n[j] = x_nn[j]; }
#pragma unroll
        for (int k = 0; k < 4; ++k)
#pragma unroll
            for (int j = 0; j < 4; ++j) y_c[k][j] = y_n[k][j];
        if (layer == 3) { f32x4* xr = (f32x4*)(a.out + (size_t)row * D) + lane;
#pragma unroll
            for (int j = 0; j < 4; ++j) xr[64 * j] = v[j];
        } else { v2u* xo = (v2u*)((bf16*)(a.ws + WS_XO) + (size_t)row * D) + lane;
#pragma unroll
            for (int j = 0; j < 4; ++j) { v2u t; t.x = pk2(v[j].x, v[j].y); t.y = pk2(v[j].z, v[j].w); xo[64 * j] = t; } }
        if (layer < 3) {
            const f32x4* gr = (const f32x4*)(a.mix_norm + (layer + 1) * D) + lane; float ss = 0.f;
#pragma unroll
            for (int j = 0; j < 4; ++j) ss += (v[j].x * v[j].x + v[j].y * v[j].y) + (v[j].z * v[j].z + v[j].w * v[j].w);
            const float rinv = __builtin_amdgcn_rsqf((wave_sum(ss) + EPS * D) * (1.f / D));
            if ((layer & 1) == 0) { unsigned* o4 = (unsigned*)((unsigned char*)H + (size_t)row * D) + lane;
#pragma unroll
                for (int j = 0; j < 4; ++j) { const f32x4 y = v[j] * (rinv * 4.0f) * gr[64 * j]; o4[64 * j] = pk8(y.x, y.y, y.z, y.w); }
            } else {
            unsigned long long* o8 = (unsigned long long*)(H + (size_t)row * D) + lane;
#pragma unroll
            for (int j = 0; j < 4; ++j) { const f32x4 y = v[j] * rinv * gr[64 * j]; o8[64 * j] = (unsigned long long)pk2(y.x, y.y) | ((unsigned long long)pk2(y.z, y.w) << 32); } }
        }
    }
}

constexpr int N_PHASES = 1 + 4 * 9;
__global__ void __launch_bounds__(512, 2) mega_fwd(Args a_k) {
    KArgs* const kargs = (KArgs*)__builtin_amdgcn_kernarg_segment_ptr(); KArgs& a = *kargs; (void)a_k;
    extern __shared__ __attribute__((aligned(16))) unsigned char lds_raw[];
    LAS unsigned char* lds = (LAS unsigned char*)lds_raw;
    const int tid = threadIdx.x, lane = tid & 63, wave = __builtin_amdgcn_readfirstlane(tid >> 6);
    const int G = gridDim.x, bid = blockIdx.x;
    unsigned char* ws = a.ws;
    volatile LAS unsigned* MISC = (volatile LAS unsigned*)(lds + LDSCTL_OFF);
    if (tid < 64) MISC[tid] = 0u;
    __syncthreads();
#if !MK_MULTI
    XcdBarrier bar = xcd_barrier_post((unsigned*)(ws + WS_CTL) + CW_BAR, MISC + 8);
#define GRID_BAR() xcd_barrier(bar)
#else
#define GRID_BAR() do {} while (0)
#endif
    const int lo = a.ph_lo, hi = a.ph_hi;
#ifndef PH_EN
#define PH_EN 0x1fff
#endif
#define EN(b) ((PH_EN >> (b)) & 1)
#ifndef PH_REP
#define PH_REP 0
#endif
#define NREP(b) (1 + ((PH_REP >> (b)) & 1))
#define IN(k) (lo <= (k) && (k) < hi)
#define SEAM(k) do { if (IN((k) + 1)) GRID_BAR(); } while (0)

#define PHASE(bit, k, seam, ...) do { if (EN(bit) && IN(k)) { for (int rep_ = 0; rep_ < NREP(bit); ++rep_) { if (rep_) GRID_BAR(); KArgs* kp_ = kargs; asm volatile("" : "+s"(kp_)); KArgs& a = *kp_; unsigned char* ws = a.ws; bf16* H = (bf16*)(ws + WS_H); (void)H; __VA_ARGS__ } if (seam) SEAM(k); } } while (0)
    constexpr int NG = 208;
    const bool split = (G == 256);
    PHASE(12, 0, true, prologue_phase(a, lds, split ? 1 : 4););

    for (int layer = 0; layer < 4; ++layer) {
        const int pb = 1 + 9 * layer, j = layer >> 1;
        if ((layer & 1) == 0) {
            PHASE(0, pb + 0, true,
                { pg8::Gemm g{H, (const bf16*)(ws + WS_WIN) + (size_t)j * 6144 * 1024, T, GW, D}; pg8::StaticOrder S; S.init(T, GW, G, bid);
                  pg8::EpiGeluBf16 E{(bf16*)(ws + WS_U), GW, a.gm_b_in + j * 6144};
                  pg8::gemm_phase<pg8::EpiGeluBf16, pg8::StaticOrder, true, true>(lds, g, S, E); }
                { pg8::Gemm g{(const bf16*)(ws + WS_WIN) + (size_t)j * 6144 * 1024 + (size_t)GW * 1024, H, GW, T, D}; pg8::StaticOrder S; S.init(GW, T, G, bid);
                  pg8::EpiVT E{(bf16*)(ws + WS_VT), T, a.gm_b_in + j * 6144 + GW, (float*)(ws + WS_SSQ)};
                  pg8::gemm_phase<pg8::EpiVT, pg8::StaticOrder, true, true>(lds, g, S, E); });
            PHASE(1, pb + 1, true, gating_phase(a, j, lds););
            PHASE(2, pb + 2, true,
                pg8::Gemm g{(const bf16*)(ws + WS_UV), (const bf16*)(ws + WS_WOUT) + (size_t)j * 1024 * 3072, T, D, GW}; pg8::StaticOrder S; S.init(T, D, G, bid);
                pg8::EpiResid E{layer == 0 ? (const void*)a.x : (const void*)(ws + WS_XO), layer == 0, (bf16*)(ws + WS_XB), D, a.gm_b_out + j * D};
                pg8::gemm_phase<pg8::EpiResid, pg8::StaticOrder, true, true>(lds, g, S, E););
        } else {
            PHASE(3, pb + 0, true,
                pg8::Gemm g{H, (const bf16*)(ws + WS_WQKV) + (size_t)j * QKVW * 1024, T, QKVW, D / 2}; pg8::StaticOrder S; S.init(T, QKVW, G, bid);
                pg8::EpiQKV E{(bf16*)(ws + WS_QKV), a.at_q_norm + j * 192, a.at_k_norm + j * 192};
                pg8::gemm_phase<pg8::EpiQKV, pg8::StaticOrder, true, false, true>(lds, g, S, E););
            PHASE(4, pb + 1, true, for (int q_ = 0; q_ < NREP(13); ++q_) { if (q_) GRID_BAR(); attn_phase(a, lds); } GRID_BAR(); for (int q_ = 0; q_ < NREP(14); ++q_) { if (q_) GRID_BAR(); attn_merge_phase(a); });
            PHASE(5, pb + 2, true,
                pg8::Gemm g{(const bf16*)(ws + WS_O), (const bf16*)(ws + WS_WO) + (size_t)j * 1024 * 512, T, D, AW}; pg8::StaticOrder S; S.init(T, D, G, bid);
                pg8::EpiResid E{layer == 0 ? (const void*)a.x : (const void*)(ws + WS_XO), layer == 0, (bf16*)(ws + WS_XB), D, nullptr};
                pg8::gemm_phase<pg8::EpiResid, pg8::StaticOrder, true, true>(lds, g, S, E););
        }
        PHASE(6, pb + 3, true, router_phase(a, layer, lds););
        PHASE(7, pb + 4, true, topk_phase(a, lds););
        PHASE(9, pb + 6, true,
            const bool hetero = split && layer < 3;
            if (hetero && bid >= NG) { moe_convert_layer(a, layer + 1, lds, (bid - NG) * 8 + wave, (G - NG) * 8); }
            else {
            pg8::Gemm g{H, (const bf16*)(ws + WS_W13) + (size_t)layer * 16 * 4096 * 1024, NSLOT, 16 * 4096, D / 2}; pg8::MoeOrder1 S{hetero ? NG : G, bid};
            pg8::EpiSwiGLU E{(bf16*)(ws + WS_HID), (const float*)(ws + WS_RS), (LAS const float*)(lds + pg8::STAGE_BYTES + 1024), 0};
            pg8::gemm_phase_gather<pg8::EpiSwiGLU, pg8::MoeOrder1, true>(lds, g, (const int*)(ws + WS_TOK), S, E); });
        PHASE(10, pb + 7, true,
            pg8::Gemm g{(const bf16*)(ws + WS_HID), (const bf16*)(ws + WS_W2) + (size_t)layer * 16 * 1024 * 2048, NSLOT, 16 * 1024, DE / 2}; pg8::MoeOrder2 S{G, bid};
            pg8::EpiGate E{(bf16*)(ws + WS_Y), (const float*)(ws + WS_GATE)};
            pg8::gemm_phase<pg8::EpiGate, pg8::MoeOrder2, true, true, true>(lds, g, S, E););
        PHASE(11, pb + 8, layer < 3, combine_phase(a, layer););
    }
#undef PHASE
#undef IN
#undef SEAM
}

extern "C" void kernel_launch(void* const* d_in, const int* in_sizes, int n_in, void* d_out, int out_size, void* d_ws, size_t ws_size, hipStream_t stream) {
    static int grid = 0;
    if (grid == 0) {
        if (n_in != 19 || out_size != T * D || ws_size < WS_END) { fprintf(stderr, "kernel_launch: unexpected shapes (n_in %d, out %d, ws %zu < %zu)\n", n_in, out_size, ws_size, (size_t)WS_END); grid = -1; return; }
        int dev = 0, cus = 0, per_cu = 0;
        if (hipGetDevice(&dev) != hipSuccess || hipDeviceGetAttribute(&cus, hipDeviceAttributeMultiprocessorCount, dev) != hipSuccess) { grid = -1; return; }
        if (hipFuncSetAttribute((const void*)mega_fwd, hipFuncAttributeMaxDynamicSharedMemorySize, LDS_BYTES) != hipSuccess) { fprintf(stderr, "kernel_launch: hipFuncSetAttribute failed\n"); grid = -1; return; }
        if (hipOccupancyMaxActiveBlocksPerMultiprocessor(&per_cu, (const void*)mega_fwd, 512, LDS_BYTES) != hipSuccess || per_cu < 1) { fprintf(stderr, "kernel_launch: occupancy query says %d\n", per_cu); }
        (void)hipGetLastError();
        grid = cus;
    }
    if (grid < 0) return;
    (void)hipMemsetAsync((char*)d_ws + WS_CTL, 0, CTL_ZERO_BYTES, stream);
    Args a{};
    const float** ap = (const float**)&a;
    for (int i = 0; i < 19; ++i) ap[i] = (const float*)d_in[i];
    a.out = (float*)d_out; a.ws = (unsigned char*)d_ws;
#if MK_MULTI
    for (int p = 0; p < N_PHASES; ++p) { a.ph_lo = p; a.ph_hi = p + 1; hipLaunchKernelGGL(mega_fwd, dim3(grid), dim3(512), LDS_BYTES, stream, a); }
#else
    a.ph_lo = 0; a.ph_hi = N_PHASES;
    hipLaunchKernelGGL(mega_fwd, dim3(grid), dim3(512), LDS_BYTES, stream, a);
#endif
}
```
